# Optimizing an MI355X kernel written in HIP

```python
import math
import jax, jax.numpy as jnp
from jax import lax
import numpy as np


D_MODEL = 2048
BATCH = 4
SEQ = 4096
DEPTH = 2

N_EVEN = (DEPTH + 1) // 2
N_ODD = DEPTH // 2
EPS = 1e-6
ROPE_THETA = 500000.0
MLSTM_HEADS = 4
MLSTM_DQK = 128
MLSTM_DV = 256
MLSTM_CHUNK = 128
CONV_W = 4
DIFF_HEADS = 8
DIFF_DQK = 64
DIFF_DV = 128
ATTN_Q_BLOCK = 128
MOBA_HEADS = 8
MOBA_DH = 128
MOBA_BLOCK = 256
MOBA_TOPK = 3
MOBA_Q_STEP = 16
SGU_GROUPS = 8
SGU_CH = 128
SGU_CHUNK = 128
PEER_HEADS = 8
PEER_NKEYS = 128
PEER_N = PEER_NKEYS * PEER_NKEYS
PEER_DQ = 256
PEER_TOPK = 16
PEER_TOKEN_BLOCK = 128
PEER_V_SCALE = 1.0
A_QK = MLSTM_HEADS * MLSTM_DQK
A_V = MLSTM_HEADS * MLSTM_DV
B_QK = DIFF_HEADS * 2 * DIFF_DQK
B_V = DIFF_HEADS * DIFF_DV
EVEN_IN = 2 * A_QK + 2 * A_V + 2 * MLSTM_HEADS + 2 * B_QK + B_V
EVEN_OUT = A_V + B_V
C_W = MOBA_HEADS * MOBA_DH
D_W = SGU_GROUPS * SGU_CH
ODD_IN = 3 * C_W + 2 * D_W
ODD_OUT = C_W + D_W

kernel_name = 'hybrid_mlstm_diffattn_moba_sgu_peer'

F32 = jnp.float32


def rmsnorm(x, g):
    xf = x.astype(F32)
    y = xf * lax.rsqrt(jnp.mean(xf * xf, axis=-1, keepdims=True) + EPS)
    return (y * g.astype(F32)).astype(x.dtype)


def split_heads(t, n):
    B, S, _ = t.shape
    return t.reshape(B, S, n, -1).transpose(0, 2, 1, 3)


def merge_heads(t):
    B, H, S, d = t.shape
    return t.transpose(0, 2, 1, 3).reshape(B, S, H * d)


def rope_tables(positions, dh):
    half = dh // 8
    inv = ROPE_THETA ** (-jnp.arange(half, dtype=F32) / half)
    ang = positions.astype(F32)[..., None] * inv
    return jnp.cos(ang), jnp.sin(ang)


def apply_rope(x, cos, sin):
    half = cos.shape[-1]
    cos = cos.astype(x.dtype)
    sin = sin.astype(x.dtype)
    x1 = x[..., :half]
    x2 = x[..., half:2 * half]
    return jnp.concatenate([x1 * cos - x2 * sin, x2 * cos + x1 * sin, x[..., 2 * half:]], axis=-1)


def causal_conv(x, w, b):
    C = x.shape[-1]
    y = lax.conv_general_dilated(x, w[:, None, :].astype(x.dtype), window_strides=(1,),
                                 padding=[(CONV_W - 1, 0)], dimension_numbers=('NWC', 'WIO', 'NWC'),
                                 feature_group_count=C)
    return y + b


def mlstm_chunkwise(q, k, v, i_pre, f_pre):
    B, H, S, dqk = q.shape
    dv = v.shape[-1]
    L = MLSTM_CHUNK
    nc = S // L
    q = q * (dqk ** -0.5)
    lf = jax.nn.log_sigmoid(f_pre.astype(F32))
    li = i_pre.astype(F32)

    def to_chunks(t):
        return jnp.moveaxis(t.reshape((B, H, nc, L) + t.shape[3:]), 2, 0)

    xs = tuple(to_chunks(t) for t in (q, k, v, lf, li))
    causal = jnp.tril(jnp.ones((L, L), bool))

    def step(carry, inp):
        Cst, nst, m = carry
        qb, kb, vb, lfb, lib = inp
        qb, kb, vb = qb.astype(F32), kb.astype(F32), vb.astype(F32)
        bcum = jnp.cumsum(lfb, axis=-1)
        g = bcum[..., -1]
        d_intra = jnp.where(causal, bcum[..., :, None] - bcum[..., None, :] + lib[..., None, :], -jnp.inf)
        d_inter = bcum + m[..., None]
        m_t = jnp.maximum(d_inter, jnp.max(d_intra, axis=-1))
        w_intra = jnp.exp(d_intra - m_t[..., None])
        w_inter = jnp.exp(d_inter - m_t)
        s = jnp.einsum('bhtd,bhsd->bhts', qb, kb) * w_intra
        num = jnp.einsum('bhts,bhsv->bhtv', s, vb) + w_inter[..., None] * jnp.einsum('bhtd,bhdv->bhtv', qb, Cst)
        den = jnp.sum(s, axis=-1) + w_inter * jnp.einsum('bhtd,bhd->bht', qb, nst)
        h = num / jnp.maximum(jnp.abs(den), jnp.exp(-m_t))[..., None]
        d_state = g[..., None] - bcum + lib
        m_new = jnp.maximum(g + m, jnp.max(d_state, axis=-1))
        w_s = jnp.exp(d_state - m_new[..., None])
        w_c = jnp.exp(g + m - m_new)
        C_new = w_c[..., None, None] * Cst + jnp.einsum('bhs,bhsd,bhsv->bhdv', w_s, kb, vb)
        n_new = w_c[..., None] * nst + jnp.einsum('bhs,bhsd->bhd', w_s, kb)
        return (C_new, n_new, m_new), h.astype(v.dtype)

    init = (jnp.zeros((B, H, dqk, dv), F32), jnp.zeros((B, H, dqk), F32), jnp.zeros((B, H), F32))
    _, hs = lax.scan(step, init, xs)
    return jnp.moveaxis(hs, 0, 2).reshape(B, H, S, dv)


def diff_attention(q, k, v, lam):
    B, H, S, _, dqk = q.shape
    scale = dqk ** -0.5
    nq = S // ATTN_Q_BLOCK
    qs = jnp.moveaxis(q.reshape(B, H, nq, ATTN_Q_BLOCK, 2, dqk), 2, 0)
    kpos = jnp.arange(S)

    def step(args):
        qi, j = args
        qpos = j * ATTN_Q_BLOCK + jnp.arange(ATTN_Q_BLOCK)
        s = jnp.einsum('bhqcd,bhkcd->cbhqk', qi, k).astype(F32) * scale
        s = jnp.where(kpos[None, :] <= qpos[:, None], s, -jnp.inf)
        p = jax.nn.softmax(s, axis=-1)
        a = (p[0] - lam * p[1]).astype(v.dtype)
        return jnp.einsum('bhqk,bhkv->bhqv', a, v)

    out = lax.map(step, (qs, jnp.arange(nq)))
    return jnp.moveaxis(out, 0, 2).reshape(B, H, S, v.shape[-1])


def moba_attention(q, k, v):
    B, H, S, dh = q.shape
    nb = -(-S // MOBA_BLOCK)
    ng = max(nb, MOBA_TOPK)
    sp = nb * MOBA_BLOCK
    pad = ((0, 0), (0, 0), (0, sp - S), (0, 0))
    kp = jnp.pad(k, pad)
    vp = jnp.pad(v, pad)
    kblk = kp.reshape(B, H, nb, MOBA_BLOCK, dh)
    vblk = vp.reshape(B, H, nb, MOBA_BLOCK, dh)
    kmean = jnp.mean(kblk.astype(F32), axis=3)
    kmean = jnp.pad(kmean, ((0, 0), (0, 0), (0, ng - nb), (0, 0)))
    scale = dh ** -0.5
    nstep = S // MOBA_Q_STEP
    qs = jnp.moveaxis(q.reshape(B, H, nstep, MOBA_Q_STEP, dh), 2, 0)
    bi = jnp.arange(B)[:, None, None, None]
    hi = jnp.arange(H)[None, :, None, None]
    nsel = MOBA_TOPK * MOBA_BLOCK

    def step(args):
        qi, j = args
        qpos = j * MOBA_Q_STEP + jnp.arange(MOBA_Q_STEP)
        own = (j * MOBA_Q_STEP) // MOBA_BLOCK
        gate = jnp.einsum('bhqd,bhnd->bhqn', qi.astype(F32), kmean)
        gate = jnp.where(jnp.arange(ng) < own, gate, -jnp.inf)
        _, sel = lax.top_k(gate, MOBA_TOPK)
        sel = jnp.minimum(sel, nb - 1)
        valid = jnp.arange(MOBA_TOPK) < jnp.minimum(own, MOBA_TOPK)
        k_sel = kblk[bi, hi, sel]
        v_sel = vblk[bi, hi, sel]
        s_sel = jnp.einsum('bhqd,bhqkpd->bhqkp', qi, k_sel).astype(F32) * scale
        s_sel = jnp.where(valid[:, None], s_sel, -jnp.inf).reshape(B, H, MOBA_Q_STEP, nsel)
        k_own = lax.dynamic_slice_in_dim(kp, own * MOBA_BLOCK, MOBA_BLOCK, axis=2)
        v_own = lax.dynamic_slice_in_dim(vp, own * MOBA_BLOCK, MOBA_BLOCK, axis=2)
        s_own = jnp.einsum('bhqd,bhpd->bhqp', qi, k_own).astype(F32) * scale
        kpos = own * MOBA_BLOCK + jnp.arange(MOBA_BLOCK)
        s_own = jnp.where(kpos[None, :] <= qpos[:, None], s_own, -jnp.inf)
        p = jax.nn.softmax(jnp.concatenate([s_sel, s_own], axis=-1), axis=-1).astype(v.dtype)
        p_sel = p[..., :nsel].reshape(B, H, MOBA_Q_STEP, MOBA_TOPK, MOBA_BLOCK)
        return (jnp.einsum('bhqkp,bhqkpv->bhqv', p_sel, v_sel)
                + jnp.einsum('bhqp,bhpv->bhqv', p[..., nsel:], v_own))

    out = lax.map(step, (qs, jnp.arange(nstep)))
    return jnp.moveaxis(out, 0, 2).reshape(B, H, S, dh)


def spatial_gating(u, v, ln_g, ln_b, w_s, b_s):
    B, S, _ = u.shape
    nc = S // SGU_CHUNK
    vf = v.astype(F32).reshape(B, S, SGU_GROUPS, SGU_CH)
    mu = jnp.mean(vf, axis=-1, keepdims=True)
    var = jnp.mean(jnp.square(vf - mu), axis=-1, keepdims=True)
    vn = ((vf - mu) * lax.rsqrt(var + EPS)).reshape(B, S, D_W) * ln_g.astype(F32) + ln_b.astype(F32)
    vn = vn.astype(v.dtype).reshape(B, nc, SGU_CHUNK, SGU_GROUPS, SGU_CH)
    w = jnp.where(jnp.tril(jnp.ones((SGU_CHUNK, SGU_CHUNK), bool)), w_s, 0.0)
    mixed = jnp.einsum('gpr,bcrgd->bcpgd', w, vn) + b_s.T[None, None, :, :, None]
    return u * mixed.reshape(B, S, D_W)


def even_mixer(h, positions, w_in, w_out, conv_w, conv_b, gate_b, mlstm_g, lam_vec, diff_g, lambda_init):
    B, S, _ = h.shape
    proj = h @ w_in
    sizes = [2 * A_QK, A_V, A_V, 2 * MLSTM_HEADS, B_QK, B_QK, B_V]
    cuts = [int(c) for c in np.cumsum(sizes)[:-1]]
    a_qk, a_v, a_o, a_gates, b_q, b_k, b_v = jnp.split(proj, cuts, axis=-1)
    qk = jax.nn.silu(causal_conv(a_qk, conv_w, conv_b))
    a_q = split_heads(qk[..., :A_QK], MLSTM_HEADS)
    a_k = split_heads(qk[..., A_QK:], MLSTM_HEADS)
    gates = (a_gates.reshape(B, S, 2, MLSTM_HEADS) + gate_b).transpose(2, 0, 3, 1)
    h_a = mlstm_chunkwise(a_q, a_k, split_heads(a_v, MLSTM_HEADS), gates[0], gates[1])
    h_a = merge_heads(rmsnorm(h_a, mlstm_g[:, None, :])) * jax.nn.sigmoid(a_o)
    cos, sin = rope_tables(positions, DIFF_DQK)
    cs, sn = cos[:, None, :, None], sin[:, None, :, None]
    bq = apply_rope(b_q.reshape(B, S, DIFF_HEADS, 2, DIFF_DQK).transpose(0, 2, 1, 3, 4), cs, sn)
    bk = apply_rope(b_k.reshape(B, S, DIFF_HEADS, 2, DIFF_DQK).transpose(0, 2, 1, 3, 4), cs, sn)
    lv = lam_vec.astype(F32)
    lam = jnp.exp(jnp.sum(lv[0] * lv[1])) - jnp.exp(jnp.sum(lv[2] * lv[3])) + lambda_init
    h_b = diff_attention(bq, bk, split_heads(b_v, DIFF_HEADS), lam)
    h_b = merge_heads(rmsnorm(h_b, diff_g[:, None, :]) * (1.0 - lambda_init))
    return jnp.concatenate([h_a, h_b], axis=-1) @ w_out


def odd_mixer(h, positions, w_in, w_out, ln_g, ln_b, sgu_w, sgu_b):
    proj = h @ w_in
    c_q, c_k, c_v, d_u, d_v = jnp.split(proj, [C_W, 2 * C_W, 3 * C_W, 3 * C_W + D_W], axis=-1)
    cos, sin = rope_tables(positions, MOBA_DH)
    cs, sn = cos[:, None], sin[:, None]
    cq = apply_rope(split_heads(c_q, MOBA_HEADS), cs, sn)
    ck = apply_rope(split_heads(c_k, MOBA_HEADS), cs, sn)
    h_c = merge_heads(moba_attention(cq, ck, split_heads(c_v, MOBA_HEADS)))
    h_d = spatial_gating(jax.nn.gelu(d_u), jax.nn.gelu(d_v), ln_g, ln_b, sgu_w, sgu_b)
    return jnp.concatenate([h_c, h_d], axis=-1) @ w_out


def peer(x, w_q, sub_keys, expert_u, expert_v):
    B, S, D = x.shape
    nblk = (B * S) // PEER_TOKEN_BLOCK

    def block(xb):
        q = (xb @ w_q).reshape(-1, PEER_HEADS, 2, PEER_DQ // 2)
        s = jnp.einsum('thcd,hcnd->thcn', q, sub_keys).astype(F32)
        s1, i1 = lax.top_k(s[:, :, 0], PEER_TOPK)
        s2, i2 = lax.top_k(s[:, :, 1], PEER_TOPK)
        cand = (s1[..., :, None] + s2[..., None, :]).reshape(-1, PEER_HEADS, PEER_TOPK * PEER_TOPK)
        cidx = (i1[..., :, None] * PEER_NKEYS + i2[..., None, :]).reshape(-1, PEER_HEADS, PEER_TOPK * PEER_TOPK)
        top_s, pos = lax.top_k(cand, PEER_TOPK)
        eidx = jnp.take_along_axis(cidx, pos, axis=-1)
        g = jax.nn.softmax(top_s, axis=-1)
        act = jax.nn.gelu(jnp.einsum('td,thkd->thk', xb, expert_u[eidx]).astype(F32))
        return jnp.einsum('thk,thkd->td', (g * act).astype(x.dtype), expert_v[eidx])

    out = lax.map(block, x.reshape(nblk, PEER_TOKEN_BLOCK, D))
    return out.reshape(B, S, D)


def setup_inputs(seed: int = 0) -> dict:
    key = jax.random.key(seed)
    ks = jax.random.split(key, 25)

    def nrm(k, shape, scale):
        return scale * jax.random.normal(k, shape, jnp.float32)

    def gain(k, shape):
        return 1.0 + nrm(k, shape, 0.02)

    offsets = jax.random.randint(ks[2], (BATCH, 1), 0, 1024, dtype=jnp.int32)
    positions = offsets + jnp.arange(SEQ, dtype=jnp.int32)[None, :]
    gate_base = jnp.stack([jnp.zeros((MLSTM_HEADS,), jnp.float32), jnp.linspace(3.0, 6.0, MLSTM_HEADS)])
    return {
        'x': nrm(ks[0], (BATCH, SEQ, D_MODEL), 1.0),
        'c': nrm(ks[1], (BATCH, D_MODEL), 1.0),
        'positions': positions,
        'mod_w': nrm(ks[3], (DEPTH, D_MODEL, 6 * D_MODEL), 0.5 * D_MODEL ** -0.5),
        'mod_b': nrm(ks[4], (DEPTH, 6 * D_MODEL), 0.02),
        'norm_g': gain(ks[5], (DEPTH, 2, D_MODEL)),
        'final_g': gain(ks[6], (D_MODEL,)),
        'even_w_in': nrm(ks[7], (N_EVEN, D_MODEL, EVEN_IN), D_MODEL ** -0.5),
        'even_w_out': nrm(ks[8], (N_EVEN, EVEN_OUT, D_MODEL), EVEN_OUT ** -0.5),
        'mlstm_conv_w': nrm(ks[9], (N_EVEN, CONV_W, 2 * A_QK), CONV_W ** -0.5),
        'mlstm_conv_b': nrm(ks[10], (N_EVEN, 2 * A_QK), 0.02),
        'mlstm_gate_b': gate_base[None] + nrm(ks[11], (N_EVEN, 2, MLSTM_HEADS), 0.1),
        'mlstm_head_g': gain(ks[12], (N_EVEN, MLSTM_HEADS, MLSTM_DV)),
        'diff_lambda': nrm(ks[13], (N_EVEN, 4, DIFF_DQK), 0.1),
        'diff_head_g': gain(ks[14], (N_EVEN, DIFF_HEADS, DIFF_DV)),
        'odd_w_in': nrm(ks[15], (N_ODD, D_MODEL, ODD_IN), D_MODEL ** -0.5),
        'odd_w_out': nrm(ks[16], (N_ODD, ODD_OUT, D_MODEL), ODD_OUT ** -0.5),
        'sgu_ln_g': gain(ks[17], (N_ODD, D_W)),
        'sgu_ln_b': nrm(ks[18], (N_ODD, D_W), 0.02),
        'sgu_w': nrm(ks[19], (N_ODD, SGU_GROUPS, SGU_CHUNK, SGU_CHUNK), SGU_CHUNK ** -0.5),
        'sgu_b': gain(ks[20], (N_ODD, SGU_GROUPS, SGU_CHUNK)),
        'peer_w_q': nrm(ks[21], (DEPTH, D_MODEL, PEER_HEADS * PEER_DQ), D_MODEL ** -0.5),
        'peer_sub_keys': nrm(ks[22], (DEPTH, PEER_HEADS, 2, PEER_NKEYS, PEER_DQ // 2), (PEER_DQ // 2) ** -0.5),
        'peer_u': nrm(ks[23], (DEPTH, PEER_N, D_MODEL), D_MODEL ** -0.5),
        'peer_v': nrm(ks[24], (DEPTH, PEER_N, D_MODEL), PEER_V_SCALE),
    }


def reference(x, c, positions, mod_w, mod_b, norm_g, final_g, even_w_in, even_w_out,
              mlstm_conv_w, mlstm_conv_b, mlstm_gate_b, mlstm_head_g, diff_lambda, diff_head_g,
              odd_w_in, odd_w_out, sgu_ln_g, sgu_ln_b, sgu_w, sgu_b,
              peer_w_q, peer_sub_keys, peer_u, peer_v):
    h = x
    c_act = jax.nn.silu(c)
    for layer in range(DEPTH):
        mod = c_act @ mod_w[layer] + mod_b[layer]
        sh1, sc1, g1, sh2, sc2, g2 = [m[:, None, :] for m in jnp.split(mod, 6, axis=-1)]
        hn = rmsnorm(h, norm_g[layer, 0]) * (1.0 + sc1) + sh1
        if layer % 2 == 0:
            e = layer // 2
            lambda_init = 0.8 - 0.6 * math.exp(-0.3 * layer)
            mix = even_mixer(hn, positions, even_w_in[e], even_w_out[e], mlstm_conv_w[e], mlstm_conv_b[e],
                             mlstm_gate_b[e], mlstm_head_g[e], diff_lambda[e], diff_head_g[e], lambda_init)
        else:
            o = layer // 2
            mix = odd_mixer(hn, positions, odd_w_in[o], odd_w_out[o], sgu_ln_g[o], sgu_ln_b[o],
                            sgu_w[o], sgu_b[o])
        h = h + g1 * mix
        hn = rmsnorm(h, norm_g[layer, 1]) * (1.0 + sc2) + sh2
        h = h + g2 * peer(hn, peer_w_q[layer], peer_sub_keys[layer], peer_u[layer], peer_v[layer])
    return rmsnorm(h, final_g)
```

```cpp
#include <hip/hip_runtime.h>
#include <hip/hip_cooperative_groups.h>
#include <cstdio>
#include <cstdint>
namespace cg = cooperative_groups;
#ifndef STOP_AFTER
#define STOP_AFTER 99
#define DUMP_STAGE 0
#endif
namespace pg8 {
#define PG8_LAS __attribute__((address_space(3)))
typedef unsigned short bf16_t;
typedef short bf16x8 __attribute__((ext_vector_type(8)));
typedef float f32x4 __attribute__((ext_vector_type(4)));
typedef unsigned u32x4 __attribute__((ext_vector_type(4)));
constexpr int BM = 256, BK = 64, HALF = 128, HTB = HALF * BK * 2  , STAGE_BYTES = 8 * HTB, NXCD = 8, WGM = 8;

__host__ __device__ __forceinline__ int lds_byte(int r, int c) { const int st = (r >> 4) * 2 + (c >> 5), rr = r & 15, cc = c & 31, ob = rr * 64 + cc * 2; return st * 1024 + (ob ^ (((ob >> 9) & 1) << 5)); }
__host__ __device__ __forceinline__ void stage_rc(int b, int& R, int& C) { const int st = b / 1024, sb = b % 1024, swz = sb ^ (((sb >> 9) & 1) << 5); R = (st >> 1) * 16 + swz / 64; C = (st & 1) * 32 + (swz % 64) / 2; }
__host__ __device__ __forceinline__ int perm32(int rho) { const int n = rho >> 4, i = rho & 15; return 8 * (i >> 2) + 4 * n + (i & 3); }

struct Unit { int pm, pn; };
struct Gemm { const bf16_t* A; const bf16_t* Bt; int M, N, K; };

struct StaticOrder {
    int nM, nN, nwg, G, c;
    __host__ __device__ void init(int M, int N, int G_, int c_) { nM = M / BM; nN = N / BM; nwg = nM * nN; G = G_; c = c_; }
    __host__ __device__ bool next(int i, Unit& u) const {
        const long L = (long)i * G + c; if (L >= nwg) return false;
        int wgid = (int)L; { const int q = nwg / NXCD, r = nwg % NXCD, xcd = wgid % NXCD, off = wgid / NXCD; wgid = (xcd < r ? xcd * (q + 1) : r * (q + 1) + (xcd - r) * q) + off; }
        const int nig = WGM * nN, gid = wgid / nig, fm = gid * WGM, gsz = (nM - fm) < WGM ? (nM - fm) : WGM;
        u.pm = fm + ((wgid % nig) % gsz); u.pn = (wgid % nig) / gsz; return true;
    }
    __device__ __forceinline__ void a_ready(const Unit&) const {}
    __device__ __forceinline__ void done(const Unit&) const {}
};
template <class Epi, class Sched, bool ALIGN_EPI = false, bool SP2 = false>
__device__ __forceinline__ void gemm_phase(PG8_LAS unsigned char* lds, const Gemm g, const Sched& S, const Epi& E) {
    const int tid = threadIdx.x, wid = __builtin_amdgcn_readfirstlane(tid >> 6), lane = tid & 63, wr = wid >> 2, wc = wid & 3, fr = lane & 15, fq = lane >> 4;
    const int K = g.K, nt = K / BK;
    unsigned voffA[2], voffB[2];
#pragma unroll
    for (int i = 0; i < 2; ++i) { int R, C; stage_rc(tid * 16 + i * 8192, R, C); const int Rb = Epi::PERM ? ((R & ~31) + perm32(R & 31)) : R;
        voffA[i] = (unsigned)(R * K + C) * 2u; voffB[i] = (unsigned)(Rb * K + C) * 2u; }
    const size_t kstep = (size_t)(BK * 2);
    const size_t hstep = (size_t)HALF * K * 2;
    const size_t tstep = 2 * hstep;
    const unsigned ldsw = (unsigned)wid * 1024u;
    const int aoff = lds_byte(wr * 64 + fr, fq * 8), boff = lds_byte(wc * 32 + fr, fq * 8);
#define PG8_SA(b, h) (((b) * 2 + (h)) * HTB)
#define PG8_SB(b, h) ((4 + (b) * 2 + (h)) * HTB)
#define PG8_STAGE(bufoff, gbase, voff) do { _Pragma("unroll") for (int _i = 0; _i < 2; ++_i) \
        __builtin_amdgcn_global_load_lds((const unsigned*)((const char*)(gbase) + (voff)[_i]), (PG8_LAS unsigned*)(lds + (bufoff) + ldsw + _i * 8192), 16, 0, 0); } while (0)
#define PG8_LDA(dst, b, h) do { _Pragma("unroll") for (int m = 0; m < 4; ++m) _Pragma("unroll") for (int k = 0; k < 2; ++k) dst[m][k] = *(const PG8_LAS bf16x8*)(lds + PG8_SA(b, h) + aoff + m * 2048 + k * 1024); } while (0)
#define PG8_LDB(dst, b, h) do { _Pragma("unroll") for (int n = 0; n < 2; ++n) _Pragma("unroll") for (int k = 0; k < 2; ++k) dst[n][k] = *(const PG8_LAS bf16x8*)(lds + PG8_SB(b, h) + boff + n * 2048 + k * 1024); } while (0)
#define PG8_MMA(ai, bj, At, Bt) do { __builtin_amdgcn_s_setprio(1); _Pragma("unroll") for (int m = 0; m < 4; ++m) _Pragma("unroll") for (int n = 0; n < 2; ++n) _Pragma("unroll") for (int k = 0; k < 2; ++k) \
        acc[ai][bj][m][n] = __builtin_amdgcn_mfma_f32_16x16x32_bf16(Bt[n][k], At[m][k], acc[ai][bj][m][n], 0, 0, 0); __builtin_amdgcn_s_setprio(0); } while (0)
#define PG8_WAIT_V(n) asm volatile("s_waitcnt vmcnt(" #n ")" ::: "memory")
#define PG8_WAIT_L(n) asm volatile("s_waitcnt lgkmcnt(" #n ")" ::: "memory")
#define PG8_BAR __builtin_amdgcn_s_barrier()
#define PG8_SCHED __builtin_amdgcn_sched_barrier(0)
    Unit cur, nxt; int ui = 0;
    if (!S.next(0, cur)) return;
    f32x4 acc[2][2][4][2];
#pragma unroll
    for (int a = 0; a < 2; ++a)
#pragma unroll
        for (int b = 0; b < 2; ++b)
#pragma unroll
            for (int m = 0; m < 4; ++m)
#pragma unroll
                for (int n = 0; n < 2; ++n) acc[a][b][m][n] = (f32x4){0.f, 0.f, 0.f, 0.f};
    bf16x8 At[4][2], B0[2][2], B1[2][2];
    const char* cA = (const char*)g.A + (size_t)cur.pm * tstep; const char* cB = (const char*)g.Bt + (size_t)cur.pn * tstep;
    S.a_ready(cur);
    if constexpr (SP2) {
        PG8_STAGE(PG8_SB(0, 0), cB, voffB); PG8_STAGE(PG8_SB(0, 1), cB + hstep, voffB); PG8_STAGE(PG8_SA(0, 0), cA, voffA); PG8_STAGE(PG8_SA(0, 1), cA + hstep, voffA);
        if (wr == 1) PG8_BAR;
        PG8_WAIT_V(2); PG8_BAR;
        PG8_STAGE(PG8_SB(1, 0), cB + kstep, voffB); PG8_STAGE(PG8_SA(1, 0), cA + kstep, voffA); PG8_STAGE(PG8_SB(1, 1), cB + hstep + kstep, voffB);
        PG8_WAIT_V(6); PG8_BAR;
    } else {
        PG8_STAGE(PG8_SB(0, 0), cB, voffB); PG8_STAGE(PG8_SA(0, 0), cA, voffA); PG8_STAGE(PG8_SB(0, 1), cB + hstep, voffB); PG8_STAGE(PG8_SA(0, 1), cA + hstep, voffA);
        if (wr == 1) PG8_BAR;
        PG8_WAIT_V(4); PG8_BAR;
        PG8_STAGE(PG8_SB(1, 0), cB + kstep, voffB); PG8_STAGE(PG8_SA(1, 0), cA + kstep, voffA); PG8_STAGE(PG8_SB(1, 1), cB + hstep + kstep, voffB);
        PG8_WAIT_V(6); PG8_BAR;
    }
    for (;;) {
        const bool has_next = S.next(ui + 1, nxt);
        const char* nA = has_next ? (const char*)g.A + (size_t)nxt.pm * tstep : cA; const char* nB = has_next ? (const char*)g.Bt + (size_t)nxt.pn * tstep : cB;
        for (int t = 0; t < nt; t += 2) {
            const bool last = (t == nt - 2);
            const char* a1 = cA + (size_t)(t + 1) * kstep;
            const char* a2 = last ? nA : cA + (size_t)(t + 2) * kstep; const char* b2 = last ? nB : cB + (size_t)(t + 2) * kstep;
            const char* a3 = a2 + kstep; const char* b3 = b2 + kstep;
            if (last && has_next) S.a_ready(nxt);
            if constexpr (SP2) {
            PG8_LDB(B0, 0, 0); PG8_LDB(B1, 0, 1); PG8_SCHED; PG8_LDA(At, 0, 0); PG8_STAGE(PG8_SA(1, 1), a1 + hstep, voffA);
            PG8_WAIT_V(8); PG8_WAIT_L(0); PG8_BAR; PG8_MMA(0, 0, At, B0); PG8_MMA(0, 1, At, B1); PG8_BAR; PG8_SCHED;
            PG8_LDA(At, 0, 1); PG8_STAGE(PG8_SB(0, 0), b2, voffB); PG8_STAGE(PG8_SB(0, 1), b2 + hstep, voffB); PG8_STAGE(PG8_SA(0, 0), a2, voffA);
            PG8_WAIT_V(8); PG8_WAIT_L(0); PG8_BAR; PG8_MMA(1, 0, At, B0); PG8_MMA(1, 1, At, B1); PG8_BAR; PG8_SCHED;
            PG8_LDB(B0, 1, 0); PG8_LDB(B1, 1, 1); PG8_SCHED; PG8_LDA(At, 1, 0); PG8_STAGE(PG8_SA(0, 1), a2 + hstep, voffA);
            PG8_WAIT_V(8); PG8_WAIT_L(0); PG8_BAR; PG8_MMA(0, 0, At, B0); PG8_MMA(0, 1, At, B1); PG8_BAR; PG8_SCHED;
            PG8_LDA(At, 1, 1); PG8_STAGE(PG8_SB(1, 0), b3, voffB); PG8_STAGE(PG8_SB(1, 1), b3 + hstep, voffB); PG8_STAGE(PG8_SA(1, 0), a3, voffA);
            PG8_WAIT_V(8); PG8_WAIT_L(0); PG8_BAR; PG8_MMA(1, 0, At, B0); PG8_MMA(1, 1, At, B1); PG8_BAR; PG8_SCHED;
            } else {
            PG8_LDB(B0, 0, 0); PG8_SCHED; PG8_LDA(At, 0, 0); PG8_STAGE(PG8_SA(1, 1), a1 + hstep, voffA);
            PG8_WAIT_L(8); PG8_BAR; PG8_WAIT_L(0); PG8_MMA(0, 0, At, B0); PG8_BAR; PG8_SCHED;
            PG8_LDB(B1, 0, 1); PG8_STAGE(PG8_SB(0, 0), b2, voffB);
            PG8_BAR; PG8_WAIT_L(0); PG8_MMA(0, 1, At, B1); PG8_BAR;
            PG8_LDA(At, 0, 1); PG8_STAGE(PG8_SA(0, 0), a2, voffA);
            PG8_BAR; PG8_WAIT_L(0); PG8_MMA(1, 0, At, B0); PG8_BAR; PG8_SCHED;
            PG8_STAGE(PG8_SB(0, 1), b2 + hstep, voffB);
            PG8_WAIT_V(6); PG8_BAR; PG8_MMA(1, 1, At, B1); PG8_BAR;
            PG8_LDB(B0, 1, 0); PG8_SCHED; PG8_LDA(At, 1, 0); PG8_STAGE(PG8_SA(0, 1), a2 + hstep, voffA);
            PG8_WAIT_L(8); PG8_BAR; PG8_WAIT_L(0); PG8_MMA(0, 0, At, B0); PG8_BAR; PG8_SCHED;
            PG8_LDB(B1, 1, 1); PG8_STAGE(PG8_SB(1, 0), b3, voffB);
            PG8_BAR; PG8_WAIT_L(0); PG8_MMA(0, 1, At, B1); PG8_BAR;
            PG8_LDA(At, 1, 1); PG8_STAGE(PG8_SA(1, 0), a3, voffA);
            PG8_BAR; PG8_WAIT_L(0); PG8_MMA(1, 0, At, B0); PG8_BAR; PG8_SCHED;
            PG8_STAGE(PG8_SB(1, 1), b3 + hstep, voffB);
            PG8_WAIT_V(6); PG8_BAR; PG8_MMA(1, 1, At, B1); PG8_BAR;
            }
        }
        if constexpr (ALIGN_EPI) { if (wr == 0) PG8_BAR; }
        if constexpr (!Epi::AFTER_DRAIN) { E(acc, cur, wr, wc, fr, fq); S.done(cur); }
        if (!has_next) break;
#pragma unroll
        for (int a = 0; a < 2; ++a)
#pragma unroll
            for (int b = 0; b < 2; ++b)
#pragma unroll
                for (int m = 0; m < 4; ++m)
#pragma unroll
                    for (int n = 0; n < 2; ++n) acc[a][b][m][n] = (f32x4){0.f, 0.f, 0.f, 0.f};
        cur = nxt; cA = nA; cB = nB; ++ui;
        if constexpr (ALIGN_EPI) { if (wr == 1) PG8_BAR; }
    }
    PG8_WAIT_V(0);
    if constexpr (!ALIGN_EPI) { if (wr == 0) PG8_BAR; }
    PG8_BAR;
    if constexpr (Epi::AFTER_DRAIN) { E.fused(acc, cur, wr, wc, fr, fq, lds, wid, lane); S.done(cur); }
#undef PG8_SA
#undef PG8_SB
#undef PG8_STAGE
#undef PG8_LDA
#undef PG8_LDB
#undef PG8_MMA
#undef PG8_WAIT_V
#undef PG8_WAIT_L
#undef PG8_BAR
#undef PG8_SCHED
}
}
#define LAS __attribute__((address_space(3)))
typedef unsigned short bf16_t;
typedef short bf16x8 __attribute__((ext_vector_type(8)));
typedef float f32x4 __attribute__((ext_vector_type(4)));
typedef unsigned u32x4 __attribute__((ext_vector_type(4)));
typedef unsigned u32x2 __attribute__((ext_vector_type(2)));

constexpr int NB = 4, SEQ = 4096, DM = 2048, NT = NB * SEQ;
constexpr int NTHREADS = 512;
constexpr int LDS_BYTES = 147456;
constexpr float EPS = 1e-6f;
constexpr int EVEN_IN_SRC = 6152, EVEN_IN = 6144, ODD_IN = 5120;

constexpr size_t MiB = 1048576;
constexpr size_t WS_MOD = 0;
constexpr size_t WS_MISC = 512 * 1024;
constexpr size_t WS_LF = 1 * MiB;
constexpr size_t WS_LI = WS_LF + 256 * 1024;
constexpr size_t WS_CHS = 2 * MiB;
constexpr size_t WS_NLOC = 2 * MiB + 512 * 1024;
constexpr size_t WS_KMEAN = 3 * MiB;
constexpr size_t WS_SK = 4 * MiB;
constexpr size_t WS_ROPE = 5 * MiB;
constexpr size_t WS_WIN0 = 8 * MiB;
constexpr size_t WS_WOUT0 = 32 * MiB;
constexpr size_t WS_WIN1 = 40 * MiB;
constexpr size_t WS_WOUT1 = 60 * MiB;
constexpr size_t WS_WQ0 = 68 * MiB;
constexpr size_t WS_WQ1 = 76 * MiB;
constexpr size_t WS_U = 84 * MiB;
constexpr size_t WS_V = 212 * MiB;
constexpr size_t WS_HN = 340 * MiB;
constexpr size_t WS_PROJ = 404 * MiB;
constexpr size_t WS_CAT = 596 * MiB;
constexpr size_t WS_QP = 660 * MiB;
constexpr size_t WS_QM = 724 * MiB;
constexpr size_t WS_KM = 740 * MiB;
constexpr size_t WS_VTM = 756 * MiB;
constexpr size_t WS_CLOC = 788 * MiB;
constexpr size_t WS_VTD = 820 * MiB;
constexpr size_t WS_END = 852 * MiB;

struct Params { const float* in[25]; float* out; unsigned char* ws; long long pad; };

__device__ __forceinline__ float bf_lo(unsigned w) { return __uint_as_float(w << 16); }
__device__ __forceinline__ float bf_hi(unsigned w) { return __uint_as_float(w & 0xffff0000u); }
__device__ __forceinline__ float bf2f(bf16_t h) { return __uint_as_float((unsigned)h << 16); }
typedef float f32x2_t __attribute__((ext_vector_type(2))); typedef __bf16 bf16x2_t __attribute__((ext_vector_type(2)));
__device__ __forceinline__ unsigned pk_bf16(float lo, float hi) { const f32x2_t v = {lo, hi}; const bf16x2_t b = __builtin_convertvector(v, bf16x2_t); return __builtin_bit_cast(unsigned, b); }
__device__ __forceinline__ bf16_t f2bf(float f) { return (bf16_t)(pk_bf16(f, 0.f) & 0xffffu); }
__device__ __forceinline__ float wave_sum(float v) {
#pragma unroll
    for (int o = 1; o < 64; o <<= 1) v += __shfl_xor(v, o);
    return v;
}
__device__ __forceinline__ float wave_max(float v) {
#pragma unroll
    for (int o = 1; o < 64; o <<= 1) v = fmaxf(v, __shfl_xor(v, o));
    return v;
}
__device__ __forceinline__ float sigmoidf_(float a) { return 1.f / (1.f + __expf(-a)); }
__device__ __forceinline__ float gelu_tanh(float x) { const float z = 0.7978845608f * (x + 0.044715f * x * x * x); return x / (1.f + __expf(-2.f * z)); }
__device__ __forceinline__ f32x4 mfma16(bf16x8 a, bf16x8 b, f32x4 c) { return __builtin_amdgcn_mfma_f32_16x16x32_bf16(a, b, c, 0, 0, 0); }
__device__ __forceinline__ void unpack8(u32x4 w, float* f) {
    f[0] = bf_lo(w.x); f[1] = bf_hi(w.x); f[2] = bf_lo(w.y); f[3] = bf_hi(w.y); f[4] = bf_lo(w.z); f[5] = bf_hi(w.z); f[6] = bf_lo(w.w); f[7] = bf_hi(w.w);
}
__device__ __forceinline__ u32x4 pack8(const float* f) { u32x4 w; w.x = pk_bf16(f[0], f[1]); w.y = pk_bf16(f[2], f[3]); w.z = pk_bf16(f[4], f[5]); w.w = pk_bf16(f[6], f[7]); return w; }

struct EpiStoreBf16 {
    static constexpr bool PERM = true, AFTER_DRAIN = false;
    bf16_t* O; int ldc;
    __device__ __forceinline__ void operator()(const f32x4 (&acc)[2][2][4][2], const pg8::Unit& u, int wr, int wc, int fr, int fq) const {
        const int row0 = u.pm * 256 + wr * 64 + fr, col0 = u.pn * 256 + wc * 32 + 8 * fq;
#pragma unroll
        for (int ai = 0; ai < 2; ++ai)
#pragma unroll
            for (int m = 0; m < 4; ++m) { bf16_t* rowp = O + (size_t)(row0 + ai * 128 + m * 16) * ldc + col0;
#pragma unroll
                for (int bj = 0; bj < 2; ++bj) { const f32x4 v0 = acc[ai][bj][m][0], v1 = acc[ai][bj][m][1];
                    u32x4 w; w.x = pk_bf16(v0[0], v0[1]); w.y = pk_bf16(v0[2], v0[3]); w.z = pk_bf16(v1[0], v1[1]); w.w = pk_bf16(v1[2], v1[3]);
                    *(u32x4*)(rowp + bj * 128) = w; } }
    }
};
struct EpiResid {
    static constexpr bool PERM = true, AFTER_DRAIN = false;
    const float* hin; float* hout; const float* gate;
    __device__ __forceinline__ void operator()(const f32x4 (&acc)[2][2][4][2], const pg8::Unit& u, int wr, int wc, int fr, int fq) const {
        const int row0 = u.pm * 256 + wr * 64 + fr, col0 = u.pn * 256 + wc * 32 + 8 * fq;
        const float* gp = gate + (size_t)((u.pm * 256) / SEQ) * 12288 + col0;
        f32x4 gv[2][2];
#pragma unroll
        for (int bj = 0; bj < 2; ++bj) { gv[bj][0] = *(const f32x4*)(gp + bj * 128); gv[bj][1] = *(const f32x4*)(gp + bj * 128 + 4); }
#pragma unroll
        for (int ai = 0; ai < 2; ++ai)
#pragma unroll
            for (int m = 0; m < 4; ++m) { const size_t off = (size_t)(row0 + ai * 128 + m * 16) * DM + col0;
#pragma unroll
                for (int bj = 0; bj < 2; ++bj)
#pragma unroll
                    for (int n = 0; n < 2; ++n) { const f32x4 hi = *(const f32x4*)(hin + off + bj * 128 + 4 * n);
                        *(f32x4*)(hout + off + bj * 128 + 4 * n) = hi + gv[bj][n] * acc[ai][bj][m][n]; } }
    }
};

__device__ __forceinline__ void rms_mod_row(const float* src, const float* ng, const float* sc, const float* sh, bf16_t* dst, int lane, f32x4 (&v)[8]) {
    const f32x4* xr = (const f32x4*)src + lane; float s = 0.f;
#pragma unroll
    for (int j = 0; j < 8; ++j) { v[j] = xr[64 * j]; s += (v[j][0] * v[j][0] + v[j][1] * v[j][1]) + (v[j][2] * v[j][2] + v[j][3] * v[j][3]); }
    const float r = rsqrtf(wave_sum(s) * (1.f / DM) + EPS);
    u32x2* o8 = (u32x2*)dst + lane;
#pragma unroll
    for (int j = 0; j < 8; ++j) {
        const f32x4 g = ((const f32x4*)ng)[lane + 64 * j], a = ((const f32x4*)sc)[lane + 64 * j], b = ((const f32x4*)sh)[lane + 64 * j];
        v[j] = v[j] * r * g * (a + 1.f) + b;
        u32x2 w; w.x = pk_bf16(v[j][0], v[j][1]); w.y = pk_bf16(v[j][2], v[j][3]); o8[64 * j] = w;
    }
}

__device__ __forceinline__ void p0_transpose_item(const float* W, int ldw, int c0, int k0, bf16_t* WT, int n0, LAS float* scr, int lane) {
#pragma unroll 8
    for (int i = 0; i < 32; ++i) { const int kk = 2 * i + (lane >> 5); scr[kk * 33 + (lane & 31)] = W[(size_t)(k0 + kk) * ldw + c0 + (lane & 31)]; }
    asm volatile("s_waitcnt lgkmcnt(0)" ::: "memory");
    const int c = lane & 7;
#pragma unroll
    for (int j = 0; j < 4; ++j) { const int n = (lane >> 3) + 8 * j; const LAS float* s = scr + (8 * c) * 33 + n;
        u32x4 o; o.x = pk_bf16(s[0 * 33], s[1 * 33]); o.y = pk_bf16(s[2 * 33], s[3 * 33]); o.z = pk_bf16(s[4 * 33], s[5 * 33]); o.w = pk_bf16(s[6 * 33], s[7 * 33]);
        *(u32x4*)(WT + (size_t)(n0 + n) * 2048 + k0 + 8 * c) = o; }
    asm volatile("s_waitcnt lgkmcnt(0)" ::: "memory");
}

__device__ __forceinline__ void phase0a(const Params& p, LAS unsigned char* lds, int tid, int lane, int wave) {
    unsigned char* ws = p.ws;
    const int gw = blockIdx.x * 8 + wave, NGW = gridDim.x * 8;
    const int gt = blockIdx.x * NTHREADS + tid, NGT = gridDim.x * NTHREADS;
    {
        LAS float* scr = (LAS float*)(lds + wave * 8704);
        constexpr int NB0 = 192, NB1 = 64, NB2 = 160, NB3 = 64, NB4 = 64, NB5 = 64, NBT = NB0 + NB1 + NB2 + NB3 + NB4 + NB5;
        for (int it = gw; it < 32 * NBT; it += NGW) {
            const int kb = it / NBT; int nb = it % NBT; const int k0 = kb * 64;
            if (nb < NB0) { const int n0 = nb * 32; p0_transpose_item(p.in[7], EVEN_IN_SRC, n0 + (n0 >= 3072 ? 8 : 0), k0, (bf16_t*)(ws + WS_WIN0), n0, scr, lane); continue; } nb -= NB0;
            if (nb < NB1) { p0_transpose_item(p.in[8], 2048, nb * 32, k0, (bf16_t*)(ws + WS_WOUT0), nb * 32, scr, lane); continue; } nb -= NB1;
            if (nb < NB2) { p0_transpose_item(p.in[15], ODD_IN, nb * 32, k0, (bf16_t*)(ws + WS_WIN1), nb * 32, scr, lane); continue; } nb -= NB2;
            if (nb < NB3) { p0_transpose_item(p.in[16], 2048, nb * 32, k0, (bf16_t*)(ws + WS_WOUT1), nb * 32, scr, lane); continue; } nb -= NB3;
            if (nb < NB4) { p0_transpose_item(p.in[21], 2048, nb * 32, k0, (bf16_t*)(ws + WS_WQ0), nb * 32, scr, lane); continue; } nb -= NB4;
            p0_transpose_item(p.in[21] + (size_t)2048 * 2048, 2048, nb * 32, k0, (bf16_t*)(ws + WS_WQ1), nb * 32, scr, lane);
        }
    }
    {
        const size_t n8 = (size_t)2 * 16384 * 2048 / 8;
        const f32x4* su = (const f32x4*)p.in[23]; const f32x4* sv = (const f32x4*)p.in[24];
        u32x4* du = (u32x4*)(ws + WS_U); u32x4* dv = (u32x4*)(ws + WS_V);
        for (size_t i = gt; i < n8; i += NGT) {
            const f32x4 a = su[2 * i], b = su[2 * i + 1], c = sv[2 * i], d = sv[2 * i + 1];
            u32x4 w; w.x = pk_bf16(a[0], a[1]); w.y = pk_bf16(a[2], a[3]); w.z = pk_bf16(b[0], b[1]); w.w = pk_bf16(b[2], b[3]); du[i] = w;
            u32x4 z; z.x = pk_bf16(c[0], c[1]); z.y = pk_bf16(c[2], c[3]); z.z = pk_bf16(d[0], d[1]); z.w = pk_bf16(d[2], d[3]); dv[i] = z;
        }
        const size_t k8 = (size_t)2 * 8 * 2 * 128 * 128 / 8;
        const f32x4* sk = (const f32x4*)p.in[22]; u32x4* dk = (u32x4*)(ws + WS_SK);
        for (size_t i = gt; i < k8; i += NGT) { const f32x4 a = sk[2 * i], b = sk[2 * i + 1];
            u32x4 w; w.x = pk_bf16(a[0], a[1]); w.y = pk_bf16(a[2], a[3]); w.z = pk_bf16(b[0], b[1]); w.w = pk_bf16(b[2], b[3]); dk[i] = w; }
    }
    {
        const int* pos = (const int*)p.in[2]; float* tab = (float*)(ws + WS_ROPE);
        for (int i = gt; i < NT * 24; i += NGT) {
            const int t = i / 24, j = i % 24;
            const float e = (j < 8) ? (float)j * (1.f / 8.f) : (float)(j - 8) * (1.f / 16.f);
            const float inv = exp2f(-e * 18.931568569324174f);
            const float ang = (float)pos[t] * inv;
            float sn, cs; sincosf(ang, &sn, &cs);
            tab[2 * i] = cs; tab[2 * i + 1] = sn;
        }
    }
    {
        const float* cin = p.in[1]; float* mod = (float*)(ws + WS_MOD);
        LAS float* part = (LAS float*)(lds + 73728);
        for (int it = blockIdx.x; it < 96; it += gridDim.x) {
            const int ng = it % 48, l = it / 48;
            const int n0 = ng * 256 + 4 * lane;
            f32x4 acc[4];
#pragma unroll
            for (int b = 0; b < 4; ++b) acc[b] = (f32x4){0.f, 0.f, 0.f, 0.f};
#pragma unroll 1
            for (int kc = 0; kc < 4; ++kc) {
                const int k0 = wave * 256 + kc * 64;
                float ca[4];
#pragma unroll
                for (int b = 0; b < 4; ++b) { const float cv = cin[b * DM + k0 + lane]; ca[b] = cv * sigmoidf_(cv); }
                const float* wp = p.in[3] + ((size_t)l * DM + k0) * 12288 + n0;
#pragma unroll 8
                for (int kk = 0; kk < 64; ++kk) {
                    const f32x4 w = *(const f32x4*)(wp + (size_t)kk * 12288);
#pragma unroll
                    for (int b = 0; b < 4; ++b) acc[b] += w * __shfl(ca[b], kk);
                }
            }
#pragma unroll
            for (int b = 0; b < 4; ++b) *(LAS f32x4*)(part + (wave * 4 + b) * 256 + 4 * lane) = acc[b];
            __syncthreads();
#pragma unroll
            for (int i = 0; i < 2; ++i) { const int o = tid + NTHREADS * i, b = o >> 8, col = o & 255;
                float sm = p.in[4][l * 12288 + ng * 256 + col];
#pragma unroll
                for (int w = 0; w < 8; ++w) sm += part[(w * 4 + b) * 256 + col];
                mod[((size_t)l * 4 + b) * 12288 + ng * 256 + col] = sm; }
            __syncthreads();
        }
    }
    if (blockIdx.x == 0 && wave == 0) {
        const float* lv = p.in[13];
        const float a = wave_sum(lv[lane] * lv[64 + lane]), b = wave_sum(lv[128 + lane] * lv[192 + lane]);
        if (lane == 0) ((float*)(ws + WS_MISC))[0] = __expf(a) - __expf(b) + 0.2f;
    }
}

__device__ __forceinline__ void phase0b(const Params& p, LAS unsigned char* lds, int tid, int lane, int wave) {
    unsigned char* ws = p.ws;
    LAS float* wg = (LAS float*)lds;
    for (int i = tid; i < 8 * DM; i += NTHREADS) { const int k = i >> 3, j = i & 7; wg[j * DM + k] = p.in[7][(size_t)k * EVEN_IN_SRC + 3072 + j]; }
    __syncthreads();
    const int gw = blockIdx.x * 8 + wave, NGW = gridDim.x * 8;
    const float* mod = (const float*)(ws + WS_MOD);
    float* lf = (float*)(ws + WS_LF); float* li = (float*)(ws + WS_LI);
    for (int m = gw; m < NT; m += NGW) {
        const int b = m / SEQ, s = m % SEQ;
        f32x4 v[8];
        rms_mod_row(p.in[0] + (size_t)m * DM, p.in[5], mod + (size_t)b * 12288 + 2048, mod + (size_t)b * 12288, (bf16_t*)(ws + WS_HN) + (size_t)m * DM, lane, v);
        float mine = 0.f;
#pragma unroll 1
        for (int jg = 0; jg < 8; ++jg) { float a = 0.f;
#pragma unroll
            for (int j = 0; j < 8; ++j) { const f32x4 w = *(const LAS f32x4*)(wg + jg * DM + 4 * lane + 256 * j); a += (v[j][0] * w[0] + v[j][1] * w[1]) + (v[j][2] * w[2] + v[j][3] * w[3]); }
            a = wave_sum(a); if (lane == jg) mine = a; }
        float ip = mine, fp = __shfl(mine, (lane & 3) + 4);
        if (lane < 4) {
            const int h = lane;
            ip += p.in[11][h]; fp += p.in[11][4 + h];
            const float lsg = (fp >= 0.f) ? -log1pf(__expf(-fp)) : fp - log1pf(__expf(fp));
            lf[((size_t)b * 4 + h) * SEQ + s] = lsg; li[((size_t)b * 4 + h) * SEQ + s] = ip;
        }
    }
}

__device__ __forceinline__ void phase_norm(const Params& p, const float* hsrc, const float* ng, const float* modl  , int sc_off, int sh_off, int lane, int wave) {
    const int gw = blockIdx.x * 8 + wave, NGW = gridDim.x * 8;
    for (int m = gw; m < NT; m += NGW) {
        const int b = m / SEQ; f32x4 v[8];
        rms_mod_row(hsrc + (size_t)m * DM, ng, modl + (size_t)b * 12288 + sc_off, modl + (size_t)b * 12288 + sh_off, (bf16_t*)(p.ws + WS_HN) + (size_t)m * DM, lane, v);
    }
}
__device__ __forceinline__ void transpose_64x128(const bf16_t* src, size_t ld_src, bf16_t* dst, size_t ld_dst, LAS unsigned char* T  , int tid) {
#pragma unroll
    for (int i = 0; i < 2; ++i) { const int id = tid + NTHREADS * i, row = id >> 4, ch = id & 15;
        const u32x4 w = *(const u32x4*)(src + (size_t)row * ld_src + ch * 8);
        LAS bf16_t* tp = (LAS bf16_t*)(T + (8 * ch) * 144 + row * 2);
        tp[0 * 72] = (bf16_t)(w.x & 0xffffu); tp[1 * 72] = (bf16_t)(w.x >> 16); tp[2 * 72] = (bf16_t)(w.y & 0xffffu); tp[3 * 72] = (bf16_t)(w.y >> 16);
        tp[4 * 72] = (bf16_t)(w.z & 0xffffu); tp[5 * 72] = (bf16_t)(w.z >> 16); tp[6 * 72] = (bf16_t)(w.w & 0xffffu); tp[7 * 72] = (bf16_t)(w.w >> 16); }
    __syncthreads();
#pragma unroll
    for (int i = 0; i < 2; ++i) { const int id = tid + NTHREADS * i, v = id >> 3, c = id & 7;
        *(u32x4*)(dst + (size_t)v * ld_dst + c * 8) = *(const LAS u32x4*)(T + v * 144 + c * 16); }
    __syncthreads();
}

__device__ __forceinline__ void diff_post_item(const Params& p, LAS unsigned char* lds, int item, int tid) {
    const int blk = item & 15, h = (item >> 4) & 7, b = item >> 7;
    bf16_t* proj = (bf16_t*)(p.ws + WS_PROJ);
    const float* tab = (const float*)(p.ws + WS_ROPE);
    const size_t row0 = (size_t)b * SEQ + blk * 256;
#pragma unroll
    for (int i = 0; i < 2; ++i) {
        const int id = tid + NTHREADS * i, tok = id >> 2, comp = id & 1, qk = (id >> 1) & 1;
        bf16_t* ptr = proj + (row0 + tok) * EVEN_IN + (qk ? 4096 : 3072) + h * 128 + comp * 64;
        const u32x4 w1 = *(const u32x4*)ptr, w2 = *(const u32x4*)(ptr + 8);
        float x1[8], x2[8], o1[8], o2[8]; unpack8(w1, x1); unpack8(w2, x2);
        const float* tb = tab + (row0 + tok) * 48;
#pragma unroll
        for (int e = 0; e < 8; ++e) { const float cs = tb[2 * e], sn = tb[2 * e + 1]; o1[e] = x1[e] * cs - x2[e] * sn; o2[e] = x2[e] * cs + x1[e] * sn; }
        *(u32x4*)ptr = pack8(o1); *(u32x4*)(ptr + 8) = pack8(o2);
    }
    bf16_t* vt = (bf16_t*)(p.ws + WS_VTD) + ((size_t)(b * 8 + h) * 128) * SEQ + blk * 256;
    for (int st = 0; st < 4; ++st)
        transpose_64x128(proj + (row0 + st * 64) * EVEN_IN + 5120 + h * 128, EVEN_IN, vt + st * 64, SEQ, lds, tid);
}

__device__ __forceinline__ void mlstm_cloc_unit(const Params& p, LAS unsigned char* lds, int unit, int tid, int lane, int wave) {
    const int c = unit & 31, h = (unit >> 5) & 3, b = unit >> 7, bh = b * 4 + h;
    unsigned char* ws = p.ws;
    const bf16_t* proj = (const bf16_t*)(ws + WS_PROJ);
    LAS unsigned char* Kt = lds;
    LAS unsigned char* Vt = lds + 34816;
    LAS float* sc = (LAS float*)(lds + 104448);
    const int s0 = c * 128;
    const float* lf = (const float*)(ws + WS_LF) + (size_t)bh * SEQ + s0;
    const float* li = (const float*)(ws + WS_LI) + (size_t)bh * SEQ + s0;
    if (wave == 0) {
        const float e0 = lf[2 * lane], e1 = lf[2 * lane + 1];
        float incl = e0 + e1;
#pragma unroll
        for (int o = 1; o < 64; o <<= 1) { const float t = __shfl_up(incl, o); if (lane >= o) incl += t; }
        const float g = __shfl(incl, 63);
        const float b0 = incl - e1, b1 = incl;
        const float a0 = g - b0 + li[2 * lane], a1 = g - b1 + li[2 * lane + 1];
        const float ml = wave_max(fmaxf(a0, a1));
        sc[2 * lane] = __expf(a0 - ml); sc[2 * lane + 1] = __expf(a1 - ml);
        if (lane == 0) { float* chs = (float*)(ws + WS_CHS) + (size_t)(bh * 32 + c) * 2; chs[0] = g; chs[1] = ml; }
    }
    __syncthreads();
    const float* cw = p.in[9]; const float* cb = p.in[10];
    bf16_t* Qm = (bf16_t*)(ws + WS_QM) + ((size_t)bh * SEQ + s0) * 128;
    bf16_t* Km = (bf16_t*)(ws + WS_KM) + ((size_t)bh * SEQ + s0) * 128;
#pragma unroll 1
    for (int i = 0; i < 8; ++i) {
        const int id = tid + NTHREADS * (i & 3), isk = i >> 2, s = id >> 4, dc = id & 15;
        const int col = isk * 512 + h * 128 + dc * 8;
        float y[8];
        { const f32x4 b0 = *(const f32x4*)(cb + col), b1 = *(const f32x4*)(cb + col + 4);
          y[0] = b0[0]; y[1] = b0[1]; y[2] = b0[2]; y[3] = b0[3]; y[4] = b1[0]; y[5] = b1[1]; y[6] = b1[2]; y[7] = b1[3]; }
#pragma unroll
        for (int w = 0; w < 4; ++w) {
            const int ts = s0 + s - 3 + w;
            if (ts >= 0) {
                const u32x4 raw = *(const u32x4*)(proj + ((size_t)b * SEQ + ts) * EVEN_IN + col);
                float x[8]; unpack8(raw, x);
                const f32x4 w0 = *(const f32x4*)(cw + w * 1024 + col), w1 = *(const f32x4*)(cw + w * 1024 + col + 4);
                y[0] += x[0] * w0[0]; y[1] += x[1] * w0[1]; y[2] += x[2] * w0[2]; y[3] += x[3] * w0[3];
                y[4] += x[4] * w1[0]; y[5] += x[5] * w1[1]; y[6] += x[6] * w1[2]; y[7] += x[7] * w1[3];
            }
        }
#pragma unroll
        for (int e = 0; e < 8; ++e) y[e] = y[e] * sigmoidf_(y[e]);
        if (!isk) {
#pragma unroll
            for (int e = 0; e < 8; ++e) y[e] *= 0.08838834764831845f;
            *(u32x4*)(Qm + (size_t)s * 128 + dc * 8) = pack8(y);
        } else {
            *(u32x4*)(Km + (size_t)s * 128 + dc * 8) = pack8(y);
            const float wsv = sc[s];
            LAS bf16_t* kp = (LAS bf16_t*)(Kt + (dc * 8) * 272 + s * 2);
#pragma unroll
            for (int e = 0; e < 8; ++e) kp[e * 136] = f2bf(y[e] * wsv);
        }
    }
#pragma unroll 1
    for (int i = 0; i < 8; ++i) {
        const int id = tid + NTHREADS * i, s = id >> 5, vc = id & 31;
        const u32x4 w = *(const u32x4*)(proj + ((size_t)b * SEQ + s0 + s) * EVEN_IN + 1024 + h * 256 + vc * 8);
        LAS bf16_t* vp = (LAS bf16_t*)(Vt + (vc * 8) * 272 + s * 2);
        vp[0 * 136] = (bf16_t)(w.x & 0xffffu); vp[1 * 136] = (bf16_t)(w.x >> 16); vp[2 * 136] = (bf16_t)(w.y & 0xffffu); vp[3 * 136] = (bf16_t)(w.y >> 16);
        vp[4 * 136] = (bf16_t)(w.z & 0xffffu); vp[5 * 136] = (bf16_t)(w.z >> 16); vp[6 * 136] = (bf16_t)(w.w & 0xffffu); vp[7 * 136] = (bf16_t)(w.w >> 16);
    }
    __syncthreads();
    bf16_t* Vtm = (bf16_t*)(ws + WS_VTM) + ((size_t)bh * 256) * SEQ + s0;
#pragma unroll 1
    for (int i = 0; i < 8; ++i) { const int id = tid + NTHREADS * i, v = id >> 4, ch = id & 15;
        *(u32x4*)(Vtm + (size_t)v * SEQ + ch * 8) = *(const LAS u32x4*)(Vt + v * 272 + ch * 16); }
    if (tid < 128) { float a = 0.f;
#pragma unroll
        for (int ch = 0; ch < 16; ++ch) { float f[8]; unpack8(*(const LAS u32x4*)(Kt + tid * 272 + ch * 16), f); a += ((f[0] + f[1]) + (f[2] + f[3])) + ((f[4] + f[5]) + (f[6] + f[7])); }
        ((float*)(ws + WS_NLOC))[(size_t)(bh * 32 + c) * 128 + tid] = a; }
    const int r16 = lane & 15, g = lane >> 4;
    f32x4 acc[8][2];
#pragma unroll
    for (int db = 0; db < 8; ++db) { acc[db][0] = (f32x4){0.f, 0.f, 0.f, 0.f}; acc[db][1] = (f32x4){0.f, 0.f, 0.f, 0.f}; }
#pragma unroll
    for (int ks = 0; ks < 4; ++ks) {
        bf16x8 vf[2];
#pragma unroll
        for (int j = 0; j < 2; ++j) vf[j] = *(const LAS bf16x8*)(Vt + (16 * (2 * wave + j) + r16) * 272 + (4 * ks + g) * 16);
#pragma unroll
        for (int db = 0; db < 8; ++db) { const bf16x8 kf = *(const LAS bf16x8*)(Kt + (16 * db + r16) * 272 + (4 * ks + g) * 16);
            acc[db][0] = mfma16(kf, vf[0], acc[db][0]); acc[db][1] = mfma16(kf, vf[1], acc[db][1]); }
    }
    bf16_t* Cl = (bf16_t*)(ws + WS_CLOC) + (size_t)(bh * 32 + c) * 256 * 128;
#pragma unroll
    for (int db = 0; db < 8; ++db)
#pragma unroll
        for (int j = 0; j < 2; ++j) { const int v = 16 * (2 * wave + j) + r16;
            u32x2 w; w.x = pk_bf16(acc[db][j][0], acc[db][j][1]); w.y = pk_bf16(acc[db][j][2], acc[db][j][3]);
            *(u32x2*)(Cl + (size_t)v * 128 + 16 * db + 4 * g) = w; }
    __syncthreads();
}

constexpr int ATT_KROW = 272, ATT_VROW = 144, ATT_KBYTES = 64 * ATT_KROW, ATT_BUF = ATT_KBYTES + 128 * ATT_VROW, ATT_EXTRA = 2 * ATT_BUF;
template <int MODE>
__device__ __forceinline__ void attn_unit(LAS unsigned char* lds, const bf16_t* Qb, const bf16_t* Kb, int ld, const bf16_t* Vt, int j,
                                          const float* kmean  , bf16_t* outp, const float* gvec  , float lam,
                                          int tid, int lane, int wave) {
    constexpr int NC = (MODE == 0) ? 2 : 1;
    constexpr float CS = ((MODE == 0) ? 0.125f : 0.08838834764831845f) * 1.4426950408889634f;
    const int r16 = lane & 15, g = lane >> 4;
    const int q0 = j * 128, qpos = q0 + 16 * wave + r16;
    const int own = j >> 1, half = j & 1;
    const int nown = (MODE == 0) ? 0 : 2 + 2 * half;
    const int ntiles = (MODE == 0) ? 2 * (j + 1) : nown + 4 * own;
    bf16x8 qf[4];
#pragma unroll
    for (int ks = 0; ks < 4; ++ks) qf[ks] = *(const bf16x8*)(Qb + (size_t)qpos * ld + 32 * ks + 8 * g);
    unsigned sel = 0;
    if (MODE == 1) {
        LAS float* km = (LAS float*)(lds + ATT_EXTRA);
        for (int i = tid; i < 16 * 128; i += NTHREADS) km[i] = kmean[i];
        __syncthreads();
        float qv[32];
#pragma unroll
        for (int ks = 0; ks < 4; ++ks) { float f[8]; unpack8(__builtin_bit_cast(u32x4, qf[ks]), f);
#pragma unroll
            for (int e = 0; e < 8; ++e) qv[8 * ks + e] = f[e]; }
        float gate[15]; float t1 = -INFINITY, t2 = -INFINITY, t3 = -INFINITY;
#pragma unroll
        for (int n = 0; n < 15; ++n) {
            gate[n] = -INFINITY;
            if (n < own) {
                float a = 0.f;
#pragma unroll
                for (int ks = 0; ks < 4; ++ks) { const f32x4 k0 = *(const LAS f32x4*)(km + n * 128 + 32 * ks + 8 * g), k1 = *(const LAS f32x4*)(km + n * 128 + 32 * ks + 8 * g + 4);
                    a += (qv[8 * ks + 0] * k0[0] + qv[8 * ks + 1] * k0[1]) + (qv[8 * ks + 2] * k0[2] + qv[8 * ks + 3] * k0[3])
                       + (qv[8 * ks + 4] * k1[0] + qv[8 * ks + 5] * k1[1]) + (qv[8 * ks + 6] * k1[2] + qv[8 * ks + 7] * k1[3]); }
                a += __shfl_xor(a, 16); a += __shfl_xor(a, 32);
                gate[n] = a;
                float v = a; const float n1 = fmaxf(t1, v); v = fminf(t1, v); t1 = n1; const float n2 = fmaxf(t2, v); v = fminf(t2, v); t2 = n2; t3 = fmaxf(t3, v);
            }
        }
        const float theta = (own >= 3) ? t3 : -INFINITY;
#pragma unroll
        for (int n = 0; n < 15; ++n) if (n < own && gate[n] >= theta) sel |= 1u << n;
    }
    f32x4 O[NC][8];
#pragma unroll
    for (int c = 0; c < NC; ++c)
#pragma unroll
        for (int vb = 0; vb < 8; ++vb) O[c][vb] = (f32x4){0.f, 0.f, 0.f, 0.f};
    float mrun[NC], lsum[NC];
#pragma unroll
    for (int c = 0; c < NC; ++c) { mrun[c] = -INFINITY; lsum[c] = 0.f; }

    auto key0_of = [&](int t) -> int { if (MODE == 0) return 64 * t; if (t < nown) return own * 256 + 64 * t; const int tt = t - nown; return (tt >> 2) * 256 + 64 * (tt & 3); };
    u32x4 kreg[2], vreg[2];
    auto load_tile = [&](int t) { const int k0 = key0_of(t);
#pragma unroll
        for (int i = 0; i < 2; ++i) { const int id = tid + NTHREADS * i;
            kreg[i] = *(const u32x4*)(Kb + (size_t)(k0 + (id >> 4)) * ld + (id & 15) * 8);
            vreg[i] = *(const u32x4*)(Vt + (size_t)(id >> 3) * SEQ + k0 + (id & 7) * 8); } };
    auto store_tile = [&](int buf) { LAS unsigned char* base = lds + buf * ATT_BUF;
#pragma unroll
        for (int i = 0; i < 2; ++i) { const int id = tid + NTHREADS * i;
            *(LAS u32x4*)(base + (id >> 4) * ATT_KROW + (id & 15) * 16) = kreg[i];
            *(LAS u32x4*)(base + ATT_KBYTES + (id >> 3) * ATT_VROW + (id & 7) * 16) = vreg[i]; } };
    load_tile(0); store_tile(0);
    __syncthreads();
    if (ntiles > 1) load_tile(1);
    const int qlo = q0 + 16 * wave;
    const int krow_base = (8 * (r16 >> 2) + (r16 & 3)) * ATT_KROW + g * 16;
    for (int t = 0; t < ntiles; ++t) {
        const int k0 = key0_of(t);
        const LAS unsigned char* kb_ = lds + (t & 1) * ATT_BUF;
        const LAS unsigned char* vb_ = kb_ + ATT_KBYTES;
        bool causal, active = true; bool lane_on = true;
        if (MODE == 0) { causal = (k0 + 63 > qlo); active = (k0 <= qlo + 15); }
        else if (t < nown) { causal = true; active = (k0 <= qlo + 15); }
        else { causal = false; const int n = (t - nown) >> 2; lane_on = (sel >> n) & 1u; active = __any(lane_on); }
        if (active) {
#pragma unroll
            for (int c = 0; c < NC; ++c) {
                f32x4 s[2][2];
#pragma unroll
                for (int kg = 0; kg < 2; ++kg)
#pragma unroll
                    for (int kb = 0; kb < 2; ++kb) {
                        f32x4 a = (f32x4){0.f, 0.f, 0.f, 0.f};
                        const LAS unsigned char* kr = kb_ + krow_base + (32 * kg + 4 * kb) * ATT_KROW;
#pragma unroll
                        for (int ks = 0; ks < (MODE == 0 ? 2 : 4); ++ks) { const int kk = (MODE == 0) ? 2 * c + ks : ks;
                            a = mfma16(*(const LAS bf16x8*)(kr + kk * 64), qf[kk], a); }
                        s[kg][kb] = a;
                    }
                if (causal) {
#pragma unroll
                    for (int kg = 0; kg < 2; ++kg)
#pragma unroll
                        for (int kb = 0; kb < 2; ++kb)
#pragma unroll
                            for (int e = 0; e < 4; ++e) if (k0 + 32 * kg + 8 * g + 4 * kb + e > qpos) s[kg][kb][e] = -INFINITY;
                }
                if (MODE == 1 && !lane_on) {
#pragma unroll
                    for (int kg = 0; kg < 2; ++kg)
#pragma unroll
                        for (int kb = 0; kb < 2; ++kb) s[kg][kb] = (f32x4){-INFINITY, -INFINITY, -INFINITY, -INFINITY};
                }
                float tm = -INFINITY;
#pragma unroll
                for (int kg = 0; kg < 2; ++kg)
#pragma unroll
                    for (int kb = 0; kb < 2; ++kb) tm = fmaxf(tm, fmaxf(fmaxf(s[kg][kb][0], s[kg][kb][1]), fmaxf(s[kg][kb][2], s[kg][kb][3])));
                tm = fmaxf(tm, __shfl_xor(tm, 16)); tm = fmaxf(tm, __shfl_xor(tm, 32));
                const float mn = fmaxf(mrun[c], tm);
                const float alpha = __builtin_amdgcn_exp2f((mrun[c] - mn) * CS);
                const float mc = mn * CS;
                mrun[c] = mn;
                float ps = 0.f;
                bf16x8 pk[2];
#pragma unroll
                for (int kg = 0; kg < 2; ++kg) {
                    float pe[8];
#pragma unroll
                    for (int kb = 0; kb < 2; ++kb)
#pragma unroll
                        for (int e = 0; e < 4; ++e) { const float pv = __builtin_amdgcn_exp2f(s[kg][kb][e] * CS - mc); pe[4 * kb + e] = pv; ps += pv; }
                    pk[kg] = __builtin_bit_cast(bf16x8, pack8(pe));
                }
                lsum[c] = lsum[c] * alpha + ps;
#pragma unroll
                for (int vb = 0; vb < 8; ++vb) { O[c][vb] *= alpha;
#pragma unroll
                    for (int kg = 0; kg < 2; ++kg)
                        O[c][vb] = mfma16(*(const LAS bf16x8*)(vb_ + (16 * vb + r16) * ATT_VROW + (4 * kg + g) * 16), pk[kg], O[c][vb]); }
                __builtin_amdgcn_sched_barrier(0);
            }
        }
        if (t + 1 < ntiles) store_tile((t + 1) & 1);
        if (t + 2 < ntiles) load_tile(t + 2);
        __syncthreads();
    }
    float linv[NC];
#pragma unroll
    for (int c = 0; c < NC; ++c) { float l = lsum[c]; l += __shfl_xor(l, 16); l += __shfl_xor(l, 32); linv[c] = 1.f / l; }
    if (MODE == 0) {
        const float i0 = linv[0], i1 = lam * linv[1];
        float ss = 0.f; f32x4 y[8];
#pragma unroll
        for (int vb = 0; vb < 8; ++vb) { y[vb] = O[0][vb] * i0 - O[NC - 1][vb] * i1; ss += (y[vb][0] * y[vb][0] + y[vb][1] * y[vb][1]) + (y[vb][2] * y[vb][2] + y[vb][3] * y[vb][3]); }
        ss += __shfl_xor(ss, 16); ss += __shfl_xor(ss, 32);
        const float r = rsqrtf(ss * (1.f / 128.f) + EPS) * 0.8f;
#pragma unroll
        for (int vb = 0; vb < 8; ++vb) { const f32x4 gv = *(const f32x4*)(gvec + 16 * vb + 4 * g); const f32x4 o = y[vb] * r * gv;
            u32x2 w; w.x = pk_bf16(o[0], o[1]); w.y = pk_bf16(o[2], o[3]);
            *(u32x2*)(outp + (size_t)qpos * DM + 16 * vb + 4 * g) = w; }
    } else {
#pragma unroll
        for (int vb = 0; vb < 8; ++vb) { const f32x4 o = O[0][vb] * linv[0];
            u32x2 w; w.x = pk_bf16(o[0], o[1]); w.y = pk_bf16(o[2], o[3]);
            *(u32x2*)(outp + (size_t)qpos * DM + 16 * vb + 4 * g) = w; }
    }
}

__device__ __forceinline__ int swz256(int row, int ch) { return row * 256 + ((ch ^ (row & 15)) << 4); }
__device__ __forceinline__ void mlstm_out_unit(const Params& p, LAS unsigned char* lds, int unit, int tid, int lane, int wave) {
    const int c = unit & 31, h = (unit >> 5) & 3, b = unit >> 7, bh = b * 4 + h;
    unsigned char* ws = p.ws;
    LAS unsigned char* Cp = lds;
    LAS unsigned char* Vt = lds + 65536;
    LAS float* sc = (LAS float*)(lds + 131072);
    const int s0 = c * 128;
    const float* chs = (const float*)(ws + WS_CHS) + (size_t)bh * 64;
    if (wave == 0) {
        float mp = 0.f;
        if (lane == 0) {
            for (int i = 0; i < c; ++i) mp = fmaxf(chs[2 * i] + mp, chs[2 * i + 1]);
            float gs = 0.f;
            for (int i = c - 1; i >= 0; --i) { sc[i] = __expf(chs[2 * i + 1] + gs - mp); gs += chs[2 * i]; }
            sc[544] = mp;
        }
        mp = __shfl(mp, 0);
        const float* lf = (const float*)(ws + WS_LF) + (size_t)bh * SEQ + s0;
        const float* li = (const float*)(ws + WS_LI) + (size_t)bh * SEQ + s0;
        const float e0 = lf[2 * lane], e1 = lf[2 * lane + 1];
        float incl = e0 + e1;
#pragma unroll
        for (int o = 1; o < 64; o <<= 1) { const float t = __shfl_up(incl, o); if (lane >= o) incl += t; }
        const float b0 = incl - e1, b1 = incl;
        const float u0 = li[2 * lane] - b0, u1 = li[2 * lane + 1] - b1;
        float cm = fmaxf(u0, u1);
#pragma unroll
        for (int o = 1; o < 64; o <<= 1) { const float t = __shfl_up(cm, o); if (lane >= o) cm = fmaxf(cm, t); }
        float pm = __shfl_up(cm, 1); if (lane == 0) pm = -INFINITY;
        sc[160 + 2 * lane] = b0; sc[160 + 2 * lane + 1] = b1;
        sc[288 + 2 * lane] = u0; sc[288 + 2 * lane + 1] = u1;
        sc[416 + 2 * lane] = fmaxf(mp, fmaxf(pm, u0)); sc[416 + 2 * lane + 1] = fmaxf(mp, cm);
    }
    __syncthreads();
    {
        float a[64];
#pragma unroll
        for (int i = 0; i < 64; ++i) a[i] = 0.f;
        const bf16_t* Cl = (const bf16_t*)(ws + WS_CLOC) + (size_t)bh * 32 * 32768;
        for (int cc = 0; cc < c; ++cc) {
            const float cf = sc[cc];
            const bf16_t* src = Cl + (size_t)cc * 32768;
#pragma unroll
            for (int i = 0; i < 8; ++i) { const int id = tid + NTHREADS * i; float f[8]; unpack8(*(const u32x4*)(src + (size_t)id * 8), f);
#pragma unroll
                for (int e = 0; e < 8; ++e) a[8 * i + e] += cf * f[e]; }
        }
#pragma unroll
        for (int i = 0; i < 8; ++i) { const int id = tid + NTHREADS * i; *(LAS u32x4*)(Cp + swz256(id >> 4, id & 15)) = pack8(a + 8 * i); }
        if (tid < 128) { float n = 0.f; const float* nl = (const float*)(ws + WS_NLOC) + (size_t)bh * 32 * 128 + tid;
            for (int cc = 0; cc < c; ++cc) n += sc[cc] * nl[cc * 128];
            sc[32 + tid] = n; }
        const bf16_t* Vtm = (const bf16_t*)(ws + WS_VTM) + ((size_t)bh * 256) * SEQ + s0;
#pragma unroll
        for (int i = 0; i < 8; ++i) { const int id = tid + NTHREADS * i, v = id >> 4, ch = id & 15;
            *(LAS u32x4*)(Vt + swz256(v, ch)) = *(const u32x4*)(Vtm + (size_t)v * SEQ + ch * 8); }
    }
    __syncthreads();
    const int r16 = lane & 15, g = lane >> 4;
    const int tl = 16 * wave + r16;
    const float mprev = sc[544], Mt = sc[416 + tl], bc = sc[160 + tl];
    const float winter = __expf(mprev - Mt);
    const bf16_t* Qm = (const bf16_t*)(ws + WS_QM) + ((size_t)bh * SEQ + s0) * 128;
    const bf16_t* Km = (const bf16_t*)(ws + WS_KM) + ((size_t)bh * SEQ + s0) * 128;
    bf16x8 qf[4];
#pragma unroll
    for (int ks = 0; ks < 4; ++ks) qf[ks] = *(const bf16x8*)(Qm + (size_t)tl * 128 + 32 * ks + 8 * g);
    f32x4 acc[16];
#pragma unroll
    for (int vb = 0; vb < 16; ++vb) acc[vb] = (f32x4){0.f, 0.f, 0.f, 0.f};
    float den = 0.f;
    if (c > 0) {
#pragma unroll
        for (int vb = 0; vb < 16; ++vb) {
#pragma unroll
            for (int ks = 0; ks < 4; ++ks) acc[vb] = mfma16(*(const LAS bf16x8*)(Cp + swz256(16 * vb + r16, 4 * ks + g)), qf[ks], acc[vb]);
            acc[vb] *= winter;
        }
        float qn = 0.f;
#pragma unroll
        for (int ks = 0; ks < 4; ++ks) { float f[8]; unpack8(__builtin_bit_cast(u32x4, qf[ks]), f);
#pragma unroll
            for (int e = 0; e < 8; ++e) qn += f[e] * sc[32 + 32 * ks + 8 * g + e]; }
        qn += __shfl_xor(qn, 16); qn += __shfl_xor(qn, 32);
        den = winter * qn * 0.25f;
    }
    const int nsb = (wave >> 1) + 1;
    for (int sb = 0; sb < nsb; ++sb) {
        f32x4 sv[2];
#pragma unroll
        for (int kb = 0; kb < 2; ++kb) {
            f32x4 a = (f32x4){0.f, 0.f, 0.f, 0.f};
            const bf16_t* kr = Km + (size_t)(32 * sb + 8 * (r16 >> 2) + 4 * kb + (r16 & 3)) * 128 + 8 * g;
#pragma unroll
            for (int ks = 0; ks < 4; ++ks) a = mfma16(*(const bf16x8*)(kr + 32 * ks), qf[ks], a);
            sv[kb] = a;
        }
        float pe[8];
#pragma unroll
        for (int kb = 0; kb < 2; ++kb)
#pragma unroll
            for (int e = 0; e < 4; ++e) { const int s = 32 * sb + 8 * g + 4 * kb + e;
                const float w = (s <= tl) ? __expf(sc[288 + s] - Mt) : 0.f; const float x = sv[kb][e] * w; pe[4 * kb + e] = x; den += x; }
        const bf16x8 pf = __builtin_bit_cast(bf16x8, pack8(pe));
#pragma unroll
        for (int vb = 0; vb < 16; ++vb) acc[vb] = mfma16(*(const LAS bf16x8*)(Vt + swz256(16 * vb + r16, 4 * sb + g)), pf, acc[vb]);
    }
    den += __shfl_xor(den, 16); den += __shfl_xor(den, 32);
    const float dinv = 1.f / fmaxf(fabsf(den), __expf(-(bc + Mt)));
    float ss = 0.f;
#pragma unroll
    for (int vb = 0; vb < 16; ++vb) { acc[vb] *= dinv; ss += (acc[vb][0] * acc[vb][0] + acc[vb][1] * acc[vb][1]) + (acc[vb][2] * acc[vb][2] + acc[vb][3] * acc[vb][3]); }
    ss += __shfl_xor(ss, 16); ss += __shfl_xor(ss, 32);
    const float r = rsqrtf(ss * (1.f / 256.f) + EPS);
    const size_t trow = (size_t)b * SEQ + s0 + tl;
    const bf16_t* ao = (const bf16_t*)(ws + WS_PROJ) + trow * EVEN_IN + 2048 + h * 256;
    bf16_t* outp = (bf16_t*)(ws + WS_CAT) + trow * DM + h * 256;
    const float* hg = p.in[12] + h * 256;
#pragma unroll
    for (int vb = 0; vb < 16; ++vb) { const int v = 16 * vb + 4 * g;
        const u32x2 aw = *(const u32x2*)(ao + v); const f32x4 gv = *(const f32x4*)(hg + v);
        const float o0 = acc[vb][0] * r * gv[0] * sigmoidf_(bf_lo(aw.x)), o1 = acc[vb][1] * r * gv[1] * sigmoidf_(bf_hi(aw.x));
        const float o2 = acc[vb][2] * r * gv[2] * sigmoidf_(bf_lo(aw.y)), o3 = acc[vb][3] * r * gv[3] * sigmoidf_(bf_hi(aw.y));
        u32x2 w; w.x = pk_bf16(o0, o1); w.y = pk_bf16(o2, o3); *(u32x2*)(outp + v) = w; }
    __syncthreads();
}
__device__ __forceinline__ void moba_post_item(const Params& p, LAS unsigned char* lds, int item, int tid) {
    const int blk = item & 15, h = (item >> 4) & 7, b = item >> 7;
    bf16_t* proj = (bf16_t*)(p.ws + WS_PROJ);
    const float* tab = (const float*)(p.ws + WS_ROPE);
    const size_t row0 = (size_t)b * SEQ + blk * 256;
    {
        const int dc = tid & 15, tg = tid >> 4;
        float a[8];
#pragma unroll
        for (int e = 0; e < 8; ++e) a[e] = 0.f;
        for (int tt = 0; tt < 8; ++tt) {
            const size_t row = row0 + tg * 8 + tt;
            const bf16_t* kp = proj + row * ODD_IN + 1024 + h * 128;
            float x[8]; unpack8(*(const u32x4*)(kp + dc * 8), x);
            if (dc < 4) {
                float y[8]; unpack8(*(const u32x4*)(kp + (dc ^ 2) * 8), y);
                const float* tb = tab + row * 48 + 16 + 16 * (dc & 1);
#pragma unroll
                for (int e = 0; e < 8; ++e) { const float cs = tb[2 * e], sn = tb[2 * e + 1];
                    x[e] = (dc < 2) ? (x[e] * cs - y[e] * sn) : (x[e] * cs + y[e] * sn); }
            }
#pragma unroll
            for (int e = 0; e < 8; ++e) a[e] += x[e];
        }
        LAS float* part = (LAS float*)lds;
#pragma unroll
        for (int e = 0; e < 8; ++e) part[tg * 128 + dc * 8 + e] = a[e];
        __syncthreads();
        if (tid < 128) { float s = 0.f;
#pragma unroll 8
            for (int i = 0; i < 32; ++i) s += part[i * 128 + tid];
            ((float*)(p.ws + WS_KMEAN))[((size_t)(b * 8 + h) * 16 + blk) * 128 + tid] = s * (1.f / 256.f); }
        __syncthreads();
    }
    {
        const int tok = tid >> 1, qk = tid & 1;
        bf16_t* ptr = proj + (row0 + tok) * ODD_IN + qk * 1024 + h * 128;
        float x1[16], x2[16], o1[16], o2[16];
        unpack8(*(const u32x4*)ptr, x1); unpack8(*(const u32x4*)(ptr + 8), x1 + 8); unpack8(*(const u32x4*)(ptr + 16), x2); unpack8(*(const u32x4*)(ptr + 24), x2 + 8);
        const float* tb = tab + (row0 + tok) * 48 + 16;
#pragma unroll
        for (int e = 0; e < 16; ++e) { const float cs = tb[2 * e], sn = tb[2 * e + 1]; o1[e] = x1[e] * cs - x2[e] * sn; o2[e] = x2[e] * cs + x1[e] * sn; }
        *(u32x4*)ptr = pack8(o1); *(u32x4*)(ptr + 8) = pack8(o1 + 8); *(u32x4*)(ptr + 16) = pack8(o2); *(u32x4*)(ptr + 24) = pack8(o2 + 8);
    }
    bf16_t* vt = (bf16_t*)(p.ws + WS_VTD) + ((size_t)(b * 8 + h) * 128) * SEQ + blk * 256;
    for (int st = 0; st < 4; ++st)
        transpose_64x128(proj + (row0 + st * 64) * ODD_IN + 2048 + h * 128, ODD_IN, vt + st * 64, SEQ, lds, tid);
}

__device__ __forceinline__ void sgu_unit(const Params& p, LAS unsigned char* lds, int unit, int tid, int lane, int wave) {
    const int gq = unit & 7, c = (unit >> 3) & 31, b = unit >> 8;
    const bf16_t* proj = (const bf16_t*)(p.ws + WS_PROJ);
    LAS unsigned char* vnT = lds;
    const size_t row0 = (size_t)b * SEQ + c * 128;
    {
        const int pt = 16 * wave + (lane >> 2), sub = lane & 3;
        const bf16_t* src = proj + (row0 + pt) * ODD_IN + 4096 + gq * 128 + sub * 32;
        float x[32];
#pragma unroll
        for (int i = 0; i < 4; ++i) unpack8(*(const u32x4*)(src + 8 * i), x + 8 * i);
        float s1 = 0.f;
#pragma unroll
        for (int e = 0; e < 32; ++e) { x[e] = gelu_tanh(x[e]); s1 += x[e]; }
        s1 += __shfl_xor(s1, 1); s1 += __shfl_xor(s1, 2);
        const float mu = s1 * (1.f / 128.f);
        float s2 = 0.f;
#pragma unroll
        for (int e = 0; e < 32; ++e) { x[e] -= mu; s2 += x[e] * x[e]; }
        s2 += __shfl_xor(s2, 1); s2 += __shfl_xor(s2, 2);
        const float r = rsqrtf(s2 * (1.f / 128.f) + EPS);
        const float* lg = p.in[17] + gq * 128 + sub * 32; const float* lb = p.in[18] + gq * 128 + sub * 32;
        LAS bf16_t* dst = (LAS bf16_t*)(vnT + (sub * 32) * 272 + pt * 2);
#pragma unroll
        for (int e = 0; e < 32; ++e) dst[e * 136] = f2bf(x[e] * r * lg[e] + lb[e]);
    }
    __syncthreads();
    const int r16 = lane & 15, g = lane >> 4;
    const int prow = 16 * wave + r16;
    f32x4 acc[8];
#pragma unroll
    for (int db = 0; db < 8; ++db) acc[db] = (f32x4){0.f, 0.f, 0.f, 0.f};
    const float* W = p.in[19] + ((size_t)gq * 128 + prow) * 128;
    const int nrs = (wave >> 1) + 1;
    for (int rs = 0; rs < nrs; ++rs) {
        const int r0 = 32 * rs + 8 * g;
        const f32x4 w0 = *(const f32x4*)(W + r0), w1 = *(const f32x4*)(W + r0 + 4);
        float wf[8] = {w0[0], w0[1], w0[2], w0[3], w1[0], w1[1], w1[2], w1[3]};
#pragma unroll
        for (int e = 0; e < 8; ++e) if (r0 + e > prow) wf[e] = 0.f;
        const bf16x8 af = __builtin_bit_cast(bf16x8, pack8(wf));
#pragma unroll
        for (int db = 0; db < 8; ++db) acc[db] = mfma16(af, *(const LAS bf16x8*)(vnT + (16 * db + r16) * 272 + (4 * rs + g) * 16), acc[db]);
    }
    bf16_t* cat = (bf16_t*)(p.ws + WS_CAT);
#pragma unroll
    for (int e = 0; e < 4; ++e) {
        const int pr = 16 * wave + 4 * g + e; const float bs = p.in[20][gq * 128 + pr];
        const bf16_t* up = proj + (row0 + pr) * ODD_IN + 3072 + gq * 128;
        bf16_t* op = cat + (row0 + pr) * DM + 1024 + gq * 128;
#pragma unroll
        for (int db = 0; db < 8; ++db) { const int d = 16 * db + r16; op[d] = f2bf(gelu_tanh(bf2f(up[d])) * (acc[db][e] + bs)); }
    }
    __syncthreads();
}

__device__ __forceinline__ void ins16(float (&val)[16], float v) {
#pragma unroll
    for (int i = 0; i < 16; ++i) { const float hi = fmaxf(val[i], v); v = fminf(val[i], v); val[i] = hi; }
}
template <bool LAST>
__device__ __forceinline__ void peer_tile(const Params& p, LAS unsigned char* lds, int layer, int tile, int tid, int lane, int wave) {
    unsigned char* ws = p.ws;
    LAS unsigned* eL = (LAS unsigned*)lds;
    LAS float* wL = (LAS float*)(lds + 32768);
    const int r16 = lane & 15, g = lane >> 4;
    const size_t tok0 = (size_t)tile * 64;
    {
        const int tg = wave & 3, hs = wave >> 2;
        const bf16_t* qrow = (const bf16_t*)(ws + WS_QP) + (tok0 + 16 * tg + r16) * DM;
        const bf16_t* SK = (const bf16_t*)(ws + WS_SK) + (size_t)layer * 8 * 2 * 128 * 128;
#pragma unroll 1
        for (int hh = 0; hh < 4; ++hh) {
            const int h = 4 * hs + hh;
            float L[2][16];
#pragma unroll 1
            for (int c = 0; c < 2; ++c) {
                bf16x8 qf[4];
#pragma unroll
                for (int ks = 0; ks < 4; ++ks) qf[ks] = *(const bf16x8*)(qrow + h * 256 + c * 128 + 32 * ks + 8 * g);
                const bf16_t* skc = SK + (size_t)(h * 2 + c) * 128 * 128;
                float scv[32];
#pragma unroll
                for (int nb = 0; nb < 8; ++nb) {
                    f32x4 a = (f32x4){0.f, 0.f, 0.f, 0.f};
#pragma unroll
                    for (int ks = 0; ks < 4; ++ks) a = mfma16(*(const bf16x8*)(skc + (size_t)(16 * nb + r16) * 128 + 32 * ks + 8 * g), qf[ks], a);
#pragma unroll
                    for (int e = 0; e < 4; ++e) { const int n = 16 * nb + 4 * g + e;
                        scv[4 * nb + e] = __uint_as_float((__float_as_uint(a[e]) & 0xffffff80u) | (unsigned)(127 - n)); }
                }
                float Lc[16];
#pragma unroll
                for (int k = 0; k < 16; ++k) {
                    float m = scv[0];
#pragma unroll
                    for (int i = 1; i < 32; ++i) m = fmaxf(m, scv[i]);
                    m = fmaxf(m, __shfl_xor(m, 16)); m = fmaxf(m, __shfl_xor(m, 32));
                    Lc[k] = m;
#pragma unroll
                    for (int i = 0; i < 32; ++i) scv[i] = (scv[i] == m) ? -INFINITY : scv[i];
                }
#pragma unroll
                for (int k = 0; k < 16; ++k) { if (c == 0) L[0][k] = Lc[k]; else L[1][k] = Lc[k]; }
            }
            float top[16];
#pragma unroll
            for (int k = 0; k < 16; ++k) top[k] = -INFINITY;
#pragma unroll
            for (int i = 0; i < 16; ++i)
#pragma unroll
                for (int jj = 0; jj < 16; ++jj)
                    if ((i + 1) * (jj + 1) <= 16) {
                        const float sm = L[0][i] + L[1][jj];
                        ins16(top, __uint_as_float((__float_as_uint(sm) & 0xffffff00u) | (unsigned)(i * 16 + jj)));
                    }
            const float mx = top[0]; float e16[16]; float se = 0.f;
#pragma unroll
            for (int k = 0; k < 16; ++k) { e16[k] = __expf(top[k] - mx); se += e16[k]; }
            const float inv = 1.f / se;
#pragma unroll
            for (int k = 0; k < 16; ++k) {
                const unsigned id = __float_as_uint(top[k]) & 0xffu; const unsigned ii = id >> 4, jj = id & 15u;
                unsigned b1 = 0, b2 = 0;
#pragma unroll
                for (int q = 0; q < 16; ++q) { b1 = (ii == (unsigned)q) ? __float_as_uint(L[0][q]) : b1; b2 = (jj == (unsigned)q) ? __float_as_uint(L[1][q]) : b2; }
                const unsigned ex = (127u - (b1 & 127u)) * 128u + (127u - (b2 & 127u));
                if (g == 0) { eL[(16 * tg + r16) * 128 + h * 16 + k] = ex; wL[(16 * tg + r16) * 128 + h * 16 + k] = e16[k] * inv; }
            }
        }
    }
    __syncthreads();
    const bf16_t* U = (const bf16_t*)(ws + WS_U) + (size_t)layer * 16384 * 2048;
    const bf16_t* V = (const bf16_t*)(ws + WS_V) + (size_t)layer * 16384 * 2048;
    const float* mod = (const float*)(ws + WS_MOD) + (size_t)layer * 4 * 12288;
#pragma unroll 1
    for (int tt = 0; tt < 8; ++tt) {
        const int tl = 8 * wave + tt; const size_t tok = tok0 + tl; const int b = (int)(tok / SEQ);
        float xf[32];
        { const bf16_t* xr = (const bf16_t*)(ws + WS_HN) + tok * DM + 8 * lane;
#pragma unroll
          for (int j = 0; j < 4; ++j) unpack8(*(const u32x4*)(xr + 512 * j), xf + 8 * j); }
        float acc[32];
#pragma unroll
        for (int i = 0; i < 32; ++i) acc[i] = 0.f;
#pragma unroll 1
        for (int eb = 0; eb < 32; ++eb) {
            unsigned ex[4];
#pragma unroll
            for (int q = 0; q < 4; ++q) ex[q] = eL[tl * 128 + 4 * eb + q];
            u32x4 ur[4][4], vr[4][4];
#pragma unroll
            for (int q = 0; q < 4; ++q)
#pragma unroll
                for (int j = 0; j < 4; ++j) ur[q][j] = *(const u32x4*)(U + (size_t)ex[q] * 2048 + 512 * j + 8 * lane);
            float pd[4];
#pragma unroll
            for (int q = 0; q < 4; ++q) { float a = 0.f;
#pragma unroll
                for (int j = 0; j < 4; ++j) { float f[8]; unpack8(ur[q][j], f);
#pragma unroll
                    for (int e = 0; e < 8; ++e) a += f[e] * xf[8 * j + e]; }
                pd[q] = a; }
            const bool hi = lane >= 32, b4 = (lane >> 4) & 1;
            float a = hi ? pd[2] : pd[0], as = hi ? pd[0] : pd[2]; a += __shfl_xor(as, 32);
            float bq = hi ? pd[3] : pd[1], bs = hi ? pd[1] : pd[3]; bq += __shfl_xor(bs, 32);
            float cq = b4 ? bq : a, cs = b4 ? a : bq; cq += __shfl_xor(cs, 16);
            cq += __shfl_xor(cq, 8); cq += __shfl_xor(cq, 4); cq += __shfl_xor(cq, 2); cq += __shfl_xor(cq, 1);
            const float wk = wL[tl * 128 + 4 * eb + (lane >> 4)] * gelu_tanh(cq);
            float wq[4];
#pragma unroll
            for (int q = 0; q < 4; ++q) wq[q] = __shfl(wk, 16 * q);
            __builtin_amdgcn_sched_barrier(0);
#pragma unroll
            for (int q = 0; q < 4; ++q)
#pragma unroll
                for (int j = 0; j < 4; ++j) vr[q][j] = *(const u32x4*)(V + (size_t)ex[q] * 2048 + 512 * j + 8 * lane);
#pragma unroll
            for (int q = 0; q < 4; ++q)
#pragma unroll
                for (int j = 0; j < 4; ++j) { float f[8]; unpack8(vr[q][j], f);
#pragma unroll
                    for (int e = 0; e < 8; ++e) acc[8 * j + e] += wq[q] * f[e]; }
        }
        float* hrow = p.out + tok * DM + 8 * lane;
        const float* g2 = mod + (size_t)b * 12288 + 10240 + 8 * lane;
        float hv[32]; float ss = 0.f;
#pragma unroll
        for (int j = 0; j < 4; ++j) {
            const f32x4 h0 = *(const f32x4*)(hrow + 512 * j), h1 = *(const f32x4*)(hrow + 512 * j + 4);
            const f32x4 g0 = *(const f32x4*)(g2 + 512 * j), g1 = *(const f32x4*)(g2 + 512 * j + 4);
#pragma unroll
            for (int e = 0; e < 4; ++e) { hv[8 * j + e] = h0[e] + g0[e] * acc[8 * j + e]; hv[8 * j + 4 + e] = h1[e] + g1[e] * acc[8 * j + 4 + e]; }
#pragma unroll
            for (int e = 0; e < 8; ++e) ss += hv[8 * j + e] * hv[8 * j + e];
        }
        const float r = rsqrtf(wave_sum(ss) * (1.f / DM) + EPS);
        if (LAST) {
            const float* fg = p.in[6] + 8 * lane;
#pragma unroll
            for (int j = 0; j < 4; ++j) { const f32x4 g0 = *(const f32x4*)(fg + 512 * j), g1 = *(const f32x4*)(fg + 512 * j + 4);
                f32x4 o0, o1;
#pragma unroll
                for (int e = 0; e < 4; ++e) { o0[e] = hv[8 * j + e] * r * g0[e]; o1[e] = hv[8 * j + 4 + e] * r * g1[e]; }
                *(f32x4*)(hrow + 512 * j) = o0; *(f32x4*)(hrow + 512 * j + 4) = o1; }
        } else {
            const float* modn = (const float*)(ws + WS_MOD) + (size_t)(layer + 1) * 4 * 12288 + (size_t)b * 12288 + 8 * lane;
            const float* ng = p.in[5] + (size_t)(layer + 1) * 2 * DM + 8 * lane;
            bf16_t* hn = (bf16_t*)(ws + WS_HN) + tok * DM + 8 * lane;
#pragma unroll
            for (int j = 0; j < 4; ++j) {
                f32x4 o0, o1;
#pragma unroll
                for (int e = 0; e < 4; ++e) { o0[e] = hv[8 * j + e]; o1[e] = hv[8 * j + 4 + e]; }
                *(f32x4*)(hrow + 512 * j) = o0; *(f32x4*)(hrow + 512 * j + 4) = o1;
                float y[8];
#pragma unroll
                for (int e = 0; e < 8; ++e) y[e] = hv[8 * j + e] * r * ng[512 * j + e] * (1.f + modn[2048 + 512 * j + e]) + modn[512 * j + e];
                *(u32x4*)(hn + 512 * j) = pack8(y);
            }
        }
    }
    __syncthreads();
}
template <class Epi>
__device__ __forceinline__ void run_gemm(LAS unsigned char* lds, const bf16_t* A, const bf16_t* Bt, int N, const Epi& E) {
    pg8::Gemm gm{A, Bt, NT, N, DM}; pg8::StaticOrder S; S.init(NT, N, (int)gridDim.x, (int)blockIdx.x);
    pg8::gemm_phase<Epi, pg8::StaticOrder, true, true>(lds, gm, S, E);
}


typedef __attribute__((address_space(4))) const unsigned char* karg_t;
__device__ __forceinline__ Params load_params() {
    int z; asm volatile("s_mov_b32 %0, 0" : "=s"(z));
    karg_t ka = (karg_t)__builtin_amdgcn_kernarg_segment_ptr() + z;
    Params q;
#pragma unroll
    for (int k = 0; k < 25; ++k) q.in[k] = *(const float* const __attribute__((address_space(4)))*)(ka + 8 * k);
    q.out = *(float* const __attribute__((address_space(4)))*)(ka + 200);
    q.ws = *(unsigned char* const __attribute__((address_space(4)))*)(ka + 208);
    q.pad = 0;
    return q;
}

#ifndef DUMP_STAGE
#define DUMP_STAGE 0
#endif
__device__ __forceinline__ void dump_bf16(float* out, const bf16_t* src, size_t ld) {
    for (size_t i = (size_t)blockIdx.x * NTHREADS + threadIdx.x; i < (size_t)NT * DM; i += (size_t)gridDim.x * NTHREADS) {
        const size_t t = i / DM, c = i % DM; float v = bf2f(src[t * ld + c]); if (!(v == v) || fabsf(v) > 1e30f) v = 1.0e4f; out[i] = v; }
}
__device__ __forceinline__ void dump_f32(float* out, const float* src, size_t n) {
    for (size_t i = (size_t)blockIdx.x * NTHREADS + threadIdx.x; i < (size_t)NT * DM; i += (size_t)gridDim.x * NTHREADS) out[i] = src[i % n];
}
#define DUMPF_AT(n, srcexpr, cnt) if (DUMP_STAGE == (n)) { const Params pd = load_params(); unsigned char* ws = pd.ws; dump_f32(pd.out, (const float*)(srcexpr), (cnt)); return; }
#define DUMP_AT(n, srcexpr, ld) if (DUMP_STAGE == (n)) { const Params pd = load_params(); unsigned char* ws = pd.ws; dump_bf16(pd.out, (const bf16_t*)(srcexpr), (ld)); return; }

__global__ void __launch_bounds__(NTHREADS, 2) fwd_megakernel(Params p_unused) {
    extern __shared__ __attribute__((aligned(16))) unsigned char lds_raw[];
    LAS unsigned char* lds = (LAS unsigned char*)lds_raw;
    cg::grid_group grid = cg::this_grid();
#define PHASE_BEGIN const Params p = load_params(); unsigned char* ws = p.ws; (void)ws; \
    int tid = threadIdx.x; asm volatile("" : "+v"(tid)); const int lane = tid & 63, wave = __builtin_amdgcn_readfirstlane(tid >> 6); (void)lane; (void)wave; \
    int bid = blockIdx.x, G = gridDim.x; asm volatile("" : "+s"(bid), "+s"(G));

    { PHASE_BEGIN phase0a(p, lds, tid, lane, wave); }
    grid.sync();
    { PHASE_BEGIN phase0b(p, lds, tid, lane, wave); }
    grid.sync();
    DUMP_AT(1, ws + WS_HN, DM)
    DUMPF_AT(10, ws + WS_LF, 131072)
    DUMPF_AT(12, ws + WS_MOD, 98304)
    DUMP_AT(2, ws + WS_WIN0, DM)
    { PHASE_BEGIN EpiStoreBf16 E{(bf16_t*)(ws + WS_PROJ), EVEN_IN}; run_gemm(lds, (const bf16_t*)(ws + WS_HN), (const bf16_t*)(ws + WS_WIN0), EVEN_IN, E); }
    grid.sync();
    DUMP_AT(3, ws + WS_PROJ, EVEN_IN)
    DUMP_AT(4, ws + WS_PROJ + 2 * 3072, EVEN_IN)
    { PHASE_BEGIN
      for (int it = bid; it < 1024; it += G) {
        if (it < 512) mlstm_cloc_unit(p, lds, it, tid, lane, wave); else diff_post_item(p, lds, it - 512, tid);
      } }
    grid.sync();
    DUMP_AT(5, ws + WS_PROJ + 2 * 3072, EVEN_IN)
    DUMP_AT(6, ws + WS_CLOC, DM)
    DUMPF_AT(11, ws + WS_CHS, 1024)
    DUMPF_AT(13, ws + WS_NLOC, 65536)
    DUMP_AT(7, ws + WS_VTD, DM)
    DUMP_AT(8, ws + WS_QM, DM)
    {
        PHASE_BEGIN
        const float lam = ((const float*)(ws + WS_MISC))[0];
        for (int pr = bid; pr < 512; pr += G) {
            const int bh = pr >> 4, jj = pr & 15, b = bh >> 3, h = bh & 7;
            const bf16_t* PROJ = (const bf16_t*)(ws + WS_PROJ);
            const bf16_t* Qb = PROJ + (size_t)b * SEQ * EVEN_IN + 3072 + h * 128;
            const bf16_t* Kb = PROJ + (size_t)b * SEQ * EVEN_IN + 4096 + h * 128;
            const bf16_t* Vt = (const bf16_t*)(ws + WS_VTD) + ((size_t)bh * 128) * SEQ;
            bf16_t* outp = (bf16_t*)(ws + WS_CAT) + (size_t)b * SEQ * DM + 1024 + h * 128;
#pragma unroll 1
            for (int rep = 0; rep < 2; ++rep)
                attn_unit<0>(lds, Qb, Kb, EVEN_IN, Vt, rep ? jj : 31 - jj, nullptr, outp, p.in[14] + h * 128, lam, tid, lane, wave);
        }
    }
    {
        PHASE_BEGIN
        for (int pr = bid; pr < 256; pr += G) {
            const int bh = pr >> 4, cc = pr & 15;
#pragma unroll 1
            for (int rep = 0; rep < 2; ++rep) mlstm_out_unit(p, lds, bh * 32 + (rep ? cc : 31 - cc), tid, lane, wave);
        }
    }
    grid.sync();
    DUMP_AT(9, ws + WS_CAT, DM)
    { PHASE_BEGIN EpiResid E{p.in[0], p.out, (const float*)(ws + WS_MOD) + 4096}; run_gemm(lds, (const bf16_t*)(ws + WS_CAT), (const bf16_t*)(ws + WS_WOUT0), DM, E); }
    grid.sync();
#if STOP_AFTER >= 2
    { PHASE_BEGIN phase_norm(p, p.out, p.in[5] + DM, (const float*)(ws + WS_MOD), 8192, 6144, lane, wave); }
    grid.sync();
    { PHASE_BEGIN EpiStoreBf16 E{(bf16_t*)(ws + WS_QP), DM}; run_gemm(lds, (const bf16_t*)(ws + WS_HN), (const bf16_t*)(ws + WS_WQ0), DM, E); }
    grid.sync();
    { PHASE_BEGIN for (int tile = bid; tile < 256; tile += G) peer_tile<false>(p, lds, 0, tile, tid, lane, wave); }
    grid.sync();
#endif
#if STOP_AFTER >= 3
    { PHASE_BEGIN EpiStoreBf16 E{(bf16_t*)(ws + WS_PROJ), ODD_IN}; run_gemm(lds, (const bf16_t*)(ws + WS_HN), (const bf16_t*)(ws + WS_WIN1), ODD_IN, E); }
    grid.sync();
    { PHASE_BEGIN
      for (int it = bid; it < 1536; it += G) {
        if (it < 512) moba_post_item(p, lds, it, tid); else sgu_unit(p, lds, it - 512, tid, lane, wave);
      } }
    grid.sync();
    { PHASE_BEGIN
      for (int pr = bid; pr < 512; pr += G) {
        const int bh = pr >> 4, jj = pr & 15, b = bh >> 3, h = bh & 7;
        const bf16_t* PROJ = (const bf16_t*)(ws + WS_PROJ);
        const bf16_t* Qb = PROJ + (size_t)b * SEQ * ODD_IN + h * 128;
        const bf16_t* Kb = PROJ + (size_t)b * SEQ * ODD_IN + 1024 + h * 128;
        const bf16_t* Vt = (const bf16_t*)(ws + WS_VTD) + ((size_t)bh * 128) * SEQ;
        const float* km = (const float*)(ws + WS_KMEAN) + (size_t)bh * 16 * 128;
        bf16_t* outp = (bf16_t*)(ws + WS_CAT) + (size_t)b * SEQ * DM + h * 128;
#pragma unroll 1
        for (int rep = 0; rep < 2; ++rep)
            attn_unit<1>(lds, Qb, Kb, ODD_IN, Vt, rep ? jj : 31 - jj, km, outp, nullptr, 0.f, tid, lane, wave);
      } }
    grid.sync();
    { PHASE_BEGIN EpiResid E{p.out, p.out, (const float*)(ws + WS_MOD) + 4 * 12288 + 4096}; run_gemm(lds, (const bf16_t*)(ws + WS_CAT), (const bf16_t*)(ws + WS_WOUT1), DM, E); }
    grid.sync();
#endif
#if STOP_AFTER >= 4
    { PHASE_BEGIN phase_norm(p, p.out, p.in[5] + 3 * DM, (const float*)(ws + WS_MOD) + 4 * 12288, 8192, 6144, lane, wave); }
    grid.sync();
    { PHASE_BEGIN EpiStoreBf16 E{(bf16_t*)(ws + WS_QP), DM}; run_gemm(lds, (const bf16_t*)(ws + WS_HN), (const bf16_t*)(ws + WS_WQ1), DM, E); }
    grid.sync();
    { PHASE_BEGIN for (int tile = bid; tile < 256; tile += G) peer_tile<true>(p, lds, 1, tile, tid, lane, wave); }
#else
    {
        PHASE_BEGIN
        const int gw = bid * 8 + wave, NGW = G * 8;
        for (int m = gw; m < NT; m += NGW) {
            float* hr = p.out + (size_t)m * DM;
            f32x4 v[8]; float s = 0.f;
#pragma unroll
            for (int j = 0; j < 8; ++j) { v[j] = ((const f32x4*)hr)[lane + 64 * j]; s += (v[j][0] * v[j][0] + v[j][1] * v[j][1]) + (v[j][2] * v[j][2] + v[j][3] * v[j][3]); }
            const float r = rsqrtf(wave_sum(s) * (1.f / DM) + EPS);
#pragma unroll
            for (int j = 0; j < 8; ++j) ((f32x4*)hr)[lane + 64 * j] = v[j] * r * ((const f32x4*)p.in[6])[lane + 64 * j];
        }
    }
#endif
}

extern "C" void kernel_launch(void* const* d_in, const int* in_sizes, int n_in, void* d_out, int out_size, void* d_ws, size_t ws_size,
                              hipStream_t stream) {
    static int grid_blocks = 0;
    if (!grid_blocks) {
        int dev = 0, cus = 0, per_cu = 0;
        (void)hipGetDevice(&dev);
        (void)hipDeviceGetAttribute(&cus, hipDeviceAttributeMultiprocessorCount, dev);
        (void)hipFuncSetAttribute((const void*)fwd_megakernel, hipFuncAttributeMaxDynamicSharedMemorySize, LDS_BYTES);
        (void)hipOccupancyMaxActiveBlocksPerMultiprocessor(&per_cu, (const void*)fwd_megakernel, NTHREADS, LDS_BYTES);
        if (per_cu < 1) { fprintf(stderr, "kernel_launch: occupancy query says %d blocks per CU\n", per_cu); per_cu = 1; }
        grid_blocks = cus;
        if (n_in != 25 || ws_size < WS_END) fprintf(stderr, "kernel_launch: unexpected n_in %d or ws_size %zu (< %zu)\n", n_in, ws_size, (size_t)WS_END);
    }
    Params p{};
    for (int i = 0; i < 25 && i < n_in; ++i) p.in[i] = (const float*)d_in[i];
    p.out = (float*)d_out; p.ws = (unsigned char*)d_ws;
    void* args[] = {&p};
    hipError_t e = hipLaunchCooperativeKernel((const void*)fwd_megakernel, dim3(grid_blocks), dim3(NTHREADS), args, LDS_BYTES, stream);
    if (e != hipSuccess) fprintf(stderr, "cooperative launch failed: %s (grid %d)\n", hipGetErrorString(e), grid_blocks);
}
```

```cpp
#include <hip/hip_runtime.h>
#include <hip/hip_cooperative_groups.h>
#include <cstdio>
#include <cstdint>
namespace cg = cooperative_groups;
namespace pg8 {
#define PG8_LAS __attribute__((address_space(3)))
typedef unsigned short bf16_t;
typedef short bf16x8 __attribute__((ext_vector_type(8)));
typedef float f32x4 __attribute__((ext_vector_type(4)));
typedef unsigned u32x4 __attribute__((ext_vector_type(4)));
constexpr int BM = 256, BK = 64, HALF = 128, HTB = HALF * BK * 2  , STAGE_BYTES = 8 * HTB, NXCD = 8, WGM = 8;

__host__ __device__ __forceinline__ int lds_byte(int r, int c) { const int st = (r >> 4) * 2 + (c >> 5), rr = r & 15, cc = c & 31, ob = rr * 64 + cc * 2; return st * 1024 + (ob ^ (((ob >> 9) & 1) << 5)); }
__host__ __device__ __forceinline__ void stage_rc(int b, int& R, int& C) { const int st = b / 1024, sb = b % 1024, swz = sb ^ (((sb >> 9) & 1) << 5); R = (st >> 1) * 16 + swz / 64; C = (st & 1) * 32 + (swz % 64) / 2; }
__host__ __device__ __forceinline__ int perm32(int rho) { const int n = rho >> 4, i = rho & 15; return 8 * (i >> 2) + 4 * n + (i & 3); }

struct Unit { int pm, pn; };
struct Gemm { const bf16_t* A; const bf16_t* Bt; int M, N, K; };

struct StaticOrder {
    int nM, nN, nwg, G, c;
    __host__ __device__ void init(int M, int N, int G_, int c_) { nM = M / BM; nN = N / BM; nwg = nM * nN; G = G_; c = c_; }
    __host__ __device__ bool next(int i, Unit& u) const {
        const long L = (long)i * G + c; if (L >= nwg) return false;
        int wgid = (int)L; { const int q = nwg / NXCD, r = nwg % NXCD, xcd = wgid % NXCD, off = wgid / NXCD; wgid = (xcd < r ? xcd * (q + 1) : r * (q + 1) + (xcd - r) * q) + off; }
        const int nig = WGM * nN, gid = wgid / nig, fm = gid * WGM, gsz = (nM - fm) < WGM ? (nM - fm) : WGM;
        u.pm = fm + ((wgid % nig) % gsz); u.pn = (wgid % nig) / gsz; return true;
    }
    __device__ __forceinline__ void a_ready(const Unit&) const {}
    __device__ __forceinline__ void done(const Unit&) const {}
};
template <class Epi, class Sched, bool ALIGN_EPI = false, bool SP2 = false>
__device__ __forceinline__ void gemm_phase(PG8_LAS unsigned char* lds, const Gemm g, const Sched& S, const Epi& E, const int tid) {
    const int wid = __builtin_amdgcn_readfirstlane(tid >> 6), lane = tid & 63, wr = wid >> 2, wc = wid & 3, fr = lane & 15, fq = lane >> 4;
    const int K = g.K, nt = K / BK;
    unsigned voffA[2], voffB[2];
#pragma unroll
    for (int i = 0; i < 2; ++i) { int R, C; stage_rc(tid * 16 + i * 8192, R, C); const int Rb = Epi::PERM ? ((R & ~31) + perm32(R & 31)) : R;
        voffA[i] = (unsigned)(R * K + C) * 2u; voffB[i] = (unsigned)(Rb * K + C) * 2u; }
    const size_t kstep = (size_t)(BK * 2);
    const size_t hstep = (size_t)HALF * K * 2;
    const size_t tstep = 2 * hstep;
    const unsigned ldsw = (unsigned)wid * 1024u;
    const int aoff = lds_byte(wr * 64 + fr, fq * 8), boff = lds_byte(wc * 32 + fr, fq * 8);
#define PG8_SA(b, h) (((b) * 2 + (h)) * HTB)
#define PG8_SB(b, h) ((4 + (b) * 2 + (h)) * HTB)
#define PG8_STAGE(bufoff, gbase, voff) do { _Pragma("unroll") for (int _i = 0; _i < 2; ++_i) \
        __builtin_amdgcn_global_load_lds((const unsigned*)((const char*)(gbase) + (voff)[_i]), (PG8_LAS unsigned*)(lds + (bufoff) + ldsw + _i * 8192), 16, 0, 0); } while (0)
#define PG8_LDA(dst, b, h) do { _Pragma("unroll") for (int m = 0; m < 4; ++m) _Pragma("unroll") for (int k = 0; k < 2; ++k) dst[m][k] = *(const PG8_LAS bf16x8*)(lds + PG8_SA(b, h) + aoff + m * 2048 + k * 1024); } while (0)
#define PG8_LDB(dst, b, h) do { _Pragma("unroll") for (int n = 0; n < 2; ++n) _Pragma("unroll") for (int k = 0; k < 2; ++k) dst[n][k] = *(const PG8_LAS bf16x8*)(lds + PG8_SB(b, h) + boff + n * 2048 + k * 1024); } while (0)
#define PG8_MMA(ai, bj, At, Bt) do { __builtin_amdgcn_s_setprio(1); _Pragma("unroll") for (int m = 0; m < 4; ++m) _Pragma("unroll") for (int n = 0; n < 2; ++n) _Pragma("unroll") for (int k = 0; k < 2; ++k) \
        acc[ai][bj][m][n] = __builtin_amdgcn_mfma_f32_16x16x32_bf16(Bt[n][k], At[m][k], acc[ai][bj][m][n], 0, 0, 0); __builtin_amdgcn_s_setprio(0); } while (0)
#define PG8_WAIT_V(n) asm volatile("s_waitcnt vmcnt(" #n ")" ::: "memory")
#define PG8_WAIT_L(n) asm volatile("s_waitcnt lgkmcnt(" #n ")" ::: "memory")
#define PG8_BAR __builtin_amdgcn_s_barrier()
#define PG8_SCHED __builtin_amdgcn_sched_barrier(0)
    Unit cur, nxt; int ui = 0;
    if (!S.next(0, cur)) return;
    f32x4 acc[2][2][4][2];
#pragma unroll
    for (int a = 0; a < 2; ++a)
#pragma unroll
        for (int b = 0; b < 2; ++b)
#pragma unroll
            for (int m = 0; m < 4; ++m)
#pragma unroll
                for (int n = 0; n < 2; ++n) acc[a][b][m][n] = (f32x4){0.f, 0.f, 0.f, 0.f};
    bf16x8 At[4][2], B0[2][2], B1[2][2];
    const char* cA = (const char*)g.A + (size_t)cur.pm * tstep; const char* cB = (const char*)g.Bt + (size_t)cur.pn * tstep;
    S.a_ready(cur);
    if constexpr (SP2) {
        PG8_STAGE(PG8_SB(0, 0), cB, voffB); PG8_STAGE(PG8_SB(0, 1), cB + hstep, voffB); PG8_STAGE(PG8_SA(0, 0), cA, voffA); PG8_STAGE(PG8_SA(0, 1), cA + hstep, voffA);
        if (wr == 1) PG8_BAR;
        PG8_WAIT_V(2); PG8_BAR;
        PG8_STAGE(PG8_SB(1, 0), cB + kstep, voffB); PG8_STAGE(PG8_SA(1, 0), cA + kstep, voffA); PG8_STAGE(PG8_SB(1, 1), cB + hstep + kstep, voffB);
        PG8_WAIT_V(6); PG8_BAR;
    } else {
        PG8_STAGE(PG8_SB(0, 0), cB, voffB); PG8_STAGE(PG8_SA(0, 0), cA, voffA); PG8_STAGE(PG8_SB(0, 1), cB + hstep, voffB); PG8_STAGE(PG8_SA(0, 1), cA + hstep, voffA);
        if (wr == 1) PG8_BAR;
        PG8_WAIT_V(4); PG8_BAR;
        PG8_STAGE(PG8_SB(1, 0), cB + kstep, voffB); PG8_STAGE(PG8_SA(1, 0), cA + kstep, voffA); PG8_STAGE(PG8_SB(1, 1), cB + hstep + kstep, voffB);
        PG8_WAIT_V(6); PG8_BAR;
    }
    for (;;) {
        const bool has_next = S.next(ui + 1, nxt);
        const char* nA = has_next ? (const char*)g.A + (size_t)nxt.pm * tstep : cA; const char* nB = has_next ? (const char*)g.Bt + (size_t)nxt.pn * tstep : cB;
        for (int t = 0; t < nt; t += 2) {
            const bool last = (t == nt - 2);
            const char* a1 = cA + (size_t)(t + 1) * kstep;
            const char* a2 = last ? nA : cA + (size_t)(t + 2) * kstep; const char* b2 = last ? nB : cB + (size_t)(t + 2) * kstep;
            const char* a3 = a2 + kstep; const char* b3 = b2 + kstep;
            if (last && has_next) S.a_ready(nxt);
            if constexpr (SP2) {
            PG8_LDB(B0, 0, 0); PG8_LDB(B1, 0, 1); PG8_SCHED; PG8_LDA(At, 0, 0); PG8_STAGE(PG8_SA(1, 1), a1 + hstep, voffA);
            PG8_WAIT_V(8); PG8_WAIT_L(0); PG8_BAR; PG8_MMA(0, 0, At, B0); PG8_MMA(0, 1, At, B1); PG8_BAR; PG8_SCHED;
            PG8_LDA(At, 0, 1); PG8_STAGE(PG8_SB(0, 0), b2, voffB); PG8_STAGE(PG8_SB(0, 1), b2 + hstep, voffB); PG8_STAGE(PG8_SA(0, 0), a2, voffA);
            PG8_WAIT_V(8); PG8_WAIT_L(0); PG8_BAR; PG8_MMA(1, 0, At, B0); PG8_MMA(1, 1, At, B1); PG8_BAR; PG8_SCHED;
            PG8_LDB(B0, 1, 0); PG8_LDB(B1, 1, 1); PG8_SCHED; PG8_LDA(At, 1, 0); PG8_STAGE(PG8_SA(0, 1), a2 + hstep, voffA);
            PG8_WAIT_V(8); PG8_WAIT_L(0); PG8_BAR; PG8_MMA(0, 0, At, B0); PG8_MMA(0, 1, At, B1); PG8_BAR; PG8_SCHED;
            PG8_LDA(At, 1, 1); PG8_STAGE(PG8_SB(1, 0), b3, voffB); PG8_STAGE(PG8_SB(1, 1), b3 + hstep, voffB); PG8_STAGE(PG8_SA(1, 0), a3, voffA);
            PG8_WAIT_V(8); PG8_WAIT_L(0); PG8_BAR; PG8_MMA(1, 0, At, B0); PG8_MMA(1, 1, At, B1); PG8_BAR; PG8_SCHED;
            } else {
            PG8_LDB(B0, 0, 0); PG8_SCHED; PG8_LDA(At, 0, 0); PG8_STAGE(PG8_SA(1, 1), a1 + hstep, voffA);
            PG8_WAIT_L(8); PG8_BAR; PG8_WAIT_L(0); PG8_MMA(0, 0, At, B0); PG8_BAR; PG8_SCHED;
            PG8_LDB(B1, 0, 1); PG8_STAGE(PG8_SB(0, 0), b2, voffB);
            PG8_BAR; PG8_WAIT_L(0); PG8_MMA(0, 1, At, B1); PG8_BAR;
            PG8_LDA(At, 0, 1); PG8_STAGE(PG8_SA(0, 0), a2, voffA);
            PG8_BAR; PG8_WAIT_L(0); PG8_MMA(1, 0, At, B0); PG8_BAR; PG8_SCHED;
            PG8_STAGE(PG8_SB(0, 1), b2 + hstep, voffB);
            PG8_WAIT_V(6); PG8_BAR; PG8_MMA(1, 1, At, B1); PG8_BAR;
            PG8_LDB(B0, 1, 0); PG8_SCHED; PG8_LDA(At, 1, 0); PG8_STAGE(PG8_SA(0, 1), a2 + hstep, voffA);
            PG8_WAIT_L(8); PG8_BAR; PG8_WAIT_L(0); PG8_MMA(0, 0, At, B0); PG8_BAR; PG8_SCHED;
            PG8_LDB(B1, 1, 1); PG8_STAGE(PG8_SB(1, 0), b3, voffB);
            PG8_BAR; PG8_WAIT_L(0); PG8_MMA(0, 1, At, B1); PG8_BAR;
            PG8_LDA(At, 1, 1); PG8_STAGE(PG8_SA(1, 0), a3, voffA);
            PG8_BAR; PG8_WAIT_L(0); PG8_MMA(1, 0, At, B0); PG8_BAR; PG8_SCHED;
            PG8_STAGE(PG8_SB(1, 1), b3 + hstep, voffB);
            PG8_WAIT_V(6); PG8_BAR; PG8_MMA(1, 1, At, B1); PG8_BAR;
            }
        }
        if constexpr (ALIGN_EPI) { if (wr == 0) PG8_BAR; }
        if constexpr (!Epi::AFTER_DRAIN) { E(acc, cur, wr, wc, fr, fq); S.done(cur); }
        if (!has_next) break;
#pragma unroll
        for (int a = 0; a < 2; ++a)
#pragma unroll
            for (int b = 0; b < 2; ++b)
#pragma unroll
                for (int m = 0; m < 4; ++m)
#pragma unroll
                    for (int n = 0; n < 2; ++n) acc[a][b][m][n] = (f32x4){0.f, 0.f, 0.f, 0.f};
        cur = nxt; cA = nA; cB = nB; ++ui;
        if constexpr (ALIGN_EPI) { if (wr == 1) PG8_BAR; }
    }
    PG8_WAIT_V(0);
    if constexpr (!ALIGN_EPI) { if (wr == 0) PG8_BAR; }
    PG8_BAR;
    if constexpr (Epi::AFTER_DRAIN) { E.fused(acc, cur, wr, wc, fr, fq, lds, wid, lane); S.done(cur); }
#undef PG8_SA
#undef PG8_SB
#undef PG8_STAGE
#undef PG8_LDA
#undef PG8_LDB
#undef PG8_MMA
#undef PG8_WAIT_V
#undef PG8_WAIT_L
#undef PG8_BAR
#undef PG8_SCHED
}
}
#define LAS __attribute__((address_space(3)))
typedef unsigned short bf16_t;
typedef short bf16x8 __attribute__((ext_vector_type(8)));
typedef float f32x4 __attribute__((ext_vector_type(4)));
typedef unsigned u32x4 __attribute__((ext_vector_type(4)));
typedef unsigned u32x2 __attribute__((ext_vector_type(2)));

constexpr int NB = 4, SEQ = 4096, DM = 2048, NT = NB * SEQ;
constexpr int NTHREADS = 512;
constexpr int LDS_BYTES = 147456;
constexpr float EPS = 1e-6f;
constexpr int EVEN_IN_SRC = 6152, EVEN_IN = 6144, ODD_IN = 5120;

constexpr size_t MiB = 1048576;
constexpr size_t WS_MOD = 0;
constexpr size_t WS_MISC = 512 * 1024;
constexpr size_t WS_LF = 1 * MiB;
constexpr size_t WS_LI = WS_LF + 256 * 1024;
constexpr size_t WS_CHS = 2 * MiB;
constexpr size_t WS_NLOC = 2 * MiB + 512 * 1024;
constexpr size_t WS_KMEAN = 3 * MiB;
constexpr size_t WS_SCL = 3 * MiB + 512 * 1024;
constexpr size_t WS_SK = 4 * MiB;
constexpr size_t WS_ROPE = 5 * MiB;
constexpr size_t WS_WIN0 = 8 * MiB;
constexpr size_t WS_WOUT0 = 32 * MiB;
constexpr size_t WS_WIN1 = 40 * MiB;
constexpr size_t WS_WOUT1 = 60 * MiB;
constexpr size_t WS_WQ0 = 68 * MiB;
constexpr size_t WS_WQ1 = 76 * MiB;
constexpr size_t WS_U = 84 * MiB;
constexpr size_t WS_V = 212 * MiB;
constexpr size_t WS_HN = 340 * MiB;
constexpr size_t WS_PROJ = 404 * MiB;
constexpr size_t WS_CAT = 596 * MiB;
constexpr size_t WS_QP = 660 * MiB;
constexpr size_t WS_QM = 724 * MiB;
constexpr size_t WS_KM = 740 * MiB;
constexpr size_t WS_VTM = 756 * MiB;
constexpr size_t WS_CLOC = 788 * MiB;
constexpr size_t WS_VTD = 820 * MiB;
constexpr size_t WS_CPREV = 852 * MiB;
constexpr size_t WS_NPREV = 2 * MiB + 768 * 1024;
constexpr size_t WS_MPREV = 2 * MiB + 16384;
constexpr size_t WS_H = 884 * MiB;
constexpr size_t WS_END = 948 * MiB;

struct Params { const float* in[25]; float* out; unsigned char* ws; long long pad; };

__device__ __forceinline__ float bf_lo(unsigned w) { return __uint_as_float(w << 16); }
__device__ __forceinline__ float bf_hi(unsigned w) { return __uint_as_float(w & 0xffff0000u); }
__device__ __forceinline__ float bf2f(bf16_t h) { return __uint_as_float((unsigned)h << 16); }
typedef float f32x2_t __attribute__((ext_vector_type(2))); typedef __bf16 bf16x2_t __attribute__((ext_vector_type(2)));
__device__ __forceinline__ unsigned pk_bf16(float lo, float hi) { const f32x2_t v = {lo, hi}; const bf16x2_t b = __builtin_convertvector(v, bf16x2_t); return __builtin_bit_cast(unsigned, b); }
__device__ __forceinline__ bf16_t f2bf(float f) { return (bf16_t)(pk_bf16(f, 0.f) & 0xffffu); }
__device__ __forceinline__ float wave_sum(float v) {
#pragma unroll
    for (int o = 1; o < 64; o <<= 1) v += __shfl_xor(v, o);
    return v;
}
__device__ __forceinline__ float wave_max(float v) {
#pragma unroll
    for (int o = 1; o < 64; o <<= 1) v = fmaxf(v, __shfl_xor(v, o));
    return v;
}
__device__ __forceinline__ float sigmoidf_(float a) { return 1.f / (1.f + __expf(-a)); }
__device__ __forceinline__ float gelu_tanh(float x) { const float z = 0.7978845608f * (x + 0.044715f * x * x * x); return x / (1.f + __expf(-2.f * z)); }
__device__ __forceinline__ f32x4 mfma16(bf16x8 a, bf16x8 b, f32x4 c) { return __builtin_amdgcn_mfma_f32_16x16x32_bf16(a, b, c, 0, 0, 0); }
__device__ __forceinline__ void unpack8(u32x4 w, float* f) {
    f[0] = bf_lo(w.x); f[1] = bf_hi(w.x); f[2] = bf_lo(w.y); f[3] = bf_hi(w.y); f[4] = bf_lo(w.z); f[5] = bf_hi(w.z); f[6] = bf_lo(w.w); f[7] = bf_hi(w.w);
}
__device__ __forceinline__ u32x4 pack8(const float* f) { u32x4 w; w.x = pk_bf16(f[0], f[1]); w.y = pk_bf16(f[2], f[3]); w.z = pk_bf16(f[4], f[5]); w.w = pk_bf16(f[6], f[7]); return w; }

struct EpiStoreBf16 {
    static constexpr bool PERM = true, AFTER_DRAIN = false;
    bf16_t* O; int ldc;
    __device__ __forceinline__ void operator()(const f32x4 (&acc)[2][2][4][2], const pg8::Unit& u, int wr, int wc, int fr, int fq) const {
        const int row0 = u.pm * 256 + wr * 64 + fr, col0 = u.pn * 256 + wc * 32 + 8 * fq;
#pragma unroll
        for (int ai = 0; ai < 2; ++ai)
#pragma unroll
            for (int m = 0; m < 4; ++m) { bf16_t* rowp = O + (size_t)(row0 + ai * 128 + m * 16) * ldc + col0;
#pragma unroll
                for (int bj = 0; bj < 2; ++bj) { const f32x4 v0 = acc[ai][bj][m][0], v1 = acc[ai][bj][m][1];
                    u32x4 w; w.x = pk_bf16(v0[0], v0[1]); w.y = pk_bf16(v0[2], v0[3]); w.z = pk_bf16(v1[0], v1[1]); w.w = pk_bf16(v1[2], v1[3]);
                    *(u32x4*)(rowp + bj * 128) = w; } }
    }
};
template <int LAYER>
struct EpiProj {
    static constexpr bool PERM = true, AFTER_DRAIN = false;
    bf16_t* O; int ldc; bf16_t* vta; bf16_t* vtb;
    __device__ __forceinline__ void operator()(const f32x4 (&acc)[2][2][4][2], const pg8::Unit& u, int wr, int wc, int fr, int fq) const {
        const int row0 = u.pm * 256 + wr * 64 + fr, col0 = u.pn * 256 + wc * 32 + 8 * fq;
        const bool isva = (LAYER == 0) && (u.pn >= 4 && u.pn < 8);
        const bool isvb = (LAYER == 0) ? (u.pn >= 20) : (u.pn >= 8 && u.pn < 12);
        if (!isva && !isvb) {
#pragma unroll
            for (int ai = 0; ai < 2; ++ai)
#pragma unroll
                for (int m = 0; m < 4; ++m) { bf16_t* rowp = O + (size_t)(row0 + ai * 128 + m * 16) * ldc + col0;
#pragma unroll
                    for (int bj = 0; bj < 2; ++bj) { const f32x4 v0 = acc[ai][bj][m][0], v1 = acc[ai][bj][m][1];
                        u32x4 w; w.x = pk_bf16(v0[0], v0[1]); w.y = pk_bf16(v0[2], v0[3]); w.z = pk_bf16(v1[0], v1[1]); w.w = pk_bf16(v1[2], v1[3]);
                        *(u32x4*)(rowp + bj * 128) = w; } }
        } else {
            const int b = (u.pm * 256) / SEQ, s0 = (u.pm * 256) % SEQ + wr * 64 + fr;
            const int cbase = isva ? 1024 : (LAYER == 0 ? 5120 : 2048);
            const int hv = isva ? 256 : 128, nh = isva ? 4 : 8;
            bf16_t* vt = isva ? vta : vtb;
#pragma unroll
            for (int bj = 0; bj < 2; ++bj) {
                const int cc = col0 + bj * 128 - cbase; const int h = cc / hv, v0i = cc % hv;
                bf16_t* vp = vt + ((size_t)(b * nh + h) * hv + v0i) * SEQ + s0;
#pragma unroll
                for (int ai = 0; ai < 2; ++ai)
#pragma unroll
                    for (int m = 0; m < 4; ++m) { const int so = ai * 128 + m * 16;
#pragma unroll
                        for (int n = 0; n < 2; ++n)
#pragma unroll
                            for (int e = 0; e < 4; ++e) vp[(size_t)(4 * n + e) * SEQ + so] = f2bf(acc[ai][bj][m][n][e]); }
            }
        }
    }
};
template <bool IN_F32>
struct EpiResid {
    static constexpr bool PERM = true, AFTER_DRAIN = false;
    const void* hin; bf16_t* hout; const float* gate;
    __device__ __forceinline__ void operator()(const f32x4 (&acc)[2][2][4][2], const pg8::Unit& u, int wr, int wc, int fr, int fq) const {
        const int row0 = u.pm * 256 + wr * 64 + fr, col0 = u.pn * 256 + wc * 32 + 8 * fq;
        const float* gp = gate + (size_t)((u.pm * 256) / SEQ) * 12288 + col0;
        f32x4 gv[2][2];
#pragma unroll
        for (int bj = 0; bj < 2; ++bj) { gv[bj][0] = *(const f32x4*)(gp + bj * 128); gv[bj][1] = *(const f32x4*)(gp + bj * 128 + 4); }
#pragma unroll
        for (int ai = 0; ai < 2; ++ai)
#pragma unroll
            for (int m = 0; m < 4; ++m) { const size_t off = (size_t)(row0 + ai * 128 + m * 16) * DM + col0;
#pragma unroll
                for (int bj = 0; bj < 2; ++bj) {
                    float h8[8];
                    if (IN_F32) { const f32x4 a = *(const f32x4*)((const float*)hin + off + bj * 128), c = *(const f32x4*)((const float*)hin + off + bj * 128 + 4);
                        h8[0] = a[0]; h8[1] = a[1]; h8[2] = a[2]; h8[3] = a[3]; h8[4] = c[0]; h8[5] = c[1]; h8[6] = c[2]; h8[7] = c[3]; }
                    else unpack8(*(const u32x4*)((const bf16_t*)hin + off + bj * 128), h8);
                    const f32x4 v0 = acc[ai][bj][m][0] * gv[bj][0], v1 = acc[ai][bj][m][1] * gv[bj][1];
                    u32x4 w; w.x = pk_bf16(h8[0] + v0[0], h8[1] + v0[1]); w.y = pk_bf16(h8[2] + v0[2], h8[3] + v0[3]); w.z = pk_bf16(h8[4] + v1[0], h8[5] + v1[1]); w.w = pk_bf16(h8[6] + v1[2], h8[7] + v1[3]);
                    *(u32x4*)(hout + off + bj * 128) = w; } }
    }
};

__device__ __forceinline__ void rms_mod_row(const float* src, const float* ng, const float* sc, const float* sh, bf16_t* dst, int lane, f32x4 (&v)[8]) {
    const f32x4* xr = (const f32x4*)src + lane; float s = 0.f;
#pragma unroll
    for (int j = 0; j < 8; ++j) { v[j] = xr[64 * j]; s += (v[j][0] * v[j][0] + v[j][1] * v[j][1]) + (v[j][2] * v[j][2] + v[j][3] * v[j][3]); }
    const float r = rsqrtf(wave_sum(s) * (1.f / DM) + EPS);
    u32x2* o8 = (u32x2*)dst + lane;
#pragma unroll
    for (int j = 0; j < 8; ++j) {
        const f32x4 g = ((const f32x4*)ng)[lane + 64 * j], a = ((const f32x4*)sc)[lane + 64 * j], b = ((const f32x4*)sh)[lane + 64 * j];
        v[j] = v[j] * r * g * (a + 1.f) + b;
        u32x2 w; w.x = pk_bf16(v[j][0], v[j][1]); w.y = pk_bf16(v[j][2], v[j][3]); o8[64 * j] = w;
    }
}

__device__ __forceinline__ void p0_transpose_item(const float* W, int ldw, int c0, int k0, bf16_t* WT, int n0, LAS float* scr, int lane) {
#pragma unroll 8
    for (int i = 0; i < 32; ++i) { const int kk = 2 * i + (lane >> 5); scr[kk * 33 + (lane & 31)] = W[(size_t)(k0 + kk) * ldw + c0 + (lane & 31)]; }
    asm volatile("s_waitcnt lgkmcnt(0)" ::: "memory");
    const int c = lane & 7;
#pragma unroll
    for (int j = 0; j < 4; ++j) { const int n = (lane >> 3) + 8 * j; const LAS float* s = scr + (8 * c) * 33 + n;
        u32x4 o; o.x = pk_bf16(s[0 * 33], s[1 * 33]); o.y = pk_bf16(s[2 * 33], s[3 * 33]); o.z = pk_bf16(s[4 * 33], s[5 * 33]); o.w = pk_bf16(s[6 * 33], s[7 * 33]);
        *(u32x4*)(WT + (size_t)(n0 + n) * 2048 + k0 + 8 * c) = o; }
    asm volatile("s_waitcnt lgkmcnt(0)" ::: "memory");
}

__device__ __forceinline__ void phase0a(const Params& p, LAS unsigned char* lds, int tid, int lane, int wave, int bid, int G) {
    unsigned char* ws = p.ws;
    const int gw = bid * 8 + wave, NGW = G * 8;
    const int gt = bid * NTHREADS + tid, NGT = G * NTHREADS;
    {
        LAS float* scr = (LAS float*)(lds + wave * 8704);
        constexpr int NB0 = 192, NB1 = 64, NB2 = 160, NB3 = 64, NB4 = 64, NB5 = 64, NBT = NB0 + NB1 + NB2 + NB3 + NB4 + NB5;
        for (int it = gw; it < 32 * NBT; it += NGW) {
            const int kb = it / NBT; int nb = it % NBT; const int k0 = kb * 64;
            if (nb < NB0) { const int n0 = nb * 32; p0_transpose_item(p.in[7], EVEN_IN_SRC, n0 + (n0 >= 3072 ? 8 : 0), k0, (bf16_t*)(ws + WS_WIN0), n0, scr, lane); continue; } nb -= NB0;
            if (nb < NB1) { p0_transpose_item(p.in[8], 2048, nb * 32, k0, (bf16_t*)(ws + WS_WOUT0), nb * 32, scr, lane); continue; } nb -= NB1;
            if (nb < NB2) { p0_transpose_item(p.in[15], ODD_IN, nb * 32, k0, (bf16_t*)(ws + WS_WIN1), nb * 32, scr, lane); continue; } nb -= NB2;
            if (nb < NB3) { p0_transpose_item(p.in[16], 2048, nb * 32, k0, (bf16_t*)(ws + WS_WOUT1), nb * 32, scr, lane); continue; } nb -= NB3;
            if (nb < NB4) { p0_transpose_item(p.in[21], 2048, nb * 32, k0, (bf16_t*)(ws + WS_WQ0), nb * 32, scr, lane); continue; } nb -= NB4;
            p0_transpose_item(p.in[21] + (size_t)2048 * 2048, 2048, nb * 32, k0, (bf16_t*)(ws + WS_WQ1), nb * 32, scr, lane);
        }
    }
    {
        float* scl = (float*)(ws + WS_SCL);
        for (int r = gw; r < 65536; r += 2 * NGW) {
            const int r1 = r + NGW; const bool has1 = r1 < 65536; const int rb = has1 ? r1 : r;
            const float* s0 = (r < 32768 ? p.in[23] : p.in[24]) + (size_t)(r & 32767) * 2048;
            const float* s1 = (rb < 32768 ? p.in[23] : p.in[24]) + (size_t)(rb & 32767) * 2048;
            unsigned char* d0 = ws + (r < 32768 ? WS_U : WS_V) + (size_t)((r >> 14) & 1) * 16384 * 2048 + (size_t)(r & 16383) * 128;
            unsigned char* d1 = ws + (rb < 32768 ? WS_U : WS_V) + (size_t)((rb >> 14) & 1) * 16384 * 2048 + (size_t)(rb & 16383) * 128;
            f32x4 v0[8], v1[8]; float a0 = 0.f, a1 = 0.f;
#pragma unroll
            for (int j = 0; j < 8; ++j) { v0[j] = ((const f32x4*)s0)[lane + 64 * j]; v1[j] = ((const f32x4*)s1)[lane + 64 * j]; }
#pragma unroll
            for (int j = 0; j < 8; ++j) { a0 = fmaxf(a0, fmaxf(fmaxf(fabsf(v0[j][0]), fabsf(v0[j][1])), fmaxf(fabsf(v0[j][2]), fabsf(v0[j][3]))));
                                          a1 = fmaxf(a1, fmaxf(fmaxf(fabsf(v1[j][0]), fabsf(v1[j][1])), fmaxf(fabsf(v1[j][2]), fabsf(v1[j][3])))); }
#pragma unroll
            for (int o = 1; o < 64; o <<= 1) { a0 = fmaxf(a0, __shfl_xor(a0, o)); a1 = fmaxf(a1, __shfl_xor(a1, o)); }
            int e0 = 0, e1 = 0; (void)frexpf(a0, &e0); (void)frexpf(a1, &e1); if (e0 < -100) e0 = -100; if (e1 < -100) e1 = -100;
            const float c0 = (a0 > 0.f) ? ldexpf(1.f, 8 - e0) : 1.f, c1 = (a1 > 0.f) ? ldexpf(1.f, 8 - e1) : 1.f;
#pragma unroll
            for (int j = 0; j < 8; ++j) { const size_t off = (size_t)(2 * j + (lane >> 5)) * (16384 * 128) + (lane & 31) * 4;
                int w = __builtin_amdgcn_cvt_pk_fp8_f32(v0[j][0] * c0, v0[j][1] * c0, 0, false); w = __builtin_amdgcn_cvt_pk_fp8_f32(v0[j][2] * c0, v0[j][3] * c0, w, true);
                *(unsigned*)(d0 + off) = (unsigned)w;
                if (has1) { int z = __builtin_amdgcn_cvt_pk_fp8_f32(v1[j][0] * c1, v1[j][1] * c1, 0, false); z = __builtin_amdgcn_cvt_pk_fp8_f32(v1[j][2] * c1, v1[j][3] * c1, z, true);
                    *(unsigned*)(d1 + off) = (unsigned)z; } }
            if (lane == 0) { scl[r] = (a0 > 0.f) ? ldexpf(1.f, e0 - 8) : 1.f; if (has1) scl[r1] = (a1 > 0.f) ? ldexpf(1.f, e1 - 8) : 1.f; }
        }
        const size_t k8 = (size_t)2 * 8 * 2 * 128 * 128 / 8;
        const f32x4* sk = (const f32x4*)p.in[22]; u32x4* dk = (u32x4*)(ws + WS_SK);
        for (size_t i = gt; i < k8; i += NGT) { const f32x4 a = sk[2 * i], b = sk[2 * i + 1];
            u32x4 w; w.x = pk_bf16(a[0], a[1]); w.y = pk_bf16(a[2], a[3]); w.z = pk_bf16(b[0], b[1]); w.w = pk_bf16(b[2], b[3]); dk[i] = w; }
    }
    {
        const int* pos = (const int*)p.in[2]; float* tab = (float*)(ws + WS_ROPE);
        for (int i = gt; i < NT * 24; i += NGT) {
            const int t = i / 24, j = i % 24;
            const float e = (j < 8) ? (float)j * (1.f / 8.f) : (float)(j - 8) * (1.f / 16.f);
            const float inv = exp2f(-e * 18.931568569324174f);
            const float ang = (float)pos[t] * inv;
            float sn, cs; sincosf(ang, &sn, &cs);
            tab[2 * i] = cs; tab[2 * i + 1] = sn;
        }
    }
    {
        const float* cin = p.in[1]; float* mod = (float*)(ws + WS_MOD);
        LAS float* part = (LAS float*)(lds + 73728);
        for (int it = bid; it < 192; it += G) {
            const int ng = it % 96, l = it / 96;
            const int n0 = ng * 128 + 2 * lane;
            f32x2_t acc[4];
#pragma unroll
            for (int b = 0; b < 4; ++b) acc[b] = (f32x2_t){0.f, 0.f};
#pragma unroll 1
            for (int kc = 0; kc < 4; ++kc) {
                const int k0 = wave * 256 + kc * 64;
                float ca[4];
#pragma unroll
                for (int b = 0; b < 4; ++b) { const float cv = cin[b * DM + k0 + lane]; ca[b] = cv * sigmoidf_(cv); }
                const float* wp = p.in[3] + ((size_t)l * DM + k0) * 12288 + n0;
#pragma unroll 16
                for (int kk = 0; kk < 64; ++kk) {
                    const f32x2_t w = *(const f32x2_t*)(wp + (size_t)kk * 12288);
#pragma unroll
                    for (int b = 0; b < 4; ++b) acc[b] += w * __shfl(ca[b], kk);
                }
            }
#pragma unroll
            for (int b = 0; b < 4; ++b) *(LAS f32x2_t*)(part + (wave * 4 + b) * 128 + 2 * lane) = acc[b];
            __syncthreads();
            { const int o = tid, b = o >> 7, col = o & 127;
                float sm = p.in[4][l * 12288 + ng * 128 + col];
#pragma unroll
                for (int w = 0; w < 8; ++w) sm += part[(w * 4 + b) * 128 + col];
                mod[((size_t)l * 4 + b) * 12288 + ng * 128 + col] = sm; }
            __syncthreads();
        }
    }
    if (bid == 0 && wave == 0) {
        const float* lv = p.in[13];
        const float a = wave_sum(lv[lane] * lv[64 + lane]), b = wave_sum(lv[128 + lane] * lv[192 + lane]);
        if (lane == 0) ((float*)(ws + WS_MISC))[0] = __expf(a) - __expf(b) + 0.2f;
    }
}

template <bool GATES>
__device__ __forceinline__ void phase_rows(const Params& p, LAS unsigned char* lds, const void* hsrc_, const float* ng, const float* modl  , int sc_off, int sh_off,
                                           int tid, int lane, int wave, int bid, int G) {
    unsigned char* ws = p.ws;
    LAS float* wg = (LAS float*)lds;
    if (GATES) {
        for (int i = tid; i < 8 * DM; i += NTHREADS) { const int k = i >> 3, j = i & 7; wg[j * DM + k] = p.in[7][(size_t)k * EVEN_IN_SRC + 3072 + j]; }
        __syncthreads();
    }
    float* lf = (float*)(ws + WS_LF); float* li = (float*)(ws + WS_LI);
    for (int r0 = (bid * 8 + wave) * 8; r0 < NT; r0 += G * 64) {
        const int b = r0 / SEQ;
        f32x4 av[8], bv[8];
        { const float* sc = modl + (size_t)b * 12288 + sc_off; const float* sh = modl + (size_t)b * 12288 + sh_off;
#pragma unroll
          for (int j = 0; j < 8; ++j) { av[j] = ((const f32x4*)ng)[lane + 64 * j] * (((const f32x4*)sc)[lane + 64 * j] + 1.f); bv[j] = ((const f32x4*)sh)[lane + 64 * j]; } }
#pragma unroll 1
        for (int i = 0; i < 8; i += 2) {
            f32x4 v0[8], v1[8]; float s0 = 0.f, s1 = 0.f;
            if (GATES) { const f32x4* x0 = (const f32x4*)((const float*)hsrc_ + (size_t)(r0 + i) * DM) + lane; const f32x4* x1 = x0 + DM / 4;
#pragma unroll
                for (int j = 0; j < 8; ++j) { v0[j] = x0[64 * j]; v1[j] = x1[64 * j]; } }
            else { const u32x2* x0 = (const u32x2*)((const bf16_t*)hsrc_ + (size_t)(r0 + i) * DM) + lane; const u32x2* x1 = x0 + DM / 4;
#pragma unroll
                for (int j = 0; j < 8; ++j) { const u32x2 a = x0[64 * j], c = x1[64 * j];
                    v0[j] = (f32x4){bf_lo(a.x), bf_hi(a.x), bf_lo(a.y), bf_hi(a.y)}; v1[j] = (f32x4){bf_lo(c.x), bf_hi(c.x), bf_lo(c.y), bf_hi(c.y)}; } }
#pragma unroll
            for (int j = 0; j < 8; ++j) { s0 += (v0[j][0] * v0[j][0] + v0[j][1] * v0[j][1]) + (v0[j][2] * v0[j][2] + v0[j][3] * v0[j][3]);
                                          s1 += (v1[j][0] * v1[j][0] + v1[j][1] * v1[j][1]) + (v1[j][2] * v1[j][2] + v1[j][3] * v1[j][3]); }
#pragma unroll
            for (int o = 1; o < 64; o <<= 1) { s0 += __shfl_xor(s0, o); s1 += __shfl_xor(s1, o); }
            const float q0 = rsqrtf(s0 * (1.f / DM) + EPS), q1 = rsqrtf(s1 * (1.f / DM) + EPS);
            u32x2* o0 = (u32x2*)((bf16_t*)(ws + WS_HN) + (size_t)(r0 + i) * DM) + lane; u32x2* o1 = o0 + DM / 4;
#pragma unroll
            for (int j = 0; j < 8; ++j) { v0[j] = v0[j] * q0 * av[j] + bv[j]; v1[j] = v1[j] * q1 * av[j] + bv[j];
                u32x2 w; w.x = pk_bf16(v0[j][0], v0[j][1]); w.y = pk_bf16(v0[j][2], v0[j][3]); o0[64 * j] = w;
                u32x2 z; z.x = pk_bf16(v1[j][0], v1[j][1]); z.y = pk_bf16(v1[j][2], v1[j][3]); o1[64 * j] = z; }
            if (GATES) {
#pragma unroll
                for (int rr = 0; rr < 2; ++rr) {
                    float pd[8];
#pragma unroll
                    for (int jg = 0; jg < 8; ++jg) { float a = 0.f;
#pragma unroll
                        for (int j = 0; j < 8; ++j) { const f32x4 w = *(const LAS f32x4*)(wg + jg * DM + 4 * lane + 256 * j); const f32x4 x = rr ? v1[j] : v0[j];
                            a += (x[0] * w[0] + x[1] * w[1]) + (x[2] * w[2] + x[3] * w[3]); }
                        pd[jg] = a; __builtin_amdgcn_sched_barrier(0); }
                    const bool b5 = (lane >> 5) & 1, b4 = (lane >> 4) & 1, b3 = (lane >> 3) & 1;
                    float r4[4], r2[2];
#pragma unroll
                    for (int q = 0; q < 4; ++q) r4[q] = (b5 ? pd[4 + q] : pd[q]) + __shfl_xor(b5 ? pd[q] : pd[4 + q], 32);
#pragma unroll
                    for (int q = 0; q < 2; ++q) r2[q] = (b4 ? r4[2 + q] : r4[q]) + __shfl_xor(b4 ? r4[q] : r4[2 + q], 16);
                    float g1 = (b3 ? r2[1] : r2[0]) + __shfl_xor(b3 ? r2[0] : r2[1], 8);
                    g1 += __shfl_xor(g1, 4); g1 += __shfl_xor(g1, 2); g1 += __shfl_xor(g1, 1);
                    const int jg = lane >> 3, h = jg & 3; const int m = r0 + i + rr, s = m % SEQ;
                    if ((lane & 7) == 0) {
                        const float pre = g1 + p.in[11][jg];
                        if (jg < 4) li[((size_t)b * 4 + h) * SEQ + s] = pre;
                        else lf[((size_t)b * 4 + h) * SEQ + s] = (pre >= 0.f) ? -log1pf(__expf(-pre)) : pre - log1pf(__expf(pre));
                    }
                }
            }
        }
    }
}
#define XB_TMO      128
#define XB_XCNT(j)  (256  + 64 * (j))
#define XB_XSUB(j)  (1280 + 64 * (j))
#define XB_XGEN(j)  (2304 + 64 * (j))
#define XB_TOP      3328
#define XB_TOPGEN   3392
#define XCD_BAR_WORDS 3456
#define XB_SPIN_CAP (1u << 18)

__device__ __forceinline__ unsigned xb_ld(unsigned* p)              { return __hip_atomic_load(p, __ATOMIC_RELAXED, __HIP_MEMORY_SCOPE_AGENT); }
__device__ __forceinline__ unsigned xb_add(unsigned* p, unsigned v) { return __hip_atomic_fetch_add(p, v, __ATOMIC_RELAXED, __HIP_MEMORY_SCOPE_AGENT); }
__device__ __forceinline__ unsigned xb_xcc_id() { return (unsigned)__builtin_amdgcn_s_getreg((3 << 11) | 20) & 0xFu; }
#define XB_SPIN(cond, bar) do { unsigned _sp = 0; while (cond) { __builtin_amdgcn_s_sleep(1); \
    if ((++_sp & 255u) == 0u) { if (xb_ld(&(bar)[XB_TMO])) break; if (_sp > XB_SPIN_CAP) { atomicAdd(&(bar)[XB_TMO], 1u); break; } } } } while (0)

struct XcdBarrier {
    unsigned* bar; unsigned x;
    volatile LAS unsigned* st;
};

__device__ __forceinline__ XcdBarrier xcd_barrier_post(unsigned* bar, volatile LAS unsigned* st) {
    XcdBarrier b; b.bar = bar; b.x = xb_xcc_id(); b.st = st;
    if (threadIdx.x == 0) (void)xb_add(&bar[XB_XCNT(b.x)], 1u);
    return b;
}
__device__ __forceinline__ void xcd_barrier_complete(unsigned* bar, unsigned x, unsigned& nloc, unsigned& nx) {
    const unsigned G = gridDim.x * gridDim.y * gridDim.z;
    unsigned sum, cnt, mine, sp = 0u;
    for (;;) {
        sum = 0u; cnt = 0u; mine = 0u;
#pragma unroll
        for (unsigned j = 0; j < 16; ++j) { const unsigned c = xb_ld(&bar[XB_XCNT(j)]); sum += c; cnt += (c > 0u) ? 1u : 0u; mine = (j == x) ? c : mine; }
        if (sum == G) break;
        __builtin_amdgcn_s_sleep(1);
        if ((++sp & 255u) == 0u) { if (xb_ld(&bar[XB_TMO])) break; if (sp > XB_SPIN_CAP) { atomicAdd(&bar[XB_TMO], 1u); break; } }
    }
    nloc = mine > 0u ? mine : 1u; nx = cnt > 0u ? cnt : 1u;
}

__device__ __forceinline__ void xcd_barrier(const XcdBarrier& b) {
    asm volatile("s_waitcnt vmcnt(0)" ::: "memory");
    __syncthreads();
    if (threadIdx.x == 0) {
        unsigned* bar = b.bar;
        __builtin_amdgcn_s_waitcnt(0);
        unsigned nloc = b.st[0], nx = b.st[1];
        if (nloc == 0u) { xcd_barrier_complete(bar, b.x, nloc, nx); b.st[0] = nloc; b.st[1] = nx; }
        const unsigned old = xb_add(&bar[XB_XSUB(b.x)], 1u);
        const unsigned gen = old / nloc;
        if (old + 1u == (gen + 1u) * nloc) {
            __builtin_amdgcn_fence(__ATOMIC_RELEASE, "agent");
            asm volatile("s_waitcnt vmcnt(0)" ::: "memory");
            const unsigned og = xb_add(&bar[XB_TOP], 1u);
            const unsigned tg = og / nx;
            if (og + 1u == (tg + 1u) * nx) xb_add(&bar[XB_TOPGEN], 1u);
            else XB_SPIN(xb_ld(&bar[XB_TOPGEN]) == tg, bar);
            __builtin_amdgcn_fence(__ATOMIC_ACQUIRE, "agent");
            xb_add(&bar[XB_XGEN(b.x)], 1u);
            asm volatile("s_waitcnt vmcnt(0)" ::: "memory");
        } else {
            XB_SPIN(xb_ld(&bar[XB_XGEN(b.x)]) == gen, bar);
            __builtin_amdgcn_fence(__ATOMIC_ACQUIRE, "agent");
            asm volatile("s_waitcnt vmcnt(0)" ::: "memory");
        }
    }
    __syncthreads();
}
__device__ __forceinline__ void transpose_64x128(const bf16_t* src, size_t ld_src, bf16_t* dst, size_t ld_dst, LAS unsigned char* T  , int tid) {
#pragma unroll
    for (int i = 0; i < 2; ++i) { const int id = tid + NTHREADS * i, row = id >> 4, ch = id & 15;
        const u32x4 w = *(const u32x4*)(src + (size_t)row * ld_src + ch * 8);
        LAS bf16_t* tp = (LAS bf16_t*)(T + (8 * ch) * 144 + ((((row >> 3) ^ (ch & 7)) << 4) + (row & 7) * 2));
        tp[0 * 72] = (bf16_t)(w.x & 0xffffu); tp[1 * 72] = (bf16_t)(w.x >> 16); tp[2 * 72] = (bf16_t)(w.y & 0xffffu); tp[3 * 72] = (bf16_t)(w.y >> 16);
        tp[4 * 72] = (bf16_t)(w.z & 0xffffu); tp[5 * 72] = (bf16_t)(w.z >> 16); tp[6 * 72] = (bf16_t)(w.w & 0xffffu); tp[7 * 72] = (bf16_t)(w.w >> 16); }
    __syncthreads();
#pragma unroll
    for (int i = 0; i < 2; ++i) { const int id = tid + NTHREADS * i, v = id >> 3, c = id & 7;
        *(u32x4*)(dst + (size_t)v * ld_dst + c * 8) = *(const LAS u32x4*)(T + v * 144 + ((c ^ ((v >> 3) & 7)) << 4)); }
    __syncthreads();
}

__device__ __forceinline__ void diff_post_item(const Params& p, LAS unsigned char* lds, int item, int tid) {
    const int blk = item & 15, h = (item >> 4) & 7, b = item >> 7;
    bf16_t* proj = (bf16_t*)(p.ws + WS_PROJ);
    const float* tab = (const float*)(p.ws + WS_ROPE);
    const size_t row0 = (size_t)b * SEQ + blk * 256;
#pragma unroll
    for (int i = 0; i < 2; ++i) {
        const int id = tid + NTHREADS * i, tok = id >> 2, comp = id & 1, qk = (id >> 1) & 1;
        bf16_t* ptr = proj + (row0 + tok) * EVEN_IN + (qk ? 4096 : 3072) + h * 128 + comp * 64;
        const u32x4 w1 = *(const u32x4*)ptr, w2 = *(const u32x4*)(ptr + 8);
        float x1[8], x2[8], o1[8], o2[8]; unpack8(w1, x1); unpack8(w2, x2);
        const float* tb = tab + (row0 + tok) * 48;
#pragma unroll
        for (int e = 0; e < 8; ++e) { const float cs = tb[2 * e], sn = tb[2 * e + 1]; o1[e] = x1[e] * cs - x2[e] * sn; o2[e] = x2[e] * cs + x1[e] * sn; }
        *(u32x4*)ptr = pack8(o1); *(u32x4*)(ptr + 8) = pack8(o2);
    }
    (void)lds;
}

__device__ __forceinline__ void mlstm_cloc_unit(const Params& p, LAS unsigned char* lds, int unit, int tid, int lane, int wave) {
    const int c = unit & 31, h = (unit >> 5) & 3, b = unit >> 7, bh = b * 4 + h;
    unsigned char* ws = p.ws;
    const bf16_t* proj = (const bf16_t*)(ws + WS_PROJ);
    LAS unsigned char* Kt = lds;
    LAS unsigned char* Vt = lds + 34816;
    LAS float* sc = (LAS float*)(lds + 104448);
    const int s0 = c * 128;
    const float* lf = (const float*)(ws + WS_LF) + (size_t)bh * SEQ + s0;
    const float* li = (const float*)(ws + WS_LI) + (size_t)bh * SEQ + s0;
    if (wave == 0) {
        const float e0 = lf[2 * lane], e1 = lf[2 * lane + 1];
        float incl = e0 + e1;
#pragma unroll
        for (int o = 1; o < 64; o <<= 1) { const float t = __shfl_up(incl, o); if (lane >= o) incl += t; }
        const float g = __shfl(incl, 63);
        const float b0 = incl - e1, b1 = incl;
        const float a0 = g - b0 + li[2 * lane], a1 = g - b1 + li[2 * lane + 1];
        const float ml = wave_max(fmaxf(a0, a1));
        sc[2 * lane] = __expf(a0 - ml); sc[2 * lane + 1] = __expf(a1 - ml);
        if (lane == 0) { float* chs = (float*)(ws + WS_CHS) + (size_t)(bh * 32 + c) * 2; chs[0] = g; chs[1] = ml; }
    }
    __syncthreads();
    const float* cw = p.in[9]; const float* cb = p.in[10];
    bf16_t* Qm = (bf16_t*)(ws + WS_QM) + ((size_t)bh * SEQ + s0) * 128;
    bf16_t* Km = (bf16_t*)(ws + WS_KM) + ((size_t)bh * SEQ + s0) * 128;
#pragma unroll 2
    for (int i = 0; i < 8; ++i) {
        const int id = tid + NTHREADS * (i & 3), isk = i >> 2, s = id >> 4, dc = id & 15;
        const int col = isk * 512 + h * 128 + dc * 8;
        float y[8];
        { const f32x4 b0 = *(const f32x4*)(cb + col), b1 = *(const f32x4*)(cb + col + 4);
          y[0] = b0[0]; y[1] = b0[1]; y[2] = b0[2]; y[3] = b0[3]; y[4] = b1[0]; y[5] = b1[1]; y[6] = b1[2]; y[7] = b1[3]; }
#pragma unroll
        for (int w = 0; w < 4; ++w) {
            const int ts = s0 + s - 3 + w;
            if (ts >= 0) {
                const u32x4 raw = *(const u32x4*)(proj + ((size_t)b * SEQ + ts) * EVEN_IN + col);
                float x[8]; unpack8(raw, x);
                const f32x4 w0 = *(const f32x4*)(cw + w * 1024 + col), w1 = *(const f32x4*)(cw + w * 1024 + col + 4);
                y[0] += x[0] * w0[0]; y[1] += x[1] * w0[1]; y[2] += x[2] * w0[2]; y[3] += x[3] * w0[3];
                y[4] += x[4] * w1[0]; y[5] += x[5] * w1[1]; y[6] += x[6] * w1[2]; y[7] += x[7] * w1[3];
            }
        }
#pragma unroll
        for (int e = 0; e < 8; ++e) y[e] = y[e] * sigmoidf_(y[e]);
        if (!isk) {
#pragma unroll
            for (int e = 0; e < 8; ++e) y[e] *= 0.08838834764831845f;
            *(u32x4*)(Qm + (size_t)s * 128 + dc * 8) = pack8(y);
        } else {
            *(u32x4*)(Km + (size_t)s * 128 + dc * 8) = pack8(y);
            const float wsv = sc[s];
            LAS bf16_t* kp = (LAS bf16_t*)(Kt + (dc * 8) * 272 + ((((s >> 3) ^ (dc & 7)) << 4) + (s & 7) * 2));
#pragma unroll
            for (int e = 0; e < 8; ++e) kp[e * 136] = f2bf(y[e] * wsv);
        }
    }
    {
        const bf16_t* Vtm = (const bf16_t*)(ws + WS_VTM) + ((size_t)bh * 256) * SEQ + s0;
#pragma unroll 4
        for (int i = 0; i < 8; ++i) { const int id = tid + NTHREADS * i, v = id >> 4, ch = id & 15;
            *(LAS u32x4*)(Vt + v * 272 + ((ch ^ ((v >> 3) & 15)) << 4)) = *(const u32x4*)(Vtm + (size_t)v * SEQ + ch * 8); }
    }
    __syncthreads();
    if (tid < 128) { float a = 0.f;
#pragma unroll
        for (int ch = 0; ch < 16; ++ch) { float f[8]; unpack8(*(const LAS u32x4*)(Kt + tid * 272 + ch * 16), f); a += ((f[0] + f[1]) + (f[2] + f[3])) + ((f[4] + f[5]) + (f[6] + f[7])); }
        ((float*)(ws + WS_NLOC))[(size_t)(bh * 32 + c) * 128 + tid] = a; }
    const int r16 = lane & 15, g = lane >> 4;
    f32x4 acc[8][2];
#pragma unroll
    for (int db = 0; db < 8; ++db) { acc[db][0] = (f32x4){0.f, 0.f, 0.f, 0.f}; acc[db][1] = (f32x4){0.f, 0.f, 0.f, 0.f}; }
#pragma unroll
    for (int ks = 0; ks < 4; ++ks) {
        bf16x8 vf[2];
#pragma unroll
        for (int j = 0; j < 2; ++j) { const int v = 16 * (2 * wave + j) + r16; vf[j] = *(const LAS bf16x8*)(Vt + v * 272 + (((4 * ks + g) ^ ((v >> 3) & 15)) << 4)); }
#pragma unroll
        for (int db = 0; db < 8; ++db) { const int d = 16 * db + r16; const bf16x8 kf = *(const LAS bf16x8*)(Kt + d * 272 + (((4 * ks + g) ^ ((d >> 3) & 7)) << 4));
            acc[db][0] = mfma16(kf, vf[0], acc[db][0]); acc[db][1] = mfma16(kf, vf[1], acc[db][1]); }
    }
    bf16_t* Cl = (bf16_t*)(ws + WS_CLOC) + (size_t)(bh * 32 + c) * 256 * 128;
#pragma unroll
    for (int db = 0; db < 8; ++db)
#pragma unroll
        for (int j = 0; j < 2; ++j) { const int v = 16 * (2 * wave + j) + r16;
            u32x2 w; w.x = pk_bf16(acc[db][j][0], acc[db][j][1]); w.y = pk_bf16(acc[db][j][2], acc[db][j][3]);
            *(u32x2*)(Cl + (size_t)v * 128 + 16 * db + 4 * g) = w; }
    __syncthreads();
}

constexpr int ATT_KROW = 256, ATT_VROW = 128, ATT_KBYTES = 64 * ATT_KROW, ATT_BUF = ATT_KBYTES + 128 * ATT_VROW, ATT_EXTRA = 2 * ATT_BUF;
template <int MODE>
__device__ __forceinline__ void attn_unit(LAS unsigned char* lds, const bf16_t* Qb, const bf16_t* Kb, int ld, const bf16_t* Vt, int j,
                                          const float* kmean  , bf16_t* outp, const float* gvec  , float lam,
                                          int tid, int lane, int wave) {
    constexpr int NC = (MODE == 0) ? 2 : 1;
    constexpr float CS = ((MODE == 0) ? 0.125f : 0.08838834764831845f) * 1.4426950408889634f;
    const int r16 = lane & 15, g = lane >> 4;
    const int q0 = j * 128, qpos = q0 + 16 * wave + r16;
    const int own = j >> 1, half = j & 1;
    const int nown = (MODE == 0) ? 0 : 2 + 2 * half;
    const int ntiles = (MODE == 0) ? 2 * (j + 1) : nown + 4 * own;
    bf16x8 qf[4];
#pragma unroll
    for (int ks = 0; ks < 4; ++ks) qf[ks] = *(const bf16x8*)(Qb + (size_t)qpos * ld + 32 * ks + 8 * g);
    unsigned sel = 0;
    if (MODE == 1) {
        LAS float* km = (LAS float*)(lds + ATT_EXTRA);
        for (int i = tid; i < 16 * 128; i += NTHREADS) km[i] = kmean[i];
        __syncthreads();
        float qv[32];
#pragma unroll
        for (int ks = 0; ks < 4; ++ks) { float f[8]; unpack8(__builtin_bit_cast(u32x4, qf[ks]), f);
#pragma unroll
            for (int e = 0; e < 8; ++e) qv[8 * ks + e] = f[e]; }
        float gate[15]; float t1 = -INFINITY, t2 = -INFINITY, t3 = -INFINITY;
#pragma unroll
        for (int n = 0; n < 15; ++n) {
            gate[n] = -INFINITY;
            if (n < own) {
                float a = 0.f;
#pragma unroll
                for (int ks = 0; ks < 4; ++ks) { const f32x4 k0 = *(const LAS f32x4*)(km + n * 128 + 32 * ks + 8 * g), k1 = *(const LAS f32x4*)(km + n * 128 + 32 * ks + 8 * g + 4);
                    a += (qv[8 * ks + 0] * k0[0] + qv[8 * ks + 1] * k0[1]) + (qv[8 * ks + 2] * k0[2] + qv[8 * ks + 3] * k0[3])
                       + (qv[8 * ks + 4] * k1[0] + qv[8 * ks + 5] * k1[1]) + (qv[8 * ks + 6] * k1[2] + qv[8 * ks + 7] * k1[3]); }
                a += __shfl_xor(a, 16); a += __shfl_xor(a, 32);
                gate[n] = a;
                float v = a; const float n1 = fmaxf(t1, v); v = fminf(t1, v); t1 = n1; const float n2 = fmaxf(t2, v); v = fminf(t2, v); t2 = n2; t3 = fmaxf(t3, v);
            }
        }
        const float theta = (own >= 3) ? t3 : -INFINITY;
#pragma unroll
        for (int n = 0; n < 15; ++n) if (n < own && gate[n] >= theta) sel |= 1u << n;
    }
    f32x4 O[NC][8];
#pragma unroll
    for (int c = 0; c < NC; ++c)
#pragma unroll
        for (int vb = 0; vb < 8; ++vb) O[c][vb] = (f32x4){0.f, 0.f, 0.f, 0.f};
    float mrun[NC], lsum[NC];
#pragma unroll
    for (int c = 0; c < NC; ++c) { mrun[c] = -INFINITY; lsum[c] = 0.f; }

    auto key0_of = [&](int t) -> int { if (MODE == 0) return 64 * t; if (t < nown) return own * 256 + 64 * t; const int tt = t - nown; return (tt >> 2) * 256 + 64 * (tt & 3); };
    u32x4 kreg[2], vreg[2];
    auto load_tile = [&](int t) { const int k0 = key0_of(t);
#pragma unroll
        for (int i = 0; i < 2; ++i) { const int id = tid + NTHREADS * i;
            kreg[i] = *(const u32x4*)(Kb + (size_t)(k0 + (id >> 4)) * ld + (id & 15) * 8);
            vreg[i] = *(const u32x4*)(Vt + (size_t)(id >> 3) * SEQ + k0 + (id & 7) * 8); } };
    auto store_tile = [&](int buf) { LAS unsigned char* base = lds + buf * ATT_BUF;
#pragma unroll
        for (int i = 0; i < 2; ++i) { const int id = tid + NTHREADS * i;
            { const int r = id >> 4; *(LAS u32x4*)(base + r * ATT_KROW + (((id & 15) ^ ((r & 3) + 4 * ((r >> 3) & 3))) << 4)) = kreg[i]; }
            { const int v = id >> 3; *(LAS u32x4*)(base + ATT_KBYTES + v * ATT_VROW + (((id & 7) ^ ((v >> 1) & 7)) << 4)) = vreg[i]; } } };
    load_tile(0); store_tile(0);
    __syncthreads();
    if (ntiles > 1) load_tile(1);
    const int qlo = q0 + 16 * wave;
    const int krow_base = (8 * (r16 >> 2) + (r16 & 3)) * ATT_KROW;
    int koff[4], voff[2];
#pragma unroll
    for (int kk = 0; kk < 4; ++kk) koff[kk] = krow_base + (((4 * kk + g) ^ r16) << 4);
#pragma unroll
    for (int kg = 0; kg < 2; ++kg) voff[kg] = r16 * ATT_VROW + (((4 * kg + g) ^ (r16 >> 1)) << 4);
    for (int t = 0; t < ntiles; ++t) {
        const int k0 = key0_of(t);
        const LAS unsigned char* kb_ = lds + (t & 1) * ATT_BUF;
        const LAS unsigned char* vb_ = kb_ + ATT_KBYTES;
        bool causal, active = true; bool lane_on = true;
        if (MODE == 0) { causal = (k0 + 63 > qlo); active = (k0 <= qlo + 15); }
        else if (t < nown) { causal = true; active = (k0 <= qlo + 15); }
        else { causal = false; const int n = (t - nown) >> 2; lane_on = (sel >> n) & 1u; active = __any(lane_on); }
        if (active) {
#pragma unroll
            for (int c = 0; c < NC; ++c) {
                f32x4 s[2][2];
#pragma unroll
                for (int kg = 0; kg < 2; ++kg)
#pragma unroll
                    for (int kb = 0; kb < 2; ++kb) {
                        f32x4 a = (f32x4){0.f, 0.f, 0.f, 0.f};
                        const LAS unsigned char* kr = kb_ + (32 * kg + 4 * kb) * ATT_KROW;
#pragma unroll
                        for (int ks = 0; ks < (MODE == 0 ? 2 : 4); ++ks) { const int kk = (MODE == 0) ? 2 * c + ks : ks;
                            a = mfma16(*(const LAS bf16x8*)(kr + koff[kk]), qf[kk], a); }
                        s[kg][kb] = a;
                    }
                if (causal) {
#pragma unroll
                    for (int kg = 0; kg < 2; ++kg)
#pragma unroll
                        for (int kb = 0; kb < 2; ++kb)
#pragma unroll
                            for (int e = 0; e < 4; ++e) if (k0 + 32 * kg + 8 * g + 4 * kb + e > qpos) s[kg][kb][e] = -INFINITY;
                }
                if (MODE == 1 && !lane_on) {
#pragma unroll
                    for (int kg = 0; kg < 2; ++kg)
#pragma unroll
                        for (int kb = 0; kb < 2; ++kb) s[kg][kb] = (f32x4){-INFINITY, -INFINITY, -INFINITY, -INFINITY};
                }
                float tm = -INFINITY;
#pragma unroll
                for (int kg = 0; kg < 2; ++kg)
#pragma unroll
                    for (int kb = 0; kb < 2; ++kb) tm = fmaxf(tm, fmaxf(fmaxf(s[kg][kb][0], s[kg][kb][1]), fmaxf(s[kg][kb][2], s[kg][kb][3])));
                if (__any((tm - mrun[c]) * CS > 6.0f)) {
                    tm = fmaxf(tm, __shfl_xor(tm, 16)); tm = fmaxf(tm, __shfl_xor(tm, 32));
                    const float mn = fmaxf(mrun[c], tm);
                    const float alpha = __builtin_amdgcn_exp2f((mrun[c] - mn) * CS);
                    mrun[c] = mn; lsum[c] *= alpha;
#pragma unroll
                    for (int vb = 0; vb < 8; ++vb) O[c][vb] *= alpha;
                }
                const float mc = mrun[c] * CS;
                f32x4 psv = (f32x4){0.f, 0.f, 0.f, 0.f};
                bf16x8 pk[2];
#pragma unroll
                for (int kg = 0; kg < 2; ++kg) {
                    float pe[8];
#pragma unroll
                    for (int kb = 0; kb < 2; ++kb) { const f32x4 t4 = s[kg][kb] * CS - mc; f32x4 p4;
#pragma unroll
                        for (int e = 0; e < 4; ++e) { p4[e] = __builtin_amdgcn_exp2f(t4[e]); pe[4 * kb + e] = p4[e]; }
                        psv += p4; }
                    pk[kg] = __builtin_bit_cast(bf16x8, pack8(pe));
                }
                lsum[c] += (psv[0] + psv[1]) + (psv[2] + psv[3]);
#pragma unroll
                for (int vb = 0; vb < 8; ++vb) {
#pragma unroll
                    for (int kg = 0; kg < 2; ++kg)
                        O[c][vb] = mfma16(*(const LAS bf16x8*)(vb_ + 16 * vb * ATT_VROW + voff[kg]), pk[kg], O[c][vb]); }
                __builtin_amdgcn_sched_barrier(0);
            }
        }
        if (t + 1 < ntiles) store_tile((t + 1) & 1);
        if (t + 2 < ntiles) load_tile(t + 2);
        __syncthreads();
    }
    float linv[NC];
#pragma unroll
    for (int c = 0; c < NC; ++c) { float l = lsum[c]; l += __shfl_xor(l, 16); l += __shfl_xor(l, 32); linv[c] = 1.f / l;
    }
    if (MODE == 0) {
        const float i0 = linv[0], i1 = lam * linv[1];
        float ss = 0.f; f32x4 y[8];
#pragma unroll
        for (int vb = 0; vb < 8; ++vb) { y[vb] = O[0][vb] * i0 - O[NC - 1][vb] * i1; ss += (y[vb][0] * y[vb][0] + y[vb][1] * y[vb][1]) + (y[vb][2] * y[vb][2] + y[vb][3] * y[vb][3]); }
        ss += __shfl_xor(ss, 16); ss += __shfl_xor(ss, 32);
        const float r = rsqrtf(ss * (1.f / 128.f) + EPS) * 0.8f;
#pragma unroll
        for (int vb = 0; vb < 8; ++vb) { const f32x4 gv = *(const f32x4*)(gvec + 16 * vb + 4 * g); const f32x4 o = y[vb] * r * gv;
            u32x2 w; w.x = pk_bf16(o[0], o[1]); w.y = pk_bf16(o[2], o[3]);
            *(u32x2*)(outp + (size_t)qpos * DM + 16 * vb + 4 * g) = w; }
    } else {
#pragma unroll
        for (int vb = 0; vb < 8; ++vb) { const f32x4 o = O[0][vb] * linv[0];
            u32x2 w; w.x = pk_bf16(o[0], o[1]); w.y = pk_bf16(o[2], o[3]);
            *(u32x2*)(outp + (size_t)qpos * DM + 16 * vb + 4 * g) = w; }
    }
}

__device__ __forceinline__ void mlstm_scan(const Params& p, int idx) {
    unsigned char* ws = p.ws;
    const int bh = idx >> 12, ch = idx & 4095;
    const float* chs = (const float*)(ws + WS_CHS) + (size_t)bh * 64;
    const bf16_t* Cl = (const bf16_t*)(ws + WS_CLOC) + (size_t)bh * 32 * 32768 + (size_t)ch * 8;
    bf16_t* Cp = (bf16_t*)(ws + WS_CPREV) + (size_t)bh * 32 * 32768 + (size_t)ch * 8;
    const bool do_n = ch < 16;
    const float* nl = (const float*)(ws + WS_NLOC) + (size_t)bh * 32 * 128 + ch * 8;
    float* np = (float*)(ws + WS_NPREV) + (size_t)bh * 32 * 128 + ch * 8;
    float st[8], nst[8];
#pragma unroll
    for (int e = 0; e < 8; ++e) { st[e] = 0.f; nst[e] = 0.f; }
    float m = 0.f;
#pragma unroll 8
    for (int c = 0; c < 32; ++c) {
        const u32x4 cl = *(const u32x4*)(Cl + (size_t)c * 32768);
        *(u32x4*)(Cp + (size_t)c * 32768) = pack8(st);
        if (do_n) { *(f32x4*)(np + c * 128) = (f32x4){nst[0], nst[1], nst[2], nst[3]}; *(f32x4*)(np + c * 128 + 4) = (f32x4){nst[4], nst[5], nst[6], nst[7]}; }
        if (ch == 0) ((float*)(ws + WS_MPREV))[bh * 32 + c] = m;
        const float gc = chs[2 * c], ml = chs[2 * c + 1];
        const float mn = fmaxf(gc + m, ml), a = __expf(gc + m - mn), b = __expf(ml - mn);
        float f[8]; unpack8(cl, f);
#pragma unroll
        for (int e = 0; e < 8; ++e) st[e] = a * st[e] + b * f[e];
        if (do_n) { const f32x4 n0 = *(const f32x4*)(nl + c * 128), n1 = *(const f32x4*)(nl + c * 128 + 4);
#pragma unroll
            for (int e = 0; e < 4; ++e) { nst[e] = a * nst[e] + b * n0[e]; nst[4 + e] = a * nst[4 + e] + b * n1[e]; } }
        m = mn;
    }
}

__device__ __forceinline__ int swz256(int row, int ch) { return row * 256 + ((ch ^ (row & 15)) << 4); }
__device__ __forceinline__ void mlstm_out_unit(const Params& p, LAS unsigned char* lds, int unit, int tid, int lane, int wave) {
    const int c = unit & 31, h = (unit >> 5) & 3, b = unit >> 7, bh = b * 4 + h;
    unsigned char* ws = p.ws;
    LAS unsigned char* Cp = lds;
    LAS unsigned char* Vt = lds + 65536;
    LAS float* sc = (LAS float*)(lds + 131072);
    const int s0 = c * 128;
    if (wave == 0) {
        float mp = ((const float*)(ws + WS_MPREV))[bh * 32 + c];
        if (lane == 0) sc[544] = mp;
        const float* lf = (const float*)(ws + WS_LF) + (size_t)bh * SEQ + s0;
        const float* li = (const float*)(ws + WS_LI) + (size_t)bh * SEQ + s0;
        const float e0 = lf[2 * lane], e1 = lf[2 * lane + 1];
        float incl = e0 + e1;
#pragma unroll
        for (int o = 1; o < 64; o <<= 1) { const float t = __shfl_up(incl, o); if (lane >= o) incl += t; }
        const float b0 = incl - e1, b1 = incl;
        const float u0 = li[2 * lane] - b0, u1 = li[2 * lane + 1] - b1;
        float cm = fmaxf(u0, u1);
#pragma unroll
        for (int o = 1; o < 64; o <<= 1) { const float t = __shfl_up(cm, o); if (lane >= o) cm = fmaxf(cm, t); }
        float pm = __shfl_up(cm, 1); if (lane == 0) pm = -INFINITY;
        sc[160 + 2 * lane] = b0; sc[160 + 2 * lane + 1] = b1;
        sc[288 + 2 * lane] = u0; sc[288 + 2 * lane + 1] = u1;
        sc[416 + 2 * lane] = fmaxf(mp, fmaxf(pm, u0)); sc[416 + 2 * lane + 1] = fmaxf(mp, cm);
    }
    __syncthreads();
    {
        if (c > 0) {
            const bf16_t* Cpg = (const bf16_t*)(ws + WS_CPREV) + (size_t)(bh * 32 + c) * 32768;
#pragma unroll
            for (int i = 0; i < 8; ++i) { const int id = tid + NTHREADS * i; *(LAS u32x4*)(Cp + swz256(id >> 4, id & 15)) = *(const u32x4*)(Cpg + (size_t)id * 8); }
            if (tid < 128) sc[32 + tid] = ((const float*)(ws + WS_NPREV))[(size_t)(bh * 32 + c) * 128 + tid];
        }
        const bf16_t* Vtm = (const bf16_t*)(ws + WS_VTM) + ((size_t)bh * 256) * SEQ + s0;
#pragma unroll
        for (int i = 0; i < 8; ++i) { const int id = tid + NTHREADS * i, v = id >> 4, ch = id & 15;
            *(LAS u32x4*)(Vt + swz256(v, ch)) = *(const u32x4*)(Vtm + (size_t)v * SEQ + ch * 8); }
    }
    __syncthreads();
    const int r16 = lane & 15, g = lane >> 4;
    const int tl = 16 * wave + r16;
    const float mprev = sc[544], Mt = sc[416 + tl], bc = sc[160 + tl];
    const float winter = __expf(mprev - Mt);
    const bf16_t* Qm = (const bf16_t*)(ws + WS_QM) + ((size_t)bh * SEQ + s0) * 128;
    const bf16_t* Km = (const bf16_t*)(ws + WS_KM) + ((size_t)bh * SEQ + s0) * 128;
    bf16x8 qf[4];
#pragma unroll
    for (int ks = 0; ks < 4; ++ks) qf[ks] = *(const bf16x8*)(Qm + (size_t)tl * 128 + 32 * ks + 8 * g);
    f32x4 acc[16];
#pragma unroll
    for (int vb = 0; vb < 16; ++vb) acc[vb] = (f32x4){0.f, 0.f, 0.f, 0.f};
    float den = 0.f;
    if (c > 0) {
#pragma unroll
        for (int vb = 0; vb < 16; ++vb) {
#pragma unroll
            for (int ks = 0; ks < 4; ++ks) acc[vb] = mfma16(*(const LAS bf16x8*)(Cp + swz256(16 * vb + r16, 4 * ks + g)), qf[ks], acc[vb]);
            acc[vb] *= winter;
        }
        float qn = 0.f;
#pragma unroll
        for (int ks = 0; ks < 4; ++ks) { float f[8]; unpack8(__builtin_bit_cast(u32x4, qf[ks]), f);
#pragma unroll
            for (int e = 0; e < 8; ++e) qn += f[e] * sc[32 + 32 * ks + 8 * g + e]; }
        qn += __shfl_xor(qn, 16); qn += __shfl_xor(qn, 32);
        den = winter * qn * 0.25f;
    }
    const int nsb = (wave >> 1) + 1;
    for (int sb = 0; sb < nsb; ++sb) {
        f32x4 sv[2];
#pragma unroll
        for (int kb = 0; kb < 2; ++kb) {
            f32x4 a = (f32x4){0.f, 0.f, 0.f, 0.f};
            const bf16_t* kr = Km + (size_t)(32 * sb + 8 * (r16 >> 2) + 4 * kb + (r16 & 3)) * 128 + 8 * g;
#pragma unroll
            for (int ks = 0; ks < 4; ++ks) a = mfma16(*(const bf16x8*)(kr + 32 * ks), qf[ks], a);
            sv[kb] = a;
        }
        float pe[8];
#pragma unroll
        for (int kb = 0; kb < 2; ++kb)
#pragma unroll
            for (int e = 0; e < 4; ++e) { const int s = 32 * sb + 8 * g + 4 * kb + e;
                const float w = (s <= tl) ? __expf(sc[288 + s] - Mt) : 0.f; const float x = sv[kb][e] * w; pe[4 * kb + e] = x; den += x; }
        const bf16x8 pf = __builtin_bit_cast(bf16x8, pack8(pe));
#pragma unroll
        for (int vb = 0; vb < 16; ++vb) acc[vb] = mfma16(*(const LAS bf16x8*)(Vt + swz256(16 * vb + r16, 4 * sb + g)), pf, acc[vb]);
    }
    den += __shfl_xor(den, 16); den += __shfl_xor(den, 32);
    const float dinv = 1.f / fmaxf(fabsf(den), __expf(-(bc + Mt)));
    float ss = 0.f;
#pragma unroll
    for (int vb = 0; vb < 16; ++vb) { acc[vb] *= dinv; ss += (acc[vb][0] * acc[vb][0] + acc[vb][1] * acc[vb][1]) + (acc[vb][2] * acc[vb][2] + acc[vb][3] * acc[vb][3]); }
    ss += __shfl_xor(ss, 16); ss += __shfl_xor(ss, 32);
    const float r = rsqrtf(ss * (1.f / 256.f) + EPS);
    const size_t trow = (size_t)b * SEQ + s0 + tl;
    const bf16_t* ao = (const bf16_t*)(ws + WS_PROJ) + trow * EVEN_IN + 2048 + h * 256;
    bf16_t* outp = (bf16_t*)(ws + WS_CAT) + trow * DM + h * 256;
    const float* hg = p.in[12] + h * 256;
#pragma unroll
    for (int vb = 0; vb < 16; ++vb) { const int v = 16 * vb + 4 * g;
        const u32x2 aw = *(const u32x2*)(ao + v); const f32x4 gv = *(const f32x4*)(hg + v);
        const float o0 = acc[vb][0] * r * gv[0] * sigmoidf_(bf_lo(aw.x)), o1 = acc[vb][1] * r * gv[1] * sigmoidf_(bf_hi(aw.x));
        const float o2 = acc[vb][2] * r * gv[2] * sigmoidf_(bf_lo(aw.y)), o3 = acc[vb][3] * r * gv[3] * sigmoidf_(bf_hi(aw.y));
        u32x2 w; w.x = pk_bf16(o0, o1); w.y = pk_bf16(o2, o3); *(u32x2*)(outp + v) = w; }
    __syncthreads();
}
__device__ __forceinline__ void moba_post_item(const Params& p, LAS unsigned char* lds, int item, int tid) {
    const int blk = item & 15, h = (item >> 4) & 7, b = item >> 7;
    bf16_t* proj = (bf16_t*)(p.ws + WS_PROJ);
    const float* tab = (const float*)(p.ws + WS_ROPE);
    const size_t row0 = (size_t)b * SEQ + blk * 256;
    {
        const int dc = tid & 15, tg = tid >> 4;
        float a[8];
#pragma unroll
        for (int e = 0; e < 8; ++e) a[e] = 0.f;
        for (int tt = 0; tt < 8; ++tt) {
            const size_t row = row0 + tg * 8 + tt;
            const bf16_t* kp = proj + row * ODD_IN + 1024 + h * 128;
            float x[8]; unpack8(*(const u32x4*)(kp + dc * 8), x);
            if (dc < 4) {
                float y[8]; unpack8(*(const u32x4*)(kp + (dc ^ 2) * 8), y);
                const float* tb = tab + row * 48 + 16 + 16 * (dc & 1);
#pragma unroll
                for (int e = 0; e < 8; ++e) { const float cs = tb[2 * e], sn = tb[2 * e + 1];
                    x[e] = (dc < 2) ? (x[e] * cs - y[e] * sn) : (x[e] * cs + y[e] * sn); }
            }
#pragma unroll
            for (int e = 0; e < 8; ++e) a[e] += x[e];
        }
        LAS float* part = (LAS float*)lds;
#pragma unroll
        for (int e = 0; e < 8; ++e) part[tg * 128 + dc * 8 + e] = a[e];
        __syncthreads();
        if (tid < 128) { float s = 0.f;
#pragma unroll 8
            for (int i = 0; i < 32; ++i) s += part[i * 128 + tid];
            ((float*)(p.ws + WS_KMEAN))[((size_t)(b * 8 + h) * 16 + blk) * 128 + tid] = s * (1.f / 256.f); }
        __syncthreads();
    }
    {
        const int tok = tid >> 1, qk = tid & 1;
        bf16_t* ptr = proj + (row0 + tok) * ODD_IN + qk * 1024 + h * 128;
        float x1[16], x2[16], o1[16], o2[16];
        unpack8(*(const u32x4*)ptr, x1); unpack8(*(const u32x4*)(ptr + 8), x1 + 8); unpack8(*(const u32x4*)(ptr + 16), x2); unpack8(*(const u32x4*)(ptr + 24), x2 + 8);
        const float* tb = tab + (row0 + tok) * 48 + 16;
#pragma unroll
        for (int e = 0; e < 16; ++e) { const float cs = tb[2 * e], sn = tb[2 * e + 1]; o1[e] = x1[e] * cs - x2[e] * sn; o2[e] = x2[e] * cs + x1[e] * sn; }
        *(u32x4*)ptr = pack8(o1); *(u32x4*)(ptr + 8) = pack8(o1 + 8); *(u32x4*)(ptr + 16) = pack8(o2); *(u32x4*)(ptr + 24) = pack8(o2 + 8);
    }
}

__device__ __forceinline__ void sgu_unit(const Params& p, LAS unsigned char* lds, int unit, int tid, int lane, int wave) {
    const int gq = unit & 7, c = (unit >> 3) & 31, b = unit >> 8;
    const bf16_t* proj = (const bf16_t*)(p.ws + WS_PROJ);
    LAS unsigned char* vnT = lds;
    const size_t row0 = (size_t)b * SEQ + c * 128;
    {
        const int pt = 16 * wave + (lane >> 2), sub = lane & 3;
        const bf16_t* src = proj + (row0 + pt) * ODD_IN + 4096 + gq * 128 + sub * 32;
        float x[32];
#pragma unroll
        for (int i = 0; i < 4; ++i) unpack8(*(const u32x4*)(src + 8 * i), x + 8 * i);
        float s1 = 0.f;
#pragma unroll
        for (int e = 0; e < 32; ++e) { x[e] = gelu_tanh(x[e]); s1 += x[e]; }
        s1 += __shfl_xor(s1, 1); s1 += __shfl_xor(s1, 2);
        const float mu = s1 * (1.f / 128.f);
        float s2 = 0.f;
#pragma unroll
        for (int e = 0; e < 32; ++e) { x[e] -= mu; s2 += x[e] * x[e]; }
        s2 += __shfl_xor(s2, 1); s2 += __shfl_xor(s2, 2);
        const float r = rsqrtf(s2 * (1.f / 128.f) + EPS);
        const float* lg = p.in[17] + gq * 128 + sub * 32; const float* lb = p.in[18] + gq * 128 + sub * 32;
#pragma unroll
        for (int e = 0; e < 32; ++e) { const int d = sub * 32 + e;
            *(LAS bf16_t*)(vnT + d * 272 + ((((pt >> 3) ^ ((d >> 3) & 15)) << 4) + (pt & 7) * 2)) = f2bf(x[e] * r * lg[e] + lb[e]); }
    }
    __syncthreads();
    const int r16 = lane & 15, g = lane >> 4;
    const int prow = 16 * wave + r16;
    f32x4 acc[8];
#pragma unroll
    for (int db = 0; db < 8; ++db) acc[db] = (f32x4){0.f, 0.f, 0.f, 0.f};
    const float* W = p.in[19] + ((size_t)gq * 128 + prow) * 128;
    const int nrs = (wave >> 1) + 1;
    for (int rs = 0; rs < nrs; ++rs) {
        const int r0 = 32 * rs + 8 * g;
        const f32x4 w0 = *(const f32x4*)(W + r0), w1 = *(const f32x4*)(W + r0 + 4);
        float wf[8] = {w0[0], w0[1], w0[2], w0[3], w1[0], w1[1], w1[2], w1[3]};
#pragma unroll
        for (int e = 0; e < 8; ++e) if (r0 + e > prow) wf[e] = 0.f;
        const bf16x8 af = __builtin_bit_cast(bf16x8, pack8(wf));
#pragma unroll
        for (int db = 0; db < 8; ++db) { const int d = 16 * db + r16; acc[db] = mfma16(*(const LAS bf16x8*)(vnT + d * 272 + (((4 * rs + g) ^ ((d >> 3) & 15)) << 4)), af, acc[db]); }
    }
    bf16_t* cat = (bf16_t*)(p.ws + WS_CAT);
    {
        const float bs = p.in[20][gq * 128 + prow];
        const bf16_t* up = proj + (row0 + prow) * ODD_IN + 3072 + gq * 128 + 4 * g;
        bf16_t* op = cat + (row0 + prow) * DM + 1024 + gq * 128 + 4 * g;
#pragma unroll
        for (int db = 0; db < 8; ++db) { const u32x2 uw = *(const u32x2*)(up + 16 * db);
            u32x2 w; w.x = pk_bf16(gelu_tanh(bf_lo(uw.x)) * (acc[db][0] + bs), gelu_tanh(bf_hi(uw.x)) * (acc[db][1] + bs));
            w.y = pk_bf16(gelu_tanh(bf_lo(uw.y)) * (acc[db][2] + bs), gelu_tanh(bf_hi(uw.y)) * (acc[db][3] + bs));
            *(u32x2*)(op + 16 * db) = w; }
    }
    __syncthreads();
}

__device__ __forceinline__ void ins16(float (&val)[16], float v) {
#pragma unroll
    for (int i = 0; i < 16; ++i) { const float hi = fmaxf(val[i], v); v = fminf(val[i], v); val[i] = hi; }
}
template <int N>
__device__ __forceinline__ void bitonic_sort_desc(float (&v)[N]) {
#pragma unroll
    for (int k = 2; k <= N; k <<= 1)
#pragma unroll
        for (int j = k >> 1; j > 0; j >>= 1)
#pragma unroll
            for (int i = 0; i < N; ++i) { const int l = i ^ j;
                if (l > i) { const bool desc = ((i & k) == 0); const float a = v[i], b = v[l], hi = fmaxf(a, b), lo = fminf(a, b); v[i] = desc ? hi : lo; v[l] = desc ? lo : hi; } }
}
template <int XM>
__device__ __forceinline__ void merge_top16(float (&t)[16]) {
    float w[16];
#pragma unroll
    for (int i = 0; i < 16; ++i) w[i] = fmaxf(t[i], __shfl_xor(t[15 - i], XM));
#pragma unroll
    for (int j = 8; j > 0; j >>= 1)
#pragma unroll
        for (int i = 0; i < 16; ++i) { const int l = i ^ j; if (l > i) { const float a = w[i], b = w[l]; w[i] = fmaxf(a, b); w[l] = fminf(a, b); } }
#pragma unroll
    for (int i = 0; i < 16; ++i) t[i] = w[i];
}
template <bool LAST>
__device__ __forceinline__ void peer_tile(const Params& p, LAS unsigned char* lds, int layer, int tile, int tid, int lane, int wave) {
    unsigned char* ws = p.ws;
    LAS unsigned* eL = (LAS unsigned*)lds;
    LAS float* wL = (LAS float*)(lds + 32768);
    const int r16 = lane & 15, g = lane >> 4;
    const size_t tok0 = (size_t)tile * 64;
    {
        const int tg = wave & 3, hs = wave >> 2;
        const bf16_t* SK = (const bf16_t*)(ws + WS_SK) + (size_t)layer * 8 * 2 * 128 * 128;
#pragma unroll 1
        for (int hh = 0; hh < 4; ++hh) {
            const int h = 4 * hs + hh;
            int r16q = r16; asm volatile("" : "+v"(r16q));
            const bf16_t* qrow = (const bf16_t*)(ws + WS_QP) + (tok0 + 16 * tg + r16q) * DM;
            float L[2][16];
#pragma unroll 1
            for (int c = 0; c < 2; ++c) {
                bf16x8 qf[4];
#pragma unroll
                for (int ks = 0; ks < 4; ++ks) qf[ks] = *(const bf16x8*)(qrow + h * 256 + c * 128 + 32 * ks + 8 * g);
                const bf16_t* skc = SK + (size_t)(h * 2 + c) * 128 * 128;
                float scv[32];
#pragma unroll
                for (int nb = 0; nb < 8; ++nb) {
                    f32x4 a = (f32x4){0.f, 0.f, 0.f, 0.f};
#pragma unroll
                    for (int ks = 0; ks < 4; ++ks) a = mfma16(*(const bf16x8*)(skc + (size_t)(16 * nb + r16) * 128 + 32 * ks + 8 * g), qf[ks], a);
#pragma unroll
                    for (int e = 0; e < 4; ++e) { const int n = 16 * nb + 4 * g + e;
                        scv[4 * nb + e] = __uint_as_float((__float_as_uint(a[e]) & 0xffffff80u) | (unsigned)(127 - n)); }
                }
                bitonic_sort_desc<32>(scv);
                float Lc[16];
#pragma unroll
                for (int k = 0; k < 16; ++k) Lc[k] = scv[k];
                merge_top16<16>(Lc); merge_top16<32>(Lc);
#pragma unroll
                for (int k = 0; k < 16; ++k) { if (c == 0) L[0][k] = Lc[k]; else L[1][k] = Lc[k]; }
            }
            float top[16];
#pragma unroll
            for (int q = 0; q < 16; ++q) top[q] = -INFINITY;
            {
                int cix = 0;
#pragma unroll
                for (int i = 0; i < 16; ++i)
#pragma unroll
                    for (int jj = 0; jj < 16; ++jj)
                        if ((i + 1) * (jj + 1) <= 16) {
                            const float key = __uint_as_float((__float_as_uint(L[0][i] + L[1][jj]) & 0xffffff00u) | (unsigned)(i * 16 + jj));
                            top[cix >> 2] = ((cix & 3) == g) ? key : top[cix >> 2];
                            ++cix;
                        }
            }
            bitonic_sort_desc<16>(top); merge_top16<16>(top); merge_top16<32>(top);
            const float mx = top[0]; float e16[16]; float se = 0.f;
#pragma unroll
            for (int k = 0; k < 16; ++k) { e16[k] = __expf(top[k] - mx); se += e16[k]; }
            const float inv = 1.f / se;
            LAS unsigned char* ixb = (LAS unsigned char*)(lds + 98304 + wave * 2048) + lane;
#pragma unroll
            for (int q = 0; q < 16; ++q) { ixb[q * 64] = (unsigned char)(127u - (__float_as_uint(L[0][q]) & 127u)); ixb[(16 + q) * 64] = (unsigned char)(127u - (__float_as_uint(L[1][q]) & 127u)); }
#pragma unroll
            for (int k = 0; k < 16; ++k) {
                const unsigned id = __float_as_uint(top[k]) & 0xffu; const unsigned ii = id >> 4, jj = id & 15u;
                const unsigned ex = (unsigned)ixb[ii * 64] * 128u + (unsigned)ixb[(16 + jj) * 64];
                if (g == 0) { eL[(16 * tg + r16) * 128 + h * 16 + k] = ex; wL[(16 * tg + r16) * 128 + h * 16 + k] = e16[k] * inv; }
            }
        }
    }
    __syncthreads();
    { unsigned z2 = 0; asm volatile("" : "+s"(z2)); lane = (int)__builtin_amdgcn_mbcnt_hi(~0u, __builtin_amdgcn_mbcnt_lo(~0u, z2)); }
    const int g8 = lane >> 3, j8 = lane & 7;
    const bool b0 = lane & 1, b1 = (lane >> 1) & 1, b2 = (lane >> 2) & 1;
    LAS float* part = (LAS float*)(lds + 65536);
    const unsigned char* U8 = ws + WS_U + (size_t)layer * 16384 * 2048;
#pragma unroll
    for (int i = 0; i < 16; ++i) part[wave * 1024 + lane + 64 * i] = 0.f;
#define PEER_ISSUE(dst, base, tl_, hf_, gq) do { _Pragma("unroll") for (int bb = 0; bb < 8; ++bb) { const unsigned ex_ = eL[(tl_) * 128 + 64 * (hf_) + 8 * bb + (gq)]; \
        dst[bb] = *(const u32x4*)((base) + (size_t)ex_ * 128); } } while (0)
#define PEER_UDOT(src, hf_) do { float pd[8]; \
        _Pragma("unroll") for (int bb = 0; bb < 8; ++bb) { f32x2_t a2 = {0.f, 0.f}; asm volatile("" : "+v"(src[bb])); \
            _Pragma("unroll") for (int d = 0; d < 4; ++d) { const int w = (int)src[bb][d]; \
                const f32x2_t lo = __builtin_amdgcn_cvt_pk_f32_fp8(w, false), hi = __builtin_amdgcn_cvt_pk_f32_fp8(w, true); \
                a2 = __builtin_elementwise_fma(lo, xp[2 * d], a2); a2 = __builtin_elementwise_fma(hi, xp[2 * d + 1], a2); } \
            pd[bb] = a2[0] + a2[1]; __builtin_amdgcn_sched_barrier(0); } \
        float r4[4], r2[2]; \
        _Pragma("unroll") for (int i = 0; i < 4; ++i) r4[i] = (b2 ? pd[4 + i] : pd[i]) + __shfl_xor(b2 ? pd[i] : pd[4 + i], 4); \
        _Pragma("unroll") for (int i = 0; i < 2; ++i) r2[i] = (b1 ? r4[2 + i] : r4[i]) + __shfl_xor(b1 ? r4[i] : r4[2 + i], 2); \
        const float r1 = (b0 ? r2[1] : r2[0]) + __shfl_xor(b0 ? r2[0] : r2[1], 1); \
        part[tl * 128 + 64 * (hf_) + 8 * j8 + g8] += r1; } while (0)
#pragma unroll 1
    for (int cb = 0; cb < 16; ++cb) {
        const unsigned char* Ucb = U8 + (size_t)cb * (16384 * 128) + 16 * j8;
        const bf16_t* xbase = (const bf16_t*)(ws + WS_HN) + (tok0 + 8 * wave) * DM + cb * 128 + 16 * j8;
        u32x4 ua[8], ub[8], xc[2];
        PEER_ISSUE(ua, Ucb, 8 * wave, 0, g8);
        xc[0] = *(const u32x4*)xbase; xc[1] = *(const u32x4*)(xbase + 8);
#pragma unroll 1
        for (int tt = 0; tt < 8; ++tt) {
            const int tl = 8 * wave + tt;
            PEER_ISSUE(ub, Ucb, tl, 1, g8);
            float xf[16]; unpack8(xc[0], xf); unpack8(xc[1], xf + 8);
            f32x2_t xp[8];
#pragma unroll
            for (int i = 0; i < 8; ++i) xp[i] = (f32x2_t){xf[2 * i], xf[2 * i + 1]};
            if (tt + 1 < 8) { xc[0] = *(const u32x4*)(xbase + (size_t)(tt + 1) * DM); xc[1] = *(const u32x4*)(xbase + (size_t)(tt + 1) * DM + 8); }
            __builtin_amdgcn_sched_barrier(0);
            PEER_UDOT(ua, 0);
            if (tt + 1 < 8) PEER_ISSUE(ua, Ucb, tl + 1, 0, g8);
            __builtin_amdgcn_sched_barrier(0);
            PEER_UDOT(ub, 1);
        }
    }
#undef PEER_UDOT
    unsigned char* wsw = ws; asm volatile("" : "+s"(wsw));
    const float* SCU = (const float*)(wsw + WS_SCL) + layer * 16384;
    const float* SCV = (const float*)(wsw + WS_SCL) + 32768 + layer * 16384;
#pragma unroll 1
    for (int tt = 0; tt < 8; ++tt) { const int tl = 8 * wave + tt;
#pragma unroll
        for (int i = 0; i < 2; ++i) { const int pk_ = tl * 128 + lane + 64 * i; const unsigned ex = eL[pk_];
            wL[pk_] = wL[pk_] * gelu_tanh(part[pk_] * SCU[ex]) * SCV[ex]; } }
    unsigned char* wsv = ws; asm volatile("" : "+s"(wsv));
    const unsigned char* V8 = wsv + WS_V + (size_t)layer * 16384 * 2048;
    bf16_t* OUTT = (bf16_t*)(wsv + WS_PROJ);
    int lane_v = lane; asm volatile("" : "+v"(lane_v));
    const int g8v = lane_v >> 3, j8v = lane_v & 7; const bool c3 = (lane_v >> 3) & 1, c4 = (lane_v >> 4) & 1, c5 = (lane_v >> 5) & 1;
#define PEER_VACC(src, hf_) do { _Pragma("unroll") for (int bb = 0; bb < 8; ++bb) { const float wq = wL[tl * 128 + 64 * (hf_) + 8 * bb + g8v]; asm volatile("" : "+v"(src[bb])); \
            const f32x2_t wq2 = {wq, wq}; \
            _Pragma("unroll") for (int d = 0; d < 4; ++d) { const int w = (int)src[bb][d]; \
                const f32x2_t lo = __builtin_amdgcn_cvt_pk_f32_fp8(w, false), hi = __builtin_amdgcn_cvt_pk_f32_fp8(w, true); \
                ac2[2 * d] = __builtin_elementwise_fma(lo, wq2, ac2[2 * d]); ac2[2 * d + 1] = __builtin_elementwise_fma(hi, wq2, ac2[2 * d + 1]); } \
            __builtin_amdgcn_sched_barrier(0); } } while (0)
#pragma unroll 1
    for (int cb = 0; cb < 16; ++cb) {
        const unsigned char* Vcb = V8 + (size_t)cb * (16384 * 128) + 16 * j8v;
        u32x4 va[8], vb[8];
        PEER_ISSUE(va, Vcb, 8 * wave, 0, g8v);
#pragma unroll 1
        for (int tt = 0; tt < 8; ++tt) {
            const int tl = 8 * wave + tt; const size_t tok = tok0 + tl;
            PEER_ISSUE(vb, Vcb, tl, 1, g8v);
            f32x2_t ac2[8];
#pragma unroll
            for (int c = 0; c < 8; ++c) ac2[c] = (f32x2_t){0.f, 0.f};
            __builtin_amdgcn_sched_barrier(0);
            PEER_VACC(va, 0);
            if (tt + 1 < 8) PEER_ISSUE(va, Vcb, tl + 1, 0, g8v);
            __builtin_amdgcn_sched_barrier(0);
            PEER_VACC(vb, 1);
            float ac[16];
#pragma unroll
            for (int c = 0; c < 8; ++c) { ac[2 * c] = ac2[c][0]; ac[2 * c + 1] = ac2[c][1]; }
            float q8[8], q4[4], q2[2];
#pragma unroll
            for (int i = 0; i < 8; ++i) q8[i] = (c5 ? ac[8 + i] : ac[i]) + __shfl_xor(c5 ? ac[i] : ac[8 + i], 32);
#pragma unroll
            for (int i = 0; i < 4; ++i) q4[i] = (c4 ? q8[4 + i] : q8[i]) + __shfl_xor(c4 ? q8[i] : q8[4 + i], 16);
#pragma unroll
            for (int i = 0; i < 2; ++i) q2[i] = (c3 ? q4[2 + i] : q4[i]) + __shfl_xor(c3 ? q4[i] : q4[2 + i], 8);
            *(unsigned*)(OUTT + tok * DM + cb * 128 + 16 * j8v + 2 * g8v) = pk_bf16(q2[0], q2[1]);
        }
    }
#undef PEER_VACC
#undef PEER_ISSUE
    asm volatile("s_waitcnt vmcnt(0)" ::: "memory");
    unsigned char* wse = ws; asm volatile("" : "+s"(wse));
    const float* mod = (const float*)(wse + WS_MOD) + (size_t)layer * 4 * 12288;
    const bf16_t* OUTE = (const bf16_t*)(wse + WS_PROJ);
    int lane_e = lane; asm volatile("" : "+v"(lane_e));
    const int bt = (int)(tok0 / SEQ);
    float gv2[32], av[32], sv2[32];
    {
        const float* g2 = mod + (size_t)bt * 12288 + 10240 + 16 * lane_e;
        const float* modn = (const float*)(wse + WS_MOD) + (size_t)(LAST ? layer : layer + 1) * 4 * 12288 + (size_t)bt * 12288 + 16 * lane_e;
        const float* ng = (LAST ? p.in[6] : p.in[5] + (size_t)(layer + 1) * 2 * DM) + 16 * lane_e;
#pragma unroll
        for (int j = 0; j < 2; ++j)
#pragma unroll
            for (int d = 0; d < 4; ++d) { const f32x4 a = *(const f32x4*)(g2 + 1024 * j + 4 * d), g = *(const f32x4*)(ng + 1024 * j + 4 * d);
                f32x4 sc = (f32x4){0.f, 0.f, 0.f, 0.f}, sh = (f32x4){0.f, 0.f, 0.f, 0.f};
                if (!LAST) { sc = *(const f32x4*)(modn + 2048 + 1024 * j + 4 * d); sh = *(const f32x4*)(modn + 1024 * j + 4 * d); }
#pragma unroll
                for (int e = 0; e < 4; ++e) { gv2[16 * j + 4 * d + e] = a[e]; av[16 * j + 4 * d + e] = g[e] * (1.f + sc[e]); sv2[16 * j + 4 * d + e] = sh[e]; } }
    }
#pragma unroll 1
    for (int tt = 0; tt < 8; ++tt) {
        const int tl = 8 * wave + tt; const size_t tok = tok0 + tl;
        float* hrow = p.out + tok * DM + 16 * lane_e;
        bf16_t* hb = (bf16_t*)(wse + WS_H) + tok * DM + 16 * lane_e;
        const bf16_t* orow = OUTE + tok * DM + 16 * lane_e;
        float hv[32]; float ss = 0.f;
#pragma unroll
        for (int j = 0; j < 2; ++j) {
            float of[16]; unpack8(*(const u32x4*)(orow + 1024 * j), of); unpack8(*(const u32x4*)(orow + 1024 * j + 8), of + 8);
            float hf[16]; unpack8(*(const u32x4*)(hb + 1024 * j), hf); unpack8(*(const u32x4*)(hb + 1024 * j + 8), hf + 8);
#pragma unroll
            for (int e = 0; e < 16; ++e) { const float hh = hf[e] + gv2[16 * j + e] * of[e]; hv[16 * j + e] = hh; ss += hh * hh; }
        }
        const float r = rsqrtf(wave_sum(ss) * (1.f / DM) + EPS);
        if (LAST) {
#pragma unroll
            for (int j = 0; j < 2; ++j)
#pragma unroll
                for (int d = 0; d < 4; ++d) { f32x4 o;
#pragma unroll
                    for (int e = 0; e < 4; ++e) o[e] = hv[16 * j + 4 * d + e] * r * av[16 * j + 4 * d + e];
                    *(f32x4*)(hrow + 1024 * j + 4 * d) = o; }
        } else {
            bf16_t* hn = (bf16_t*)(wse + WS_HN) + tok * DM + 16 * lane_e;
#pragma unroll
            for (int j = 0; j < 2; ++j) {
                float y[16];
#pragma unroll
                for (int e = 0; e < 16; ++e) y[e] = hv[16 * j + e] * r * av[16 * j + e] + sv2[16 * j + e];
                *(u32x4*)(hb + 1024 * j) = pack8(hv + 16 * j); *(u32x4*)(hb + 1024 * j + 8) = pack8(hv + 16 * j + 8);
                *(u32x4*)(hn + 1024 * j) = pack8(y); *(u32x4*)(hn + 1024 * j + 8) = pack8(y + 8);
            }
        }
    }
    __syncthreads();
}
template <class Epi>
__device__ __forceinline__ void run_gemm(LAS unsigned char* lds, const bf16_t* A, const bf16_t* Bt, int N, const Epi& E, int tid, int bid, int G) {
    pg8::Gemm gm{A, Bt, NT, N, DM}; pg8::StaticOrder S; S.init(NT, N, G, bid);
    pg8::gemm_phase<Epi, pg8::StaticOrder, true, true>(lds, gm, S, E, tid);
}


typedef __attribute__((address_space(4))) const unsigned char* karg_t;
__device__ __forceinline__ Params load_params() {
    int z; asm volatile("s_mov_b32 %0, 0" : "=s"(z));
    karg_t ka = (karg_t)__builtin_amdgcn_kernarg_segment_ptr() + z;
    Params q;
#pragma unroll
    for (int k = 0; k < 25; ++k) q.in[k] = *(const float* const __attribute__((address_space(4)))*)(ka + 8 * k);
    q.out = *(float* const __attribute__((address_space(4)))*)(ka + 200);
    q.ws = *(unsigned char* const __attribute__((address_space(4)))*)(ka + 208);
    q.pad = 0;
    return q;
}

constexpr size_t WS_BAR = WS_MISC + 65536;
constexpr int BAR_LDS_OFF = LDS_BYTES - 64;
#define GRID_BAR() do { const Params pb = load_params(); XcdBarrier xb; xb.bar = (unsigned*)(pb.ws + WS_BAR); xb.x = xb_xcc_id(); xb.st = (volatile LAS unsigned*)(lds + BAR_LDS_OFF); xcd_barrier(xb); } while (0)

__global__ void __launch_bounds__(NTHREADS, 2) fwd_megakernel(Params p_unused) {
    extern __shared__ __attribute__((aligned(16))) unsigned char lds_raw[];
    LAS unsigned char* lds = (LAS unsigned char*)lds_raw;
    cg::grid_group grid = cg::this_grid();
    const int wave_s = __builtin_amdgcn_readfirstlane(threadIdx.x >> 6);

    {
        if (threadIdx.x < 16) ((volatile LAS unsigned*)(lds + BAR_LDS_OFF))[threadIdx.x] = 0u;
        if (blockIdx.x == 0) { const Params pz = load_params(); unsigned* bw = (unsigned*)(pz.ws + WS_BAR);
            for (int i = threadIdx.x; i < XCD_BAR_WORDS + 128; i += NTHREADS) __hip_atomic_store(bw + i, 0u, __ATOMIC_RELAXED, __HIP_MEMORY_SCOPE_AGENT); }
        __syncthreads();
    }
#define PHASE_BEGIN const Params p = load_params(); unsigned char* ws = p.ws; (void)ws; \
    int bid = blockIdx.x, G = gridDim.x; unsigned zq = 0; asm volatile("" : "+s"(bid), "+s"(G), "+s"(zq)); \
    int tid = (wave_s << 6) | (int)__builtin_amdgcn_mbcnt_hi(~0u, __builtin_amdgcn_mbcnt_lo(~0u, zq)); asm volatile("" : "+v"(tid)); const int lane = tid & 63, wave = wave_s; (void)lane; (void)wave; \


    { PHASE_BEGIN phase0a(p, lds, tid, lane, wave, bid, G); }
    grid.sync(); { const Params pb = load_params(); (void)xcd_barrier_post((unsigned*)(pb.ws + WS_BAR), (volatile LAS unsigned*)(lds + BAR_LDS_OFF)); }
    { PHASE_BEGIN phase_rows<true>(p, lds, p.in[0], p.in[5], (const float*)(ws + WS_MOD), 2048, 0, tid, lane, wave, bid, G); }
    GRID_BAR();
    { PHASE_BEGIN EpiProj<0> E{(bf16_t*)(ws + WS_PROJ), EVEN_IN, (bf16_t*)(ws + WS_VTM), (bf16_t*)(ws + WS_VTD)}; run_gemm(lds, (const bf16_t*)(ws + WS_HN), (const bf16_t*)(ws + WS_WIN0), EVEN_IN, E, tid, bid, G); }
    GRID_BAR();
    { PHASE_BEGIN
      for (int it = bid; it < 1024; it += G) {
        if (it < 512) mlstm_cloc_unit(p, lds, it, tid, lane, wave); else diff_post_item(p, lds, it - 512, tid);
      } }
    GRID_BAR();
    {
        PHASE_BEGIN
        {
            for (int idx = bid * NTHREADS + tid; idx < 65536; idx += G * NTHREADS) mlstm_scan(p, idx);
            asm volatile("s_waitcnt vmcnt(0)" ::: "memory");
            __syncthreads();
            if (tid == 0) { __builtin_amdgcn_fence(__ATOMIC_RELEASE, "agent"); asm volatile("s_waitcnt vmcnt(0)" ::: "memory");
                __hip_atomic_fetch_add((unsigned*)(ws + WS_BAR) + XCD_BAR_WORDS + 64, 1u, __ATOMIC_RELAXED, __HIP_MEMORY_SCOPE_AGENT); }
        }
        const float lam = ((const float*)(ws + WS_MISC))[0];
        for (int pr = bid; pr < 512; pr += G) {
            const int bh = pr >> 4, jj = pr & 15, b = bh >> 3, h = bh & 7;
            const bf16_t* PROJ = (const bf16_t*)(ws + WS_PROJ);
            const bf16_t* Qb = PROJ + (size_t)b * SEQ * EVEN_IN + 3072 + h * 128;
            const bf16_t* Kb = PROJ + (size_t)b * SEQ * EVEN_IN + 4096 + h * 128;
            const bf16_t* Vt = (const bf16_t*)(ws + WS_VTD) + ((size_t)bh * 128) * SEQ;
            bf16_t* outp = (bf16_t*)(ws + WS_CAT) + (size_t)b * SEQ * DM + 1024 + h * 128;
#pragma unroll 1
            for (int rep = 0; rep < 2; ++rep)
                attn_unit<0>(lds, Qb, Kb, EVEN_IN, Vt, rep ? jj : 31 - jj, nullptr, outp, p.in[14] + h * 128, lam, tid, lane, wave);
        }
    }

    {
        PHASE_BEGIN
        if (tid == 0) {
            unsigned* cnt = (unsigned*)(ws + WS_BAR) + XCD_BAR_WORDS + 64; unsigned sp = 0;
            while (__hip_atomic_load(cnt, __ATOMIC_RELAXED, __HIP_MEMORY_SCOPE_AGENT) < (unsigned)G && ++sp < (1u << 22)) __builtin_amdgcn_s_sleep(2);
            __builtin_amdgcn_fence(__ATOMIC_ACQUIRE, "agent"); asm volatile("s_waitcnt vmcnt(0)" ::: "memory");
        }
        __syncthreads();
        for (int pr = bid; pr < 256; pr += G) {
            const int bh = pr >> 4, cc = pr & 15;
#pragma unroll 1
            for (int rep = 0; rep < 2; ++rep) mlstm_out_unit(p, lds, bh * 32 + (rep ? cc : 31 - cc), tid, lane, wave);
        }
    }
    GRID_BAR();
    { PHASE_BEGIN EpiResid<true> E{p.in[0], (bf16_t*)(ws + WS_H), (const float*)(ws + WS_MOD) + 4096}; run_gemm(lds, (const bf16_t*)(ws + WS_CAT), (const bf16_t*)(ws + WS_WOUT0), DM, E, tid, bid, G); }
    GRID_BAR();
    { PHASE_BEGIN phase_rows<false>(p, lds, ws + WS_H, p.in[5] + DM, (const float*)(ws + WS_MOD), 8192, 6144, tid, lane, wave, bid, G); }
    GRID_BAR();
    { PHASE_BEGIN EpiStoreBf16 E{(bf16_t*)(ws + WS_QP), DM}; run_gemm(lds, (const bf16_t*)(ws + WS_HN), (const bf16_t*)(ws + WS_WQ0), DM, E, tid, bid, G); }
    GRID_BAR();
    { PHASE_BEGIN for (int tile = bid; tile < 256; tile += G) peer_tile<false>(p, lds, 0, tile, tid, lane, wave); }
    GRID_BAR();
    { PHASE_BEGIN EpiProj<1> E{(bf16_t*)(ws + WS_PROJ), ODD_IN, (bf16_t*)(ws + WS_VTM), (bf16_t*)(ws + WS_VTD)}; run_gemm(lds, (const bf16_t*)(ws + WS_HN), (const bf16_t*)(ws + WS_WIN1), ODD_IN, E, tid, bid, G); }
    GRID_BAR();
    { PHASE_BEGIN
      for (int it = bid; it < 1536; it += G) {
        if (it < 512) moba_post_item(p, lds, it, tid); else sgu_unit(p, lds, it - 512, tid, lane, wave);
      } }
    GRID_BAR();
    { PHASE_BEGIN
      for (int pr = bid; pr < 512; pr += G) {
        const int bh = pr >> 4, jj = pr & 15, b = bh >> 3, h = bh & 7;
        const bf16_t* PROJ = (const bf16_t*)(ws + WS_PROJ);
        const bf16_t* Qb = PROJ + (size_t)b * SEQ * ODD_IN + h * 128;
        const bf16_t* Kb = PROJ + (size_t)b * SEQ * ODD_IN + 1024 + h * 128;
        const bf16_t* Vt = (const bf16_t*)(ws + WS_VTD) + ((size_t)bh * 128) * SEQ;
        const float* km = (const float*)(ws + WS_KMEAN) + (size_t)bh * 16 * 128;
        bf16_t* outp = (bf16_t*)(ws + WS_CAT) + (size_t)b * SEQ * DM + h * 128;
#pragma unroll 1
        for (int rep = 0; rep < 2; ++rep)
            attn_unit<1>(lds, Qb, Kb, ODD_IN, Vt, rep ? jj : 31 - jj, km, outp, nullptr, 0.f, tid, lane, wave);
      } }
    GRID_BAR();
    { PHASE_BEGIN EpiResid<false> E{(const bf16_t*)(ws + WS_H), (bf16_t*)(ws + WS_H), (const float*)(ws + WS_MOD) + 4 * 12288 + 4096}; run_gemm(lds, (const bf16_t*)(ws + WS_CAT), (const bf16_t*)(ws + WS_WOUT1), DM, E, tid, bid, G); }
    GRID_BAR();
    { PHASE_BEGIN phase_rows<false>(p, lds, ws + WS_H, p.in[5] + 3 * DM, (const float*)(ws + WS_MOD) + 4 * 12288, 8192, 6144, tid, lane, wave, bid, G); }
    GRID_BAR();
    { PHASE_BEGIN EpiStoreBf16 E{(bf16_t*)(ws + WS_QP), DM}; run_gemm(lds, (const bf16_t*)(ws + WS_HN), (const bf16_t*)(ws + WS_WQ1), DM, E, tid, bid, G); }
    GRID_BAR();
    { PHASE_BEGIN for (int tile = bid; tile < 256; tile += G) peer_tile<true>(p, lds, 1, tile, tid, lane, wave); }

}

extern "C" void kernel_launch(void* const* d_in, const int* in_sizes, int n_in, void* d_out, int out_size, void* d_ws, size_t ws_size,
                              hipStream_t stream) {
    static int grid_blocks = 0;
    if (!grid_blocks) {
        int dev = 0, cus = 0, per_cu = 0;
        (void)hipGetDevice(&dev);
        (void)hipDeviceGetAttribute(&cus, hipDeviceAttributeMultiprocessorCount, dev);
        (void)hipFuncSetAttribute((const void*)fwd_megakernel, hipFuncAttributeMaxDynamicSharedMemorySize, LDS_BYTES);
        (void)hipOccupancyMaxActiveBlocksPerMultiprocessor(&per_cu, (const void*)fwd_megakernel, NTHREADS, LDS_BYTES);
        if (per_cu < 1) { fprintf(stderr, "kernel_launch: occupancy query says %d blocks per CU\n", per_cu); per_cu = 1; }
        grid_blocks = cus;
        if (n_in != 25 || ws_size < WS_END) fprintf(stderr, "kernel_launch: unexpected n_in %d or ws_size %zu (< %zu)\n", n_in, ws_size, (size_t)WS_END);
    }
    Params p{};
    for (int i = 0; i < 25 && i < n_in; ++i) p.in[i] = (const float*)d_in[i];
    p.out = (float*)d_out; p.ws = (unsigned char*)d_ws;
    void* args[] = {&p};
    hipError_t e = hipLaunchCooperativeKernel((const void*)fwd_megakernel, dim3(grid_blocks), dim3(NTHREADS), args, LDS_BYTES, stream);
    if (e != hipSuccess) fprintf(stderr, "cooperative launch failed: %s (grid %d)\n", hipGetErrorString(e), grid_blocks);
}
```

```cpp
#include <hip/hip_runtime.h>
#include <hip/hip_cooperative_groups.h>
#include <cstdio>
#include <cstdint>
namespace cg = cooperative_groups;
#ifndef STOP_AFTER
#define STOP_AFTER 99
#define DUMP_STAGE 0
#endif
#define PSB 0
#define PST 0
#define ATT_ABL 0
#define TSCALE 4.f
#ifndef TSEL_A
#define TSEL_A -1
#define TSEL_B -1
#endif
#define PEER_STAMP do { if (TSEL_A >= 0 && blockIdx.x == PSB && threadIdx.x == PST) ((unsigned long long*)(p.ws + (512 * 1024) + 1024))[20] = __builtin_amdgcn_s_memrealtime(); } while (0)
namespace pg8 {
#define PG8_LAS __attribute__((address_space(3)))
typedef unsigned short bf16_t;
typedef short bf16x8 __attribute__((ext_vector_type(8)));
typedef float f32x4 __attribute__((ext_vector_type(4)));
typedef unsigned u32x4 __attribute__((ext_vector_type(4)));
typedef int i32x4 __attribute__((ext_vector_type(4)));
constexpr int BM = 256, BK = 64, HALF = 128, HTB = HALF * BK * 2  , STAGE_BYTES = 8 * HTB, NXCD = 8, WGM = 8;

__host__ __device__ __forceinline__ int lds_byte(int r, int c) { const int st = (r >> 4) * 2 + (c >> 5), rr = r & 15, cc = c & 31, ob = rr * 64 + cc * 2; return st * 1024 + (ob ^ (((ob >> 9) & 1) << 5)); }
__host__ __device__ __forceinline__ void stage_rc(int b, int& R, int& C) { const int st = b / 1024, sb = b % 1024, swz = sb ^ (((sb >> 9) & 1) << 5); R = (st >> 1) * 16 + swz / 64; C = (st & 1) * 32 + (swz % 64) / 2; }
__host__ __device__ __forceinline__ int perm32(int rho) { const int n = rho >> 4, i = rho & 15; return 8 * (i >> 2) + 4 * n + (i & 3); }

struct Unit { int pm, pn; };
struct Gemm { const bf16_t* A; const bf16_t* Bt; int M, N, K; const float* sa; const float* sw; };

struct StaticOrder {
    int nM, nN, nwg, G, c;
    __host__ __device__ void init(int M, int N, int G_, int c_) { nM = M / BM; nN = N / BM; nwg = nM * nN; G = G_; c = c_; }
    __host__ __device__ bool next(int i, Unit& u) const {
        const long L = (long)i * G + c; if (L >= nwg) return false;
        int wgid = (int)L; { const int q = nwg / NXCD, r = nwg % NXCD, xcd = wgid % NXCD, off = wgid / NXCD; wgid = (xcd < r ? xcd * (q + 1) : r * (q + 1) + (xcd - r) * q) + off; }
        const int nig = WGM * nN, gid = wgid / nig, fm = gid * WGM, gsz = (nM - fm) < WGM ? (nM - fm) : WGM;
        u.pm = fm + ((wgid % nig) % gsz); u.pn = (wgid % nig) / gsz; return true;
    }
    __device__ __forceinline__ void a_ready(const Unit&) const {}
    __device__ __forceinline__ void done(const Unit&) const {}
};
template <class Epi, class Sched, bool ALIGN_EPI = false, bool SP2 = false, bool I8 = false>
__device__ __forceinline__ void gemm_phase(PG8_LAS unsigned char* lds, const Gemm g, const Sched& S, const Epi& E, const int tid) {
    const int wid = __builtin_amdgcn_readfirstlane(tid >> 6), lane = tid & 63, wr = wid >> 2, wc = wid & 3, fr = lane & 15, fq = lane >> 4;
    const int K = g.K, nt = K / BK;
    unsigned voffA[2], voffB[2];
#pragma unroll
    for (int i = 0; i < 2; ++i) { int R, C; stage_rc(tid * 16 + i * 8192, R, C); const int Rb = Epi::PERM ? ((R & ~31) + perm32(R & 31)) : R;
        voffA[i] = (unsigned)(R * K + C) * 2u; voffB[i] = (unsigned)(Rb * K + C) * 2u; }
    const size_t kstep = (size_t)(BK * 2);
    const size_t hstep = (size_t)HALF * K * 2;
    const size_t tstep = 2 * hstep;
    const unsigned ldsw = (unsigned)wid * 1024u;
    const int aoff = lds_byte(wr * 64 + fr, fq * 8), boff = lds_byte(wc * 32 + fr, fq * 8);
#define PG8_SA(b, h) (((b) * 2 + (h)) * HTB)
#define PG8_SB(b, h) ((4 + (b) * 2 + (h)) * HTB)
#define PG8_STAGE(bufoff, gbase, voff) do { _Pragma("unroll") for (int _i = 0; _i < 2; ++_i) \
        __builtin_amdgcn_global_load_lds((const unsigned*)((const char*)(gbase) + (voff)[_i]), (PG8_LAS unsigned*)(lds + (bufoff) + ldsw + _i * 8192), 16, 0, 0); } while (0)
#define PG8_LDA(dst, b, h) do { _Pragma("unroll") for (int m = 0; m < 4; ++m) _Pragma("unroll") for (int k = 0; k < 2; ++k) dst[m][k] = *(const PG8_LAS bf16x8*)(lds + PG8_SA(b, h) + aoff + m * 2048 + k * 1024); } while (0)
#define PG8_LDB(dst, b, h) do { _Pragma("unroll") for (int n = 0; n < 2; ++n) _Pragma("unroll") for (int k = 0; k < 2; ++k) dst[n][k] = *(const PG8_LAS bf16x8*)(lds + PG8_SB(b, h) + boff + n * 2048 + k * 1024); } while (0)
#define PG8_MMA(ai, bj, At, Bt) do { __builtin_amdgcn_s_setprio(1); _Pragma("unroll") for (int m = 0; m < 4; ++m) _Pragma("unroll") for (int n = 0; n < 2; ++n) _Pragma("unroll") for (int k = 0; k < 2; ++k) \
        { if constexpr (I8) acc[ai][bj][m][n] = __builtin_bit_cast(f32x4, __builtin_amdgcn_mfma_i32_16x16x64_i8(__builtin_bit_cast(i32x4, Bt[n][k]), __builtin_bit_cast(i32x4, At[m][k]), __builtin_bit_cast(i32x4, acc[ai][bj][m][n]), 0, 0, 0)); \
          else acc[ai][bj][m][n] = __builtin_amdgcn_mfma_f32_16x16x32_bf16(Bt[n][k], At[m][k], acc[ai][bj][m][n], 0, 0, 0); } __builtin_amdgcn_s_setprio(0); } while (0)
#define PG8_WAIT_V(n) asm volatile("s_waitcnt vmcnt(" #n ")" ::: "memory")
#define PG8_WAIT_L(n) asm volatile("s_waitcnt lgkmcnt(" #n ")" ::: "memory")
#define PG8_BAR __builtin_amdgcn_s_barrier()
#define PG8_SCHED __builtin_amdgcn_sched_barrier(0)
    Unit cur, nxt; int ui = 0;
    if (!S.next(0, cur)) return;
    f32x4 acc[2][2][4][2];
#pragma unroll
    for (int a = 0; a < 2; ++a)
#pragma unroll
        for (int b = 0; b < 2; ++b)
#pragma unroll
            for (int m = 0; m < 4; ++m)
#pragma unroll
                for (int n = 0; n < 2; ++n) acc[a][b][m][n] = (f32x4){0.f, 0.f, 0.f, 0.f};
    bf16x8 At[4][2], B0[2][2], B1[2][2];
    const char* cA = (const char*)g.A + (size_t)cur.pm * tstep; const char* cB = (const char*)g.Bt + (size_t)cur.pn * tstep;
    S.a_ready(cur);
    if constexpr (SP2) {
        PG8_STAGE(PG8_SB(0, 0), cB, voffB); PG8_STAGE(PG8_SB(0, 1), cB + hstep, voffB); PG8_STAGE(PG8_SA(0, 0), cA, voffA); PG8_STAGE(PG8_SA(0, 1), cA + hstep, voffA);
        if (wr == 1) PG8_BAR;
        PG8_WAIT_V(2); PG8_BAR;
        PG8_STAGE(PG8_SB(1, 0), cB + kstep, voffB); PG8_STAGE(PG8_SA(1, 0), cA + kstep, voffA); PG8_STAGE(PG8_SB(1, 1), cB + hstep + kstep, voffB);
        PG8_WAIT_V(6); PG8_BAR;
    } else {
        PG8_STAGE(PG8_SB(0, 0), cB, voffB); PG8_STAGE(PG8_SA(0, 0), cA, voffA); PG8_STAGE(PG8_SB(0, 1), cB + hstep, voffB); PG8_STAGE(PG8_SA(0, 1), cA + hstep, voffA);
        if (wr == 1) PG8_BAR;
        PG8_WAIT_V(4); PG8_BAR;
        PG8_STAGE(PG8_SB(1, 0), cB + kstep, voffB); PG8_STAGE(PG8_SA(1, 0), cA + kstep, voffA); PG8_STAGE(PG8_SB(1, 1), cB + hstep + kstep, voffB);
        PG8_WAIT_V(6); PG8_BAR;
    }
    for (;;) {
        const bool has_next = S.next(ui + 1, nxt);
        const char* nA = has_next ? (const char*)g.A + (size_t)nxt.pm * tstep : cA; const char* nB = has_next ? (const char*)g.Bt + (size_t)nxt.pn * tstep : cB;
        for (int t = 0; t < nt; t += 2) {
            const bool last = (t == nt - 2);
            const char* a1 = cA + (size_t)(t + 1) * kstep;
            const char* a2 = last ? nA : cA + (size_t)(t + 2) * kstep; const char* b2 = last ? nB : cB + (size_t)(t + 2) * kstep;
            const char* a3 = a2 + kstep; const char* b3 = b2 + kstep;
            if (last && has_next) S.a_ready(nxt);
            if constexpr (SP2) {
            PG8_LDB(B0, 0, 0); PG8_LDB(B1, 0, 1); PG8_SCHED; PG8_LDA(At, 0, 0); PG8_STAGE(PG8_SA(1, 1), a1 + hstep, voffA);
            PG8_WAIT_V(8); PG8_WAIT_L(0); PG8_BAR; PG8_MMA(0, 0, At, B0); PG8_MMA(0, 1, At, B1); PG8_BAR; PG8_SCHED;
            PG8_LDA(At, 0, 1); PG8_STAGE(PG8_SB(0, 0), b2, voffB); PG8_STAGE(PG8_SB(0, 1), b2 + hstep, voffB); PG8_STAGE(PG8_SA(0, 0), a2, voffA);
            PG8_WAIT_V(8); PG8_WAIT_L(0); PG8_BAR; PG8_MMA(1, 0, At, B0); PG8_MMA(1, 1, At, B1); PG8_BAR; PG8_SCHED;
            PG8_LDB(B0, 1, 0); PG8_LDB(B1, 1, 1); PG8_SCHED; PG8_LDA(At, 1, 0); PG8_STAGE(PG8_SA(0, 1), a2 + hstep, voffA);
            PG8_WAIT_V(8); PG8_WAIT_L(0); PG8_BAR; PG8_MMA(0, 0, At, B0); PG8_MMA(0, 1, At, B1); PG8_BAR; PG8_SCHED;
            PG8_LDA(At, 1, 1); PG8_STAGE(PG8_SB(1, 0), b3, voffB); PG8_STAGE(PG8_SB(1, 1), b3 + hstep, voffB); PG8_STAGE(PG8_SA(1, 0), a3, voffA);
            PG8_WAIT_V(8); PG8_WAIT_L(0); PG8_BAR; PG8_MMA(1, 0, At, B0); PG8_MMA(1, 1, At, B1); PG8_BAR; PG8_SCHED;
            } else {
            PG8_LDB(B0, 0, 0); PG8_SCHED; PG8_LDA(At, 0, 0); PG8_STAGE(PG8_SA(1, 1), a1 + hstep, voffA);
            PG8_WAIT_L(8); PG8_BAR; PG8_WAIT_L(0); PG8_MMA(0, 0, At, B0); PG8_BAR; PG8_SCHED;
            PG8_LDB(B1, 0, 1); PG8_STAGE(PG8_SB(0, 0), b2, voffB);
            PG8_BAR; PG8_WAIT_L(0); PG8_MMA(0, 1, At, B1); PG8_BAR;
            PG8_LDA(At, 0, 1); PG8_STAGE(PG8_SA(0, 0), a2, voffA);
            PG8_BAR; PG8_WAIT_L(0); PG8_MMA(1, 0, At, B0); PG8_BAR; PG8_SCHED;
            PG8_STAGE(PG8_SB(0, 1), b2 + hstep, voffB);
            PG8_WAIT_V(6); PG8_BAR; PG8_MMA(1, 1, At, B1); PG8_BAR;
            PG8_LDB(B0, 1, 0); PG8_SCHED; PG8_LDA(At, 1, 0); PG8_STAGE(PG8_SA(0, 1), a2 + hstep, voffA);
            PG8_WAIT_L(8); PG8_BAR; PG8_WAIT_L(0); PG8_MMA(0, 0, At, B0); PG8_BAR; PG8_SCHED;
            PG8_LDB(B1, 1, 1); PG8_STAGE(PG8_SB(1, 0), b3, voffB);
            PG8_BAR; PG8_WAIT_L(0); PG8_MMA(0, 1, At, B1); PG8_BAR;
            PG8_LDA(At, 1, 1); PG8_STAGE(PG8_SA(1, 0), a3, voffA);
            PG8_BAR; PG8_WAIT_L(0); PG8_MMA(1, 0, At, B0); PG8_BAR; PG8_SCHED;
            PG8_STAGE(PG8_SB(1, 1), b3 + hstep, voffB);
            PG8_WAIT_V(6); PG8_BAR; PG8_MMA(1, 1, At, B1); PG8_BAR;
            }
        }
        if constexpr (ALIGN_EPI) { if (wr == 0) PG8_BAR; }
        if constexpr (I8) {
            const float* sap = g.sa + cur.pm * 256 + wr * 64 + fr; const float* swp = g.sw + cur.pn * 256 + wc * 32 + 8 * fq;
            f32x4 cw[2][2];
#pragma unroll
            for (int b = 0; b < 2; ++b)
#pragma unroll
                for (int n = 0; n < 2; ++n) cw[b][n] = *(const f32x4*)(swp + b * 128 + 4 * n);
#pragma unroll
            for (int a = 0; a < 2; ++a)
#pragma unroll
                for (int m = 0; m < 4; ++m) { const float ra = sap[a * 128 + m * 16];
#pragma unroll
                    for (int b = 0; b < 2; ++b)
#pragma unroll
                        for (int n = 0; n < 2; ++n) acc[a][b][m][n] = __builtin_convertvector(__builtin_bit_cast(i32x4, acc[a][b][m][n]), f32x4) * ra * cw[b][n]; }
        }
        if constexpr (!Epi::AFTER_DRAIN) { E(acc, cur, wr, wc, fr, fq); S.done(cur); }
        if (!has_next) break;
#pragma unroll
        for (int a = 0; a < 2; ++a)
#pragma unroll
            for (int b = 0; b < 2; ++b)
#pragma unroll
                for (int m = 0; m < 4; ++m)
#pragma unroll
                    for (int n = 0; n < 2; ++n) acc[a][b][m][n] = (f32x4){0.f, 0.f, 0.f, 0.f};
        cur = nxt; cA = nA; cB = nB; ++ui;
        if constexpr (ALIGN_EPI) { if (wr == 1) PG8_BAR; }
    }
    PG8_WAIT_V(0);
    if constexpr (!ALIGN_EPI) { if (wr == 0) PG8_BAR; }
    PG8_BAR;
    if constexpr (Epi::AFTER_DRAIN) { E.fused(acc, cur, wr, wc, fr, fq, lds, wid, lane); S.done(cur); }
#undef PG8_SA
#undef PG8_SB
#undef PG8_STAGE
#undef PG8_LDA
#undef PG8_LDB
#undef PG8_MMA
#undef PG8_WAIT_V
#undef PG8_WAIT_L
#undef PG8_BAR
#undef PG8_SCHED
}
}
#define LAS __attribute__((address_space(3)))
#define GAS __attribute__((address_space(1)))
typedef unsigned short bf16_t;
typedef short bf16x8 __attribute__((ext_vector_type(8)));
typedef float f32x4 __attribute__((ext_vector_type(4)));
typedef unsigned u32x4 __attribute__((ext_vector_type(4)));
typedef unsigned u32x2 __attribute__((ext_vector_type(2)));

constexpr int NB = 4, SEQ = 4096, DM = 2048, NT = NB * SEQ;
constexpr int NTHREADS = 512;
constexpr int LDS_BYTES = 147456;
constexpr float EPS = 1e-6f;
constexpr int EVEN_IN_SRC = 6152, EVEN_IN = 6144, ODD_IN = 5120;

constexpr size_t MiB = 1048576;
constexpr size_t WS_MOD = 0;
constexpr size_t WS_MISC = 512 * 1024;
constexpr size_t WS_LF = 1 * MiB;
constexpr size_t WS_LI = WS_LF + 256 * 1024;
constexpr size_t WS_CHS = 2 * MiB;
constexpr size_t WS_NLOC = 2 * MiB + 512 * 1024;
constexpr size_t WS_KMEAN = 3 * MiB;
constexpr size_t WS_SCL = 3 * MiB + 512 * 1024;
constexpr size_t WS_SK = 4 * MiB;
constexpr size_t WS_ROPE = 5 * MiB;
constexpr size_t WS_WIN0 = 8 * MiB;
constexpr size_t WS_WOUT0 = 32 * MiB;
constexpr size_t WS_WIN1 = 40 * MiB;
constexpr size_t WS_WOUT1 = 60 * MiB;
constexpr size_t WS_WQ0 = 68 * MiB;
constexpr size_t WS_WQ1 = 76 * MiB;
constexpr size_t WS_U = 84 * MiB;
constexpr size_t WS_V = 212 * MiB;
constexpr size_t WS_HN8 = 148 * MiB;
constexpr size_t WS_XS = 180 * MiB;
constexpr size_t WS_W8 = 116 * MiB;
constexpr size_t WS_WSC = 181 * MiB;
constexpr size_t WS_HN = 340 * MiB;
constexpr size_t WS_PROJ = 404 * MiB;
constexpr size_t WS_CAT = 596 * MiB;
constexpr size_t WS_QP = 660 * MiB;
constexpr size_t WS_QM = 724 * MiB;
constexpr size_t WS_KM = 740 * MiB;
constexpr size_t WS_VTM = 756 * MiB;
constexpr size_t WS_CLOC = 788 * MiB;
constexpr size_t WS_VTD = 820 * MiB;
constexpr size_t WS_CPREV = 852 * MiB;
constexpr size_t WS_NPREV = 2 * MiB + 768 * 1024;
constexpr size_t WS_MPREV = 2 * MiB + 16384;
constexpr size_t WS_H = 884 * MiB;
constexpr size_t WS_END = 948 * MiB;

struct Params { const float* in[25]; float* out; unsigned char* ws; long long pad; };

__device__ __forceinline__ float bf_lo(unsigned w) { return __uint_as_float(w << 16); }
__device__ __forceinline__ float bf_hi(unsigned w) { return __uint_as_float(w & 0xffff0000u); }
__device__ __forceinline__ float bf2f(bf16_t h) { return __uint_as_float((unsigned)h << 16); }
typedef float f32x2_t __attribute__((ext_vector_type(2))); typedef __bf16 bf16x2_t __attribute__((ext_vector_type(2)));
__device__ __forceinline__ unsigned pk_bf16(float lo, float hi) { const f32x2_t v = {lo, hi}; const bf16x2_t b = __builtin_convertvector(v, bf16x2_t); return __builtin_bit_cast(unsigned, b); }
__device__ __forceinline__ bf16_t f2bf(float f) { return (bf16_t)(pk_bf16(f, 0.f) & 0xffffu); }
__device__ __forceinline__ float wave_sum(float v) {
#pragma unroll
    for (int o = 1; o < 64; o <<= 1) v += __shfl_xor(v, o);
    return v;
}
__device__ __forceinline__ float wave_max(float v) {
#pragma unroll
    for (int o = 1; o < 64; o <<= 1) v = fmaxf(v, __shfl_xor(v, o));
    return v;
}
__device__ __forceinline__ float swap32_add(float x, float y) { const auto r = __builtin_amdgcn_permlane32_swap(__float_as_uint(x), __float_as_uint(y), false, false); return __uint_as_float(r[0]) + __uint_as_float(r[1]); }
__device__ __forceinline__ float swap16_add(float x, float y) { const auto r = __builtin_amdgcn_permlane16_swap(__float_as_uint(x), __float_as_uint(y), false, false); return __uint_as_float(r[0]) + __uint_as_float(r[1]); }
__device__ __forceinline__ float dpp_xor8(float v) { return __uint_as_float(__builtin_amdgcn_update_dpp(0u, __float_as_uint(v), 0x128, 0xF, 0xF, false)); }
__device__ __forceinline__ float dpp_xor1(float v) { return __uint_as_float(__builtin_amdgcn_update_dpp(0u, __float_as_uint(v), 0xB1, 0xF, 0xF, false)); }
__device__ __forceinline__ float dpp_xor2(float v) { return __uint_as_float(__builtin_amdgcn_update_dpp(0u, __float_as_uint(v), 0x4E, 0xF, 0xF, false)); }
__device__ __forceinline__ float dpp_xor4(float v) { const unsigned t = __builtin_amdgcn_update_dpp(0u, __float_as_uint(v), 0x141, 0xF, 0xF, false);
    return __uint_as_float(__builtin_amdgcn_update_dpp(0u, t, 0x1B, 0xF, 0xF, false)); }
__device__ __forceinline__ float sigmoidf_(float a) { return 1.f / (1.f + __expf(-a)); }
__device__ __forceinline__ float gelu_tanh(float x) { const float z = 0.7978845608f * (x + 0.044715f * x * x * x); return x / (1.f + __expf(-2.f * z)); }
__device__ __forceinline__ f32x4 mfma16(bf16x8 a, bf16x8 b, f32x4 c) { return __builtin_amdgcn_mfma_f32_16x16x32_bf16(a, b, c, 0, 0, 0); }
__device__ __forceinline__ void unpack8(u32x4 w, float* f) {
    f[0] = bf_lo(w.x); f[1] = bf_hi(w.x); f[2] = bf_lo(w.y); f[3] = bf_hi(w.y); f[4] = bf_lo(w.z); f[5] = bf_hi(w.z); f[6] = bf_lo(w.w); f[7] = bf_hi(w.w);
}
__device__ __forceinline__ u32x4 pack8(const float* f) { u32x4 w; w.x = pk_bf16(f[0], f[1]); w.y = pk_bf16(f[2], f[3]); w.z = pk_bf16(f[4], f[5]); w.w = pk_bf16(f[6], f[7]); return w; }

struct EpiStoreBf16 {
    static constexpr bool PERM = true, AFTER_DRAIN = false;
    bf16_t* O; int ldc;
    __device__ __forceinline__ void operator()(const f32x4 (&acc)[2][2][4][2], const pg8::Unit& u, int wr, int wc, int fr, int fq) const {
        const int row0 = u.pm * 256 + wr * 64 + fr, col0 = u.pn * 256 + wc * 32 + 8 * fq;
#pragma unroll
        for (int ai = 0; ai < 2; ++ai)
#pragma unroll
            for (int m = 0; m < 4; ++m) { bf16_t* rowp = O + (size_t)(row0 + ai * 128 + m * 16) * ldc + col0;
#pragma unroll
                for (int bj = 0; bj < 2; ++bj) { const f32x4 v0 = acc[ai][bj][m][0], v1 = acc[ai][bj][m][1];
                    u32x4 w; w.x = pk_bf16(v0[0], v0[1]); w.y = pk_bf16(v0[2], v0[3]); w.z = pk_bf16(v1[0], v1[1]); w.w = pk_bf16(v1[2], v1[3]);
                    *(u32x4*)(rowp + bj * 128) = w; } }
    }
};
template <int LAYER>
struct EpiProj {
    static constexpr bool PERM = true, AFTER_DRAIN = false;
    bf16_t* O; int ldc; bf16_t* vta; bf16_t* vtb;
    __device__ __forceinline__ void operator()(const f32x4 (&acc)[2][2][4][2], const pg8::Unit& u, int wr, int wc, int fr, int fq) const {
        const int row0 = u.pm * 256 + wr * 64 + fr, col0 = u.pn * 256 + wc * 32 + 8 * fq;
        const bool isva = (LAYER == 0) && (u.pn >= 4 && u.pn < 8);
        const bool isvb = (LAYER == 0) ? (u.pn >= 20) : (u.pn >= 8 && u.pn < 12);
        if (!isva && !isvb) {
#pragma unroll
            for (int ai = 0; ai < 2; ++ai)
#pragma unroll
                for (int m = 0; m < 4; ++m) { bf16_t* rowp = O + (size_t)(row0 + ai * 128 + m * 16) * ldc + col0;
#pragma unroll
                    for (int bj = 0; bj < 2; ++bj) { const f32x4 v0 = acc[ai][bj][m][0], v1 = acc[ai][bj][m][1];
                        u32x4 w; w.x = pk_bf16(v0[0], v0[1]); w.y = pk_bf16(v0[2], v0[3]); w.z = pk_bf16(v1[0], v1[1]); w.w = pk_bf16(v1[2], v1[3]);
                        *(u32x4*)(rowp + bj * 128) = w; } }
        } else {
            const int b = (u.pm * 256) / SEQ, s0 = (u.pm * 256) % SEQ + wr * 64 + fr;
            const int cbase = isva ? 1024 : (LAYER == 0 ? 5120 : 2048);
            const int hv = isva ? 256 : 128, nh = isva ? 4 : 8;
            bf16_t* vt = isva ? vta : vtb;
#pragma unroll
            for (int bj = 0; bj < 2; ++bj) {
                const int cc = col0 + bj * 128 - cbase; const int h = cc / hv, v0i = cc % hv;
                bf16_t* vp = vt + ((size_t)(b * nh + h) * hv + v0i) * SEQ + s0;
#pragma unroll
                for (int ai = 0; ai < 2; ++ai)
#pragma unroll
                    for (int m = 0; m < 4; ++m) { const int so = ai * 128 + m * 16;
#pragma unroll
                        for (int n = 0; n < 2; ++n)
#pragma unroll
                            for (int e = 0; e < 4; ++e) vp[(size_t)(4 * n + e) * SEQ + so] = f2bf(acc[ai][bj][m][n][e]); }
            }
        }
    }
};
template <bool IN_F32>
struct EpiResid {
    static constexpr bool PERM = true, AFTER_DRAIN = false;
    const void* hin; bf16_t* hout; const float* gate;
    __device__ __forceinline__ void operator()(const f32x4 (&acc)[2][2][4][2], const pg8::Unit& u, int wr, int wc, int fr, int fq) const {
        const int row0 = u.pm * 256 + wr * 64 + fr, col0 = u.pn * 256 + wc * 32 + 8 * fq;
        const float* gp = gate + (size_t)((u.pm * 256) / SEQ) * 12288 + col0;
        f32x4 gv[2][2];
#pragma unroll
        for (int bj = 0; bj < 2; ++bj) { gv[bj][0] = *(const f32x4*)(gp + bj * 128); gv[bj][1] = *(const f32x4*)(gp + bj * 128 + 4); }
#pragma unroll
        for (int ai = 0; ai < 2; ++ai)
#pragma unroll
            for (int m = 0; m < 4; ++m) { const size_t off = (size_t)(row0 + ai * 128 + m * 16) * DM + col0;
#pragma unroll
                for (int bj = 0; bj < 2; ++bj) {
                    float h8[8];
                    if (IN_F32) { const f32x4 a = *(const f32x4*)((const float*)hin + off + bj * 128), c = *(const f32x4*)((const float*)hin + off + bj * 128 + 4);
                        h8[0] = a[0]; h8[1] = a[1]; h8[2] = a[2]; h8[3] = a[3]; h8[4] = c[0]; h8[5] = c[1]; h8[6] = c[2]; h8[7] = c[3]; }
                    else unpack8(*(const u32x4*)((const bf16_t*)hin + off + bj * 128), h8);
                    const f32x4 v0 = acc[ai][bj][m][0] * gv[bj][0], v1 = acc[ai][bj][m][1] * gv[bj][1];
                    u32x4 w; w.x = pk_bf16(h8[0] + v0[0], h8[1] + v0[1]); w.y = pk_bf16(h8[2] + v0[2], h8[3] + v0[3]); w.z = pk_bf16(h8[4] + v1[0], h8[5] + v1[1]); w.w = pk_bf16(h8[6] + v1[2], h8[7] + v1[3]);
                    *(u32x4*)(hout + off + bj * 128) = w; } }
    }
};

__device__ __forceinline__ void rms_mod_row(const float* src, const float* ng, const float* sc, const float* sh, bf16_t* dst, int lane, f32x4 (&v)[8]) {
    const f32x4* xr = (const f32x4*)src + lane; float s = 0.f;
#pragma unroll
    for (int j = 0; j < 8; ++j) { v[j] = xr[64 * j]; s += (v[j][0] * v[j][0] + v[j][1] * v[j][1]) + (v[j][2] * v[j][2] + v[j][3] * v[j][3]); }
    const float r = rsqrtf(wave_sum(s) * (1.f / DM) + EPS);
    u32x2* o8 = (u32x2*)dst + lane;
#pragma unroll
    for (int j = 0; j < 8; ++j) {
        const f32x4 g = ((const f32x4*)ng)[lane + 64 * j], a = ((const f32x4*)sc)[lane + 64 * j], b = ((const f32x4*)sh)[lane + 64 * j];
        v[j] = v[j] * r * g * (a + 1.f) + b;
        u32x2 w; w.x = pk_bf16(v[j][0], v[j][1]); w.y = pk_bf16(v[j][2], v[j][3]); o8[64 * j] = w;
    }
}

__device__ __forceinline__ void p0_transpose_item(const float* W, int ldw, int c0, int k0, bf16_t* WT, int n0, LAS float* scr, int lane) {
#pragma unroll 8
    for (int i = 0; i < 32; ++i) { const int kk = 2 * i + (lane >> 5); scr[kk * 33 + (lane & 31)] = W[(size_t)(k0 + kk) * ldw + c0 + (lane & 31)]; }
    asm volatile("s_waitcnt lgkmcnt(0)" ::: "memory");
    const int c = lane & 7;
#pragma unroll
    for (int j = 0; j < 4; ++j) { const int n = (lane >> 3) + 8 * j; const LAS float* s = scr + (8 * c) * 33 + n;
        u32x4 o; o.x = pk_bf16(s[0 * 33], s[1 * 33]); o.y = pk_bf16(s[2 * 33], s[3 * 33]); o.z = pk_bf16(s[4 * 33], s[5 * 33]); o.w = pk_bf16(s[6 * 33], s[7 * 33]);
        *(u32x4*)(WT + (size_t)(n0 + n) * 2048 + k0 + 8 * c) = o; }
    asm volatile("s_waitcnt lgkmcnt(0)" ::: "memory");
}

__device__ __forceinline__ unsigned p0_enc8(const f32x4 lo4, const f32x4 hi4, float c, bool isU) {
    unsigned w = 0u;
    if (isU) {
#pragma unroll
        for (int b = 0; b < 4; ++b) { const int ql = (int)__builtin_amdgcn_fmed3f(floorf(lo4[b] * c), -8.f, 7.f), qh = (int)__builtin_amdgcn_fmed3f(floorf(hi4[b] * c), -8.f, 7.f);
            w |= (((unsigned)(ql + 8) & 15u) | (((unsigned)qh & 15u) << 4)) << (8 * b); }
    } else {
        w = __builtin_amdgcn_cvt_scalef32_pk_fp4_f32(w, __builtin_amdgcn_fmed3f(lo4[0] * c, -6.f, 6.f), __builtin_amdgcn_fmed3f(lo4[1] * c, -6.f, 6.f), 1.0f, 0);
        w = __builtin_amdgcn_cvt_scalef32_pk_fp4_f32(w, __builtin_amdgcn_fmed3f(lo4[2] * c, -6.f, 6.f), __builtin_amdgcn_fmed3f(lo4[3] * c, -6.f, 6.f), 1.0f, 1);
        w = __builtin_amdgcn_cvt_scalef32_pk_fp4_f32(w, __builtin_amdgcn_fmed3f(hi4[0] * c, -6.f, 6.f), __builtin_amdgcn_fmed3f(hi4[1] * c, -6.f, 6.f), 1.0f, 2);
        w = __builtin_amdgcn_cvt_scalef32_pk_fp4_f32(w, __builtin_amdgcn_fmed3f(hi4[2] * c, -6.f, 6.f), __builtin_amdgcn_fmed3f(hi4[3] * c, -6.f, 6.f), 1.0f, 3);
    }
    return w;
}
__device__ __forceinline__ void convert_tables(const Params& p, int lane, int gw, int NGW) {
    unsigned char* ws = p.ws;
    float* scl = (float*)(ws + WS_SCL);
#define CT_LOAD(dst0, dst1, r_) do { const int ra_ = (r_), rb_ = ((r_) + NGW < 65536) ? (r_) + NGW : (r_); \
        const f32x4* sa_ = (const f32x4*)((ra_ < 32768 ? p.in[23] : p.in[24]) + (size_t)(ra_ & 32767) * 2048); const f32x4* sb_ = (const f32x4*)((rb_ < 32768 ? p.in[23] : p.in[24]) + (size_t)(rb_ & 32767) * 2048); \
        _Pragma("unroll") for (int j = 0; j < 8; ++j) { dst0[j] = sa_[2 * lane + (j & 1) + 128 * (j >> 1)]; dst1[j] = sb_[2 * lane + (j & 1) + 128 * (j >> 1)]; } } while (0)
    f32x4 v0[8], v1[8];
    if (gw < 65536) CT_LOAD(v0, v1, gw);
#pragma unroll 1
    for (int r = gw; r < 65536; r += 2 * NGW) {
        const int r1 = r + NGW; const bool has1 = r1 < 65536; const int rb = has1 ? r1 : r;
        unsigned char* d0 = ws + (r < 32768 ? WS_U : WS_V) + (size_t)((r >> 14) & 1) * 16384 * 1024 + (size_t)(r & 16383) * 128;
        unsigned char* d1 = ws + (rb < 32768 ? WS_U : WS_V) + (size_t)((rb >> 14) & 1) * 16384 * 1024 + (size_t)(rb & 16383) * 128;
        f32x4 n0[8], n1[8];
        const bool more = r + 2 * NGW < 65536;
        if (more) CT_LOAD(n0, n1, r + 2 * NGW);
        float a0 = 0.f, a1 = 0.f;
#pragma unroll
        for (int j = 0; j < 8; ++j) { a0 += (v0[j][0] * v0[j][0] + v0[j][1] * v0[j][1]) + (v0[j][2] * v0[j][2] + v0[j][3] * v0[j][3]);
                                      a1 += (v1[j][0] * v1[j][0] + v1[j][1] * v1[j][1]) + (v1[j][2] * v1[j][2] + v1[j][3] * v1[j][3]); }
        a0 = wave_sum(a0); a1 = wave_sum(a1);
        const bool u0 = r < 32768, u1 = rb < 32768;
        const float sc0 = (a0 > 0.f) ? (u0 ? 0.3352f : 0.5f) * sqrtf(a0 * (1.f / 2048.f)) : 1.f, sc1 = (a1 > 0.f) ? (u1 ? 0.3352f : 0.5f) * sqrtf(a1 * (1.f / 2048.f)) : 1.f;
        const float c0 = 1.f / sc0, c1 = 1.f / sc1;
#pragma unroll
        for (int jj = 0; jj < 4; ++jj) { const size_t off = (size_t)(2 * jj + (lane >> 5)) * (16384 * 128) + (lane & 31) * 4;
            *(unsigned*)(d0 + off) = p0_enc8(v0[2 * jj], v0[2 * jj + 1], c0, u0);
            if (has1) *(unsigned*)(d1 + off) = p0_enc8(v1[2 * jj], v1[2 * jj + 1], c1, u1); }
        if (lane == 0) { scl[r] = sc0; if (has1) scl[r1] = sc1; }
        if (more) {
#pragma unroll
            for (int j = 0; j < 8; ++j) { v0[j] = n0[j]; v1[j] = n1[j]; } }
    }
#undef CT_LOAD
}
__device__ __forceinline__ void phase0a(const Params& p, LAS unsigned char* lds, int tid, int lane, int wave, int bid, int G) {
    unsigned char* ws = p.ws;
    const int gw = bid * 8 + wave, NGW = G * 8;
    const int gt = bid * NTHREADS + tid, NGT = G * NTHREADS;
    {
        LAS float* scr = (LAS float*)(lds + wave * 8704);
        constexpr int NB0 = 192, NB1 = 64, NB2 = 160, NB3 = 64, NB4 = 64, NB5 = 64, NBT = NB0 + NB1 + NB2 + NB3 + NB4 + NB5;
        for (int it = gw; it < 32 * NBT; it += NGW) {
            const int kb = it / NBT; int nb = it % NBT; const int k0 = kb * 64;
            if (nb < NB0) { const int n0 = nb * 32; p0_transpose_item(p.in[7], EVEN_IN_SRC, n0 + (n0 >= 3072 ? 8 : 0), k0, (bf16_t*)(ws + WS_WIN0), n0, scr, lane); continue; } nb -= NB0;
            if (nb < NB1) { p0_transpose_item(p.in[8], 2048, nb * 32, k0, (bf16_t*)(ws + WS_WOUT0), nb * 32, scr, lane); continue; } nb -= NB1;
            if (nb < NB2) { p0_transpose_item(p.in[15], ODD_IN, nb * 32, k0, (bf16_t*)(ws + WS_WIN1), nb * 32, scr, lane); continue; } nb -= NB2;
            if (nb < NB3) { p0_transpose_item(p.in[16], 2048, nb * 32, k0, (bf16_t*)(ws + WS_WOUT1), nb * 32, scr, lane); continue; } nb -= NB3;
            if (nb < NB4) { p0_transpose_item(p.in[21], 2048, nb * 32, k0, (bf16_t*)(ws + WS_WQ0), nb * 32, scr, lane); continue; } nb -= NB4;
            p0_transpose_item(p.in[21] + (size_t)2048 * 2048, 2048, nb * 32, k0, (bf16_t*)(ws + WS_WQ1), nb * 32, scr, lane);
        }
    }
    {
        const size_t k8 = (size_t)2 * 8 * 2 * 128 * 128 / 8;
        const f32x4* sk = (const f32x4*)p.in[22]; u32x4* dk = (u32x4*)(ws + WS_SK);
        for (size_t i = gt; i < k8; i += NGT) { const f32x4 a = sk[2 * i], b = sk[2 * i + 1];
            u32x4 w; w.x = pk_bf16(a[0], a[1]); w.y = pk_bf16(a[2], a[3]); w.z = pk_bf16(b[0], b[1]); w.w = pk_bf16(b[2], b[3]); dk[i] = w; }
    }
    {
        const int* pos = (const int*)p.in[2]; float* tab = (float*)(ws + WS_ROPE);
        for (int i = gt; i < NT * 24; i += NGT) {
            const int t = i / 24, j = i % 24;
            const float e = (j < 8) ? (float)j * (1.f / 8.f) : (float)(j - 8) * (1.f / 16.f);
            const float inv = exp2f(-e * 18.931568569324174f);
            const float ang = (float)pos[t] * inv;
            float sn, cs; sincosf(ang, &sn, &cs);
            tab[2 * i] = cs; tab[2 * i + 1] = sn;
        }
    }
    {
        const float* cin = p.in[1]; float* mod = (float*)(ws + WS_MOD);
        LAS float* part = (LAS float*)(lds + 73728);
        for (int it = bid; it < 192; it += G) {
            const int ng = it % 96, l = it / 96;
            const int n0 = ng * 128 + 2 * lane;
            f32x2_t acc[4];
#pragma unroll
            for (int b = 0; b < 4; ++b) acc[b] = (f32x2_t){0.f, 0.f};
#pragma unroll 1
            for (int kc = 0; kc < 4; ++kc) {
                const int k0 = wave * 256 + kc * 64;
                float ca[4];
#pragma unroll
                for (int b = 0; b < 4; ++b) { const float cv = cin[b * DM + k0 + lane]; ca[b] = cv * sigmoidf_(cv); }
                const float* wp = p.in[3] + ((size_t)l * DM + k0) * 12288 + n0;
#pragma unroll 16
                for (int kk = 0; kk < 64; ++kk) {
                    const f32x2_t w = *(const f32x2_t*)(wp + (size_t)kk * 12288);
#pragma unroll
                    for (int b = 0; b < 4; ++b) acc[b] += w * __shfl(ca[b], kk);
                }
            }
#pragma unroll
            for (int b = 0; b < 4; ++b) *(LAS f32x2_t*)(part + (wave * 4 + b) * 128 + 2 * lane) = acc[b];
            __syncthreads();
            { const int o = tid, b = o >> 7, col = o & 127;
                float sm = p.in[4][l * 12288 + ng * 128 + col];
#pragma unroll
                for (int w = 0; w < 8; ++w) sm += part[(w * 4 + b) * 128 + col];
                mod[((size_t)l * 4 + b) * 12288 + ng * 128 + col] = sm; }
            __syncthreads();
        }
    }
    if (bid == 0 && wave == 0) {
        const float* lv = p.in[13];
        const float a = wave_sum(lv[lane] * lv[64 + lane]), b = wave_sum(lv[128 + lane] * lv[192 + lane]);
        if (lane == 0) ((float*)(ws + WS_MISC))[0] = __expf(a) - __expf(b) + 0.2f;
    }
}

__device__ __forceinline__ unsigned pack4_i8(float a, float b, float c, float d, float inv) {
    return ((unsigned)(int)rintf(a * inv) & 255u) | (((unsigned)(int)rintf(b * inv) & 255u) << 8) | (((unsigned)(int)rintf(c * inv) & 255u) << 16) | ((unsigned)(int)rintf(d * inv) << 24);
}
__device__ __forceinline__ void quant_weights(unsigned char* ws, int lane, int gw, int NGW) {
    float* wsc = (float*)(ws + WS_WSC);
    for (int n = gw; n < 15360; n += NGW) {
        const bf16_t* src = (n < 6144) ? (const bf16_t*)(ws + WS_WIN0) + (size_t)n * 2048 : (n < 11264) ? (const bf16_t*)(ws + WS_WIN1) + (size_t)(n - 6144) * 2048
                          : (n < 13312) ? (const bf16_t*)(ws + WS_WQ0) + (size_t)(n - 11264) * 2048 : (const bf16_t*)(ws + WS_WQ1) + (size_t)(n - 13312) * 2048;
        u32x4 v[4];
#pragma unroll
        for (int j = 0; j < 4; ++j) v[j] = ((const u32x4*)src)[lane + 64 * j];
        float f[32]; float m = 0.f;
#pragma unroll
        for (int j = 0; j < 4; ++j) unpack8(v[j], f + 8 * j);
#pragma unroll
        for (int e = 0; e < 32; ++e) m = fmaxf(m, fabsf(f[e]));
        m = fmaxf(wave_max(m), 1e-30f);
        const float inv = 127.f / m;
        u32x2* dst = (u32x2*)(ws + WS_W8 + (size_t)n * 2048);
#pragma unroll
        for (int j = 0; j < 4; ++j) { u32x2 o; o.x = pack4_i8(f[8 * j], f[8 * j + 1], f[8 * j + 2], f[8 * j + 3], inv); o.y = pack4_i8(f[8 * j + 4], f[8 * j + 5], f[8 * j + 6], f[8 * j + 7], inv);
            dst[lane + 64 * j] = o; }
        if (lane == 0) wsc[n] = m * (1.f / 127.f);
    }
}

template <bool GATES>
__device__ __forceinline__ void phase_rows(const Params& p, LAS unsigned char* lds, const void* hsrc_, const float* ng, const float* modl  , int sc_off, int sh_off,
                                           int tid, int lane, int wave, int bid, int G) {
    unsigned char* ws = p.ws;
    LAS float* wg = (LAS float*)lds;
    if (GATES) {
        for (int i = tid; i < 8 * DM; i += NTHREADS) { const int k = i >> 3, j = i & 7; wg[j * DM + k] = p.in[7][(size_t)k * EVEN_IN_SRC + 3072 + j]; }
        __syncthreads();
    }
    float* lf = (float*)(ws + WS_LF); float* li = (float*)(ws + WS_LI);
    for (int r0 = (bid * 8 + wave) * 8; r0 < NT; r0 += G * 64) {
        const int b = r0 / SEQ;
        f32x4 av[8], bv[8];
        { const float* sc = modl + (size_t)b * 12288 + sc_off; const float* sh = modl + (size_t)b * 12288 + sh_off;
#pragma unroll
          for (int j = 0; j < 8; ++j) { av[j] = ((const f32x4*)ng)[lane + 64 * j] * (((const f32x4*)sc)[lane + 64 * j] + 1.f); bv[j] = ((const f32x4*)sh)[lane + 64 * j]; } }
#pragma unroll 1
        for (int i = 0; i < 8; i += 2) {
            f32x4 v0[8], v1[8]; float s0 = 0.f, s1 = 0.f;
            if (GATES) { const f32x4* x0 = (const f32x4*)((const float*)hsrc_ + (size_t)(r0 + i) * DM) + lane; const f32x4* x1 = x0 + DM / 4;
#pragma unroll
                for (int j = 0; j < 8; ++j) { v0[j] = x0[64 * j]; v1[j] = x1[64 * j]; } }
            else { const u32x2* x0 = (const u32x2*)((const bf16_t*)hsrc_ + (size_t)(r0 + i) * DM) + lane; const u32x2* x1 = x0 + DM / 4;
#pragma unroll
                for (int j = 0; j < 8; ++j) { const u32x2 a = x0[64 * j], c = x1[64 * j];
                    v0[j] = (f32x4){bf_lo(a.x), bf_hi(a.x), bf_lo(a.y), bf_hi(a.y)}; v1[j] = (f32x4){bf_lo(c.x), bf_hi(c.x), bf_lo(c.y), bf_hi(c.y)}; } }
#pragma unroll
            for (int j = 0; j < 8; ++j) { s0 += (v0[j][0] * v0[j][0] + v0[j][1] * v0[j][1]) + (v0[j][2] * v0[j][2] + v0[j][3] * v0[j][3]);
                                          s1 += (v1[j][0] * v1[j][0] + v1[j][1] * v1[j][1]) + (v1[j][2] * v1[j][2] + v1[j][3] * v1[j][3]); }
#pragma unroll
            for (int o = 1; o < 64; o <<= 1) { s0 += __shfl_xor(s0, o); s1 += __shfl_xor(s1, o); }
            const float q0 = rsqrtf(s0 * (1.f / DM) + EPS), q1 = rsqrtf(s1 * (1.f / DM) + EPS);
#pragma unroll
            for (int j = 0; j < 8; ++j) { v0[j] = v0[j] * q0 * av[j] + bv[j]; v1[j] = v1[j] * q1 * av[j] + bv[j]; }
            {
                float m0 = 0.f, m1 = 0.f;
#pragma unroll
                for (int j = 0; j < 8; ++j) { m0 = fmaxf(m0, fmaxf(fmaxf(fabsf(v0[j][0]), fabsf(v0[j][1])), fmaxf(fabsf(v0[j][2]), fabsf(v0[j][3]))));
                                              m1 = fmaxf(m1, fmaxf(fmaxf(fabsf(v1[j][0]), fabsf(v1[j][1])), fmaxf(fabsf(v1[j][2]), fabsf(v1[j][3])))); }
#pragma unroll
                for (int o = 1; o < 64; o <<= 1) { m0 = fmaxf(m0, __shfl_xor(m0, o)); m1 = fmaxf(m1, __shfl_xor(m1, o)); }
                m0 = fmaxf(m0, 1e-20f); m1 = fmaxf(m1, 1e-20f);
                const float i0 = 127.f / m0, i1 = 127.f / m1;
                unsigned* e0 = (unsigned*)(ws + WS_HN8 + (size_t)(r0 + i) * DM) + lane; unsigned* e1 = e0 + DM / 4;
#pragma unroll
                for (int j = 0; j < 8; ++j) {
                    const unsigned a0 = (unsigned)(int)rintf(v0[j][0] * i0) & 255u, a1 = (unsigned)(int)rintf(v0[j][1] * i0) & 255u, a2 = (unsigned)(int)rintf(v0[j][2] * i0) & 255u, a3 = (unsigned)(int)rintf(v0[j][3] * i0);
                    const unsigned c0 = (unsigned)(int)rintf(v1[j][0] * i1) & 255u, c1 = (unsigned)(int)rintf(v1[j][1] * i1) & 255u, c2 = (unsigned)(int)rintf(v1[j][2] * i1) & 255u, c3 = (unsigned)(int)rintf(v1[j][3] * i1);
                    e0[64 * j] = a0 | (a1 << 8) | (a2 << 16) | (a3 << 24); e1[64 * j] = c0 | (c1 << 8) | (c2 << 16) | (c3 << 24); }
                if (lane == 0) { float* xs = (float*)(ws + WS_XS); xs[r0 + i] = m0 * (1.f / 127.f); xs[r0 + i + 1] = m1 * (1.f / 127.f); }
            }
            if (GATES) {
#pragma unroll
                for (int rr = 0; rr < 2; ++rr) {
                    float pd[8];
#pragma unroll
                    for (int jg = 0; jg < 8; ++jg) { float a = 0.f;
#pragma unroll
                        for (int j = 0; j < 8; ++j) { const f32x4 w = *(const LAS f32x4*)(wg + jg * DM + 4 * lane + 256 * j); const f32x4 x = rr ? v1[j] : v0[j];
                            a += (x[0] * w[0] + x[1] * w[1]) + (x[2] * w[2] + x[3] * w[3]); }
                        pd[jg] = a; __builtin_amdgcn_sched_barrier(0); }
                    const bool b5 = (lane >> 5) & 1, b4 = (lane >> 4) & 1, b3 = (lane >> 3) & 1;
                    float r4[4], r2[2];
#pragma unroll
                    for (int q = 0; q < 4; ++q) r4[q] = (b5 ? pd[4 + q] : pd[q]) + __shfl_xor(b5 ? pd[q] : pd[4 + q], 32);
#pragma unroll
                    for (int q = 0; q < 2; ++q) r2[q] = (b4 ? r4[2 + q] : r4[q]) + __shfl_xor(b4 ? r4[q] : r4[2 + q], 16);
                    float g1 = (b3 ? r2[1] : r2[0]) + __shfl_xor(b3 ? r2[0] : r2[1], 8);
                    g1 += __shfl_xor(g1, 4); g1 += __shfl_xor(g1, 2); g1 += __shfl_xor(g1, 1);
                    const int jg = lane >> 3, h = jg & 3; const int m = r0 + i + rr, s = m % SEQ;
                    if ((lane & 7) == 0) {
                        const float pre = g1 + p.in[11][jg];
                        if (jg < 4) li[((size_t)b * 4 + h) * SEQ + s] = pre;
                        else lf[((size_t)b * 4 + h) * SEQ + s] = (pre >= 0.f) ? -log1pf(__expf(-pre)) : pre - log1pf(__expf(pre));
                    }
                }
            }
        }
    }
}
#define XB_TMO      128
#define XB_XCNT(j)  (256  + 64 * (j))
#define XB_XSUB(j)  (1280 + 64 * (j))
#define XB_XGEN(j)  (2304 + 64 * (j))
#define XB_TOP      3328
#define XB_TOPGEN   3392
#define XCD_BAR_WORDS 3456
#define XB_SPIN_CAP (1u << 18)

__device__ __forceinline__ unsigned xb_ld(unsigned* p)              { return __hip_atomic_load(p, __ATOMIC_RELAXED, __HIP_MEMORY_SCOPE_AGENT); }
__device__ __forceinline__ unsigned xb_add(unsigned* p, unsigned v) { return __hip_atomic_fetch_add(p, v, __ATOMIC_RELAXED, __HIP_MEMORY_SCOPE_AGENT); }
__device__ __forceinline__ unsigned xb_xcc_id() { return (unsigned)__builtin_amdgcn_s_getreg((3 << 11) | 20) & 0xFu; }
#define XB_SPIN(cond, bar) do { unsigned _sp = 0; while (cond) { __builtin_amdgcn_s_sleep(1); \
    if ((++_sp & 255u) == 0u) { if (xb_ld(&(bar)[XB_TMO])) break; if (_sp > XB_SPIN_CAP) { atomicAdd(&(bar)[XB_TMO], 1u); break; } } } } while (0)

struct XcdBarrier {
    unsigned* bar; unsigned x;
    volatile LAS unsigned* st;
};

__device__ __forceinline__ XcdBarrier xcd_barrier_post(unsigned* bar, volatile LAS unsigned* st) {
    XcdBarrier b; b.bar = bar; b.x = xb_xcc_id(); b.st = st;
    if (threadIdx.x == 0) (void)xb_add(&bar[XB_XCNT(b.x)], 1u);
    return b;
}
__device__ __forceinline__ void xcd_barrier_complete(unsigned* bar, unsigned x, unsigned& nloc, unsigned& nx) {
    const unsigned G = gridDim.x * gridDim.y * gridDim.z;
    unsigned sum, cnt, mine, sp = 0u;
    for (;;) {
        sum = 0u; cnt = 0u; mine = 0u;
#pragma unroll
        for (unsigned j = 0; j < 16; ++j) { const unsigned c = xb_ld(&bar[XB_XCNT(j)]); sum += c; cnt += (c > 0u) ? 1u : 0u; mine = (j == x) ? c : mine; }
        if (sum == G) break;
        __builtin_amdgcn_s_sleep(1);
        if ((++sp & 255u) == 0u) { if (xb_ld(&bar[XB_TMO])) break; if (sp > XB_SPIN_CAP) { atomicAdd(&bar[XB_TMO], 1u); break; } }
    }
    nloc = mine > 0u ? mine : 1u; nx = cnt > 0u ? cnt : 1u;
}

__device__ __forceinline__ void xcd_barrier(const XcdBarrier& b) {
    asm volatile("s_waitcnt vmcnt(0)" ::: "memory");
    __syncthreads();
    if (threadIdx.x == 0) {
        unsigned* bar = b.bar;
        __builtin_amdgcn_s_waitcnt(0);
        unsigned nloc = b.st[0], nx = b.st[1];
        if (nloc == 0u) { xcd_barrier_complete(bar, b.x, nloc, nx); b.st[0] = nloc; b.st[1] = nx; }
        const unsigned old = xb_add(&bar[XB_XSUB(b.x)], 1u);
        const unsigned gen = old / nloc;
        if (old + 1u == (gen + 1u) * nloc) {
            __builtin_amdgcn_fence(__ATOMIC_RELEASE, "agent");
            asm volatile("s_waitcnt vmcnt(0)" ::: "memory");
            const unsigned og = xb_add(&bar[XB_TOP], 1u);
            const unsigned tg = og / nx;
            if (og + 1u == (tg + 1u) * nx) xb_add(&bar[XB_TOPGEN], 1u);
            else XB_SPIN(xb_ld(&bar[XB_TOPGEN]) == tg, bar);
            __builtin_amdgcn_fence(__ATOMIC_ACQUIRE, "agent");
            xb_add(&bar[XB_XGEN(b.x)], 1u);
            asm volatile("s_waitcnt vmcnt(0)" ::: "memory");
        } else {
            XB_SPIN(xb_ld(&bar[XB_XGEN(b.x)]) == gen, bar);
            __builtin_amdgcn_fence(__ATOMIC_ACQUIRE, "agent");
            asm volatile("s_waitcnt vmcnt(0)" ::: "memory");
        }
    }
    __syncthreads();
}
__device__ __forceinline__ void transpose_64x128(const bf16_t* src, size_t ld_src, bf16_t* dst, size_t ld_dst, LAS unsigned char* T  , int tid) {
#pragma unroll
    for (int i = 0; i < 2; ++i) { const int id = tid + NTHREADS * i, row = id >> 4, ch = id & 15;
        const u32x4 w = *(const u32x4*)(src + (size_t)row * ld_src + ch * 8);
        LAS bf16_t* tp = (LAS bf16_t*)(T + (8 * ch) * 144 + ((((row >> 3) ^ (ch & 7)) << 4) + (row & 7) * 2));
        tp[0 * 72] = (bf16_t)(w.x & 0xffffu); tp[1 * 72] = (bf16_t)(w.x >> 16); tp[2 * 72] = (bf16_t)(w.y & 0xffffu); tp[3 * 72] = (bf16_t)(w.y >> 16);
        tp[4 * 72] = (bf16_t)(w.z & 0xffffu); tp[5 * 72] = (bf16_t)(w.z >> 16); tp[6 * 72] = (bf16_t)(w.w & 0xffffu); tp[7 * 72] = (bf16_t)(w.w >> 16); }
    __syncthreads();
#pragma unroll
    for (int i = 0; i < 2; ++i) { const int id = tid + NTHREADS * i, v = id >> 3, c = id & 7;
        *(u32x4*)(dst + (size_t)v * ld_dst + c * 8) = *(const LAS u32x4*)(T + v * 144 + ((c ^ ((v >> 3) & 7)) << 4)); }
    __syncthreads();
}

__device__ __forceinline__ void diff_post_item(const Params& p, LAS unsigned char* lds, int item, int tid) {
    const int blk = item & 15, h = (item >> 4) & 7, b = item >> 7;
    bf16_t* proj = (bf16_t*)(p.ws + WS_PROJ);
    const float* tab = (const float*)(p.ws + WS_ROPE);
    const size_t row0 = (size_t)b * SEQ + blk * 256;
#pragma unroll
    for (int i = 0; i < 2; ++i) {
        const int id = tid + NTHREADS * i, tok = id >> 2, comp = id & 1, qk = (id >> 1) & 1;
        bf16_t* ptr = proj + (row0 + tok) * EVEN_IN + (qk ? 4096 : 3072) + h * 128 + comp * 64;
        const u32x4 w1 = *(const u32x4*)ptr, w2 = *(const u32x4*)(ptr + 8);
        float x1[8], x2[8], o1[8], o2[8]; unpack8(w1, x1); unpack8(w2, x2);
        const float* tb = tab + (row0 + tok) * 48;
#pragma unroll
        for (int e = 0; e < 8; ++e) { const float cs = tb[2 * e], sn = tb[2 * e + 1]; o1[e] = x1[e] * cs - x2[e] * sn; o2[e] = x2[e] * cs + x1[e] * sn; }
        *(u32x4*)ptr = pack8(o1); *(u32x4*)(ptr + 8) = pack8(o2);
    }
    (void)lds;
}

__device__ __forceinline__ void mlstm_cloc_unit(const Params& p, LAS unsigned char* lds, int unit, int tid, int lane, int wave) {
    const int c = unit & 31, h = (unit >> 5) & 3, b = unit >> 7, bh = b * 4 + h;
    unsigned char* ws = p.ws;
    const bf16_t* proj = (const bf16_t*)(ws + WS_PROJ);
    LAS unsigned char* Kt = lds;
    LAS unsigned char* Vt = lds + 34816;
    LAS float* sc = (LAS float*)(lds + 104448);
    const int s0 = c * 128;
    const float* lf = (const float*)(ws + WS_LF) + (size_t)bh * SEQ + s0;
    const float* li = (const float*)(ws + WS_LI) + (size_t)bh * SEQ + s0;
    if (wave == 0) {
        const float e0 = lf[2 * lane], e1 = lf[2 * lane + 1];
        float incl = e0 + e1;
#pragma unroll
        for (int o = 1; o < 64; o <<= 1) { const float t = __shfl_up(incl, o); if (lane >= o) incl += t; }
        const float g = __shfl(incl, 63);
        const float b0 = incl - e1, b1 = incl;
        const float a0 = g - b0 + li[2 * lane], a1 = g - b1 + li[2 * lane + 1];
        const float ml = wave_max(fmaxf(a0, a1));
        sc[2 * lane] = __expf(a0 - ml); sc[2 * lane + 1] = __expf(a1 - ml);
        if (lane == 0) { float* chs = (float*)(ws + WS_CHS) + (size_t)(bh * 32 + c) * 2; chs[0] = g; chs[1] = ml; }
    }
    __syncthreads();
    const float* cw = p.in[9]; const float* cb = p.in[10];
    bf16_t* Qm = (bf16_t*)(ws + WS_QM) + ((size_t)bh * SEQ + s0) * 128;
    bf16_t* Km = (bf16_t*)(ws + WS_KM) + ((size_t)bh * SEQ + s0) * 128;
#pragma unroll 2
    for (int i = 0; i < 8; ++i) {
        const int id = tid + NTHREADS * (i & 3), isk = i >> 2, s = id >> 4, dc = id & 15;
        const int col = isk * 512 + h * 128 + dc * 8;
        float y[8];
        { const f32x4 b0 = *(const f32x4*)(cb + col), b1 = *(const f32x4*)(cb + col + 4);
          y[0] = b0[0]; y[1] = b0[1]; y[2] = b0[2]; y[3] = b0[3]; y[4] = b1[0]; y[5] = b1[1]; y[6] = b1[2]; y[7] = b1[3]; }
#pragma unroll
        for (int w = 0; w < 4; ++w) {
            const int ts = s0 + s - 3 + w;
            if (ts >= 0) {
                const u32x4 raw = *(const u32x4*)(proj + ((size_t)b * SEQ + ts) * EVEN_IN + col);
                float x[8]; unpack8(raw, x);
                const f32x4 w0 = *(const f32x4*)(cw + w * 1024 + col), w1 = *(const f32x4*)(cw + w * 1024 + col + 4);
                y[0] += x[0] * w0[0]; y[1] += x[1] * w0[1]; y[2] += x[2] * w0[2]; y[3] += x[3] * w0[3];
                y[4] += x[4] * w1[0]; y[5] += x[5] * w1[1]; y[6] += x[6] * w1[2]; y[7] += x[7] * w1[3];
            }
        }
#pragma unroll
        for (int e = 0; e < 8; ++e) y[e] = y[e] * sigmoidf_(y[e]);
        if (!isk) {
#pragma unroll
            for (int e = 0; e < 8; ++e) y[e] *= 0.08838834764831845f;
            *(u32x4*)(Qm + (size_t)s * 128 + dc * 8) = pack8(y);
        } else {
            *(u32x4*)(Km + (size_t)s * 128 + dc * 8) = pack8(y);
            const float wsv = sc[s];
            LAS bf16_t* kp = (LAS bf16_t*)(Kt + (dc * 8) * 272 + ((((s >> 3) ^ (dc & 7)) << 4) + (s & 7) * 2));
#pragma unroll
            for (int e = 0; e < 8; ++e) kp[e * 136] = f2bf(y[e] * wsv);
        }
    }
    {
        const bf16_t* Vtm = (const bf16_t*)(ws + WS_VTM) + ((size_t)bh * 256) * SEQ + s0;
#pragma unroll 4
        for (int i = 0; i < 8; ++i) { const int id = tid + NTHREADS * i, v = id >> 4, ch = id & 15;
            *(LAS u32x4*)(Vt + v * 272 + ((ch ^ ((v >> 3) & 15)) << 4)) = *(const u32x4*)(Vtm + (size_t)v * SEQ + ch * 8); }
    }
    __syncthreads();
    if (tid < 128) { float a = 0.f;
#pragma unroll
        for (int ch = 0; ch < 16; ++ch) { float f[8]; unpack8(*(const LAS u32x4*)(Kt + tid * 272 + ch * 16), f); a += ((f[0] + f[1]) + (f[2] + f[3])) + ((f[4] + f[5]) + (f[6] + f[7])); }
        ((float*)(ws + WS_NLOC))[(size_t)(bh * 32 + c) * 128 + tid] = a; }
    const int r16 = lane & 15, g = lane >> 4;
    f32x4 acc[8][2];
#pragma unroll
    for (int db = 0; db < 8; ++db) { acc[db][0] = (f32x4){0.f, 0.f, 0.f, 0.f}; acc[db][1] = (f32x4){0.f, 0.f, 0.f, 0.f}; }
#pragma unroll
    for (int ks = 0; ks < 4; ++ks) {
        bf16x8 vf[2];
#pragma unroll
        for (int j = 0; j < 2; ++j) { const int v = 16 * (2 * wave + j) + r16; vf[j] = *(const LAS bf16x8*)(Vt + v * 272 + (((4 * ks + g) ^ ((v >> 3) & 15)) << 4)); }
#pragma unroll
        for (int db = 0; db < 8; ++db) { const int d = 16 * db + r16; const bf16x8 kf = *(const LAS bf16x8*)(Kt + d * 272 + (((4 * ks + g) ^ ((d >> 3) & 7)) << 4));
            acc[db][0] = mfma16(kf, vf[0], acc[db][0]); acc[db][1] = mfma16(kf, vf[1], acc[db][1]); }
    }
    bf16_t* Cl = (bf16_t*)(ws + WS_CLOC) + (size_t)(bh * 32 + c) * 256 * 128;
#pragma unroll
    for (int db = 0; db < 8; ++db)
#pragma unroll
        for (int j = 0; j < 2; ++j) { const int v = 16 * (2 * wave + j) + r16;
            u32x2 w; w.x = pk_bf16(acc[db][j][0], acc[db][j][1]); w.y = pk_bf16(acc[db][j][2], acc[db][j][3]);
            *(u32x2*)(Cl + (size_t)v * 128 + 16 * db + 4 * g) = w; }
    __syncthreads();
}

constexpr int ATT_KROW = 256, ATT_VROW = 128, ATT_KBYTES = 64 * ATT_KROW, ATT_BUF = ATT_KBYTES + 128 * ATT_VROW, ATT_EXTRA = 2 * ATT_BUF;
template <int MODE>
__device__ __forceinline__ void attn_unit(LAS unsigned char* lds, const bf16_t* Qb, const bf16_t* Kb, int ld, const bf16_t* Vt, int j,
                                          const float* kmean  , bf16_t* outp, const float* gvec  , float lam,
                                          int tid, int lane, int wave) {
    constexpr int NC = (MODE == 0) ? 2 : 1;
    constexpr float CS = ((MODE == 0) ? 0.125f : 0.08838834764831845f) * 1.4426950408889634f;
    const int r16 = lane & 15, g = lane >> 4;
    const int q0 = j * 128, qpos = q0 + 16 * wave + r16;
    const int own = j >> 1, half = j & 1;
    const int nown = (MODE == 0) ? 0 : 2 + 2 * half;
    const int ntiles = (MODE == 0) ? 2 * (j + 1) : nown + 4 * own;
    bf16x8 qf[4];
#pragma unroll
    for (int ks = 0; ks < 4; ++ks) qf[ks] = *(const bf16x8*)(Qb + (size_t)qpos * ld + 32 * ks + 8 * g);
    unsigned sel = 0;
    if (MODE == 1) {
        LAS float* km = (LAS float*)(lds + ATT_EXTRA);
        for (int i = tid; i < 16 * 128; i += NTHREADS) km[i] = kmean[i];
        __syncthreads();
        float qv[32];
#pragma unroll
        for (int ks = 0; ks < 4; ++ks) { float f[8]; unpack8(__builtin_bit_cast(u32x4, qf[ks]), f);
#pragma unroll
            for (int e = 0; e < 8; ++e) qv[8 * ks + e] = f[e]; }
        float gate[15]; float t1 = -INFINITY, t2 = -INFINITY, t3 = -INFINITY;
#pragma unroll
        for (int n = 0; n < 15; ++n) {
            gate[n] = -INFINITY;
            if (n < own) {
                float a = 0.f;
#pragma unroll
                for (int ks = 0; ks < 4; ++ks) { const f32x4 k0 = *(const LAS f32x4*)(km + n * 128 + 32 * ks + 8 * g), k1 = *(const LAS f32x4*)(km + n * 128 + 32 * ks + 8 * g + 4);
                    a += (qv[8 * ks + 0] * k0[0] + qv[8 * ks + 1] * k0[1]) + (qv[8 * ks + 2] * k0[2] + qv[8 * ks + 3] * k0[3])
                       + (qv[8 * ks + 4] * k1[0] + qv[8 * ks + 5] * k1[1]) + (qv[8 * ks + 6] * k1[2] + qv[8 * ks + 7] * k1[3]); }
                a += __shfl_xor(a, 16); a += __shfl_xor(a, 32);
                gate[n] = a;
                float v = a; const float n1 = fmaxf(t1, v); v = fminf(t1, v); t1 = n1; const float n2 = fmaxf(t2, v); v = fminf(t2, v); t2 = n2; t3 = fmaxf(t3, v);
            }
        }
        const float theta = (own >= 3) ? t3 : -INFINITY;
#pragma unroll
        for (int n = 0; n < 15; ++n) if (n < own && gate[n] >= theta) sel |= 1u << n;
    }
    f32x4 O[NC][8];
#pragma unroll
    for (int c = 0; c < NC; ++c)
#pragma unroll
        for (int vb = 0; vb < 8; ++vb) O[c][vb] = (f32x4){0.f, 0.f, 0.f, 0.f};
    float mrun[NC], lsum[NC];
#pragma unroll
    for (int c = 0; c < NC; ++c) { mrun[c] = -INFINITY; lsum[c] = 0.f; }

    auto key0_of = [&](int t) -> int { if (MODE == 0) return 64 * t; if (t < nown) return own * 256 + 64 * t; const int tt = t - nown; return (tt >> 2) * 256 + 64 * (tt & 3); };
    u32x4 kreg[2], vreg[2];
    auto load_tile = [&](int t) { const int k0 = key0_of(t);
#pragma unroll
        for (int i = 0; i < 2; ++i) { const int id = tid + NTHREADS * i;
            kreg[i] = *(const u32x4*)(Kb + (size_t)(k0 + (id >> 4)) * ld + (id & 15) * 8);
            vreg[i] = *(const u32x4*)(Vt + (size_t)(id >> 3) * SEQ + k0 + (id & 7) * 8); } };
    auto store_tile = [&](int buf) { LAS unsigned char* base = lds + buf * ATT_BUF;
#pragma unroll
        for (int i = 0; i < 2; ++i) { const int id = tid + NTHREADS * i;
            { const int r = id >> 4; *(LAS u32x4*)(base + r * ATT_KROW + (((id & 15) ^ ((r & 3) + 4 * ((r >> 3) & 3))) << 4)) = kreg[i]; }
            { const int v = id >> 3; *(LAS u32x4*)(base + ATT_KBYTES + v * ATT_VROW + (((id & 7) ^ ((v >> 1) & 7)) << 4)) = vreg[i]; } } };
    load_tile(0); store_tile(0);
    __syncthreads();
    if (ntiles > 1) load_tile(1);
#if defined(ATT_ABL) && ATT_ABL == 4
    if (ntiles > 1) store_tile(1);
    __syncthreads();
#endif
    const int qlo = q0 + 16 * wave;
    const int krow_base = (8 * (r16 >> 2) + (r16 & 3)) * ATT_KROW;
    int koff[4], voff[2];
#pragma unroll
    for (int kk = 0; kk < 4; ++kk) koff[kk] = krow_base + (((4 * kk + g) ^ r16) << 4);
#pragma unroll
    for (int kg = 0; kg < 2; ++kg) voff[kg] = r16 * ATT_VROW + (((4 * kg + g) ^ (r16 >> 1)) << 4);
    for (int t = 0; t < ntiles; ++t) {
        const int k0 = key0_of(t);
        const LAS unsigned char* kb_ = lds + (t & 1) * ATT_BUF;
        const LAS unsigned char* vb_ = kb_ + ATT_KBYTES;
        bool causal, active = true; bool lane_on = true;
        if (MODE == 0) { causal = (k0 + 63 > qlo); active = (k0 <= qlo + 15); }
        else if (t < nown) { causal = true; active = (k0 <= qlo + 15); }
        else { causal = false; const int n = (t - nown) >> 2; lane_on = (sel >> n) & 1u; active = __any(lane_on); }
#if defined(ATT_ABL) && ATT_ABL == 3
        active = false;
#endif
        if (active) {
#pragma unroll
            for (int c = 0; c < NC; ++c) {
                f32x4 s[2][2];
#pragma unroll
                for (int kg = 0; kg < 2; ++kg)
#pragma unroll
                    for (int kb = 0; kb < 2; ++kb) {
                        f32x4 a = (f32x4){0.f, 0.f, 0.f, 0.f};
                        const LAS unsigned char* kr = kb_ + (32 * kg + 4 * kb) * ATT_KROW;
#pragma unroll
                        for (int ks = 0; ks < (MODE == 0 ? 2 : 4); ++ks) { const int kk = (MODE == 0) ? 2 * c + ks : ks;
                            a = mfma16(*(const LAS bf16x8*)(kr + koff[kk]), qf[kk], a); }
                        s[kg][kb] = a;
                    }
                if (causal) {
#pragma unroll
                    for (int kg = 0; kg < 2; ++kg)
#pragma unroll
                        for (int kb = 0; kb < 2; ++kb)
#pragma unroll
                            for (int e = 0; e < 4; ++e) if (k0 + 32 * kg + 8 * g + 4 * kb + e > qpos) s[kg][kb][e] = -INFINITY;
                }
                if (MODE == 1 && !lane_on) {
#pragma unroll
                    for (int kg = 0; kg < 2; ++kg)
#pragma unroll
                        for (int kb = 0; kb < 2; ++kb) s[kg][kb] = (f32x4){-INFINITY, -INFINITY, -INFINITY, -INFINITY};
                }
                float tm = -INFINITY;
#pragma unroll
                for (int kg = 0; kg < 2; ++kg)
#pragma unroll
                    for (int kb = 0; kb < 2; ++kb) tm = fmaxf(tm, fmaxf(fmaxf(s[kg][kb][0], s[kg][kb][1]), fmaxf(s[kg][kb][2], s[kg][kb][3])));
                if (__any((tm - mrun[c]) * CS > 6.0f)) {
                    tm = fmaxf(tm, __shfl_xor(tm, 16)); tm = fmaxf(tm, __shfl_xor(tm, 32));
                    const float mn = fmaxf(mrun[c], tm);
                    const float alpha = __builtin_amdgcn_exp2f((mrun[c] - mn) * CS);
                    mrun[c] = mn; lsum[c] *= alpha;
#pragma unroll
                    for (int vb = 0; vb < 8; ++vb) O[c][vb] *= alpha;
                }
                const float mc = mrun[c] * CS;
                f32x4 psv = (f32x4){0.f, 0.f, 0.f, 0.f};
                bf16x8 pk[2];
#pragma unroll
                for (int kg = 0; kg < 2; ++kg) {
                    float pe[8];
#pragma unroll
                    for (int kb = 0; kb < 2; ++kb) { const f32x4 t4 = s[kg][kb] * CS - mc; f32x4 p4;
#pragma unroll
#if defined(ATT_ABL) && ATT_ABL == 2
                        for (int e = 0; e < 4; ++e) { p4[e] = t4[e]; pe[4 * kb + e] = p4[e]; }
#else
                        for (int e = 0; e < 4; ++e) { p4[e] = __builtin_amdgcn_exp2f(t4[e]); pe[4 * kb + e] = p4[e]; }
#endif
                        psv += p4; }
                    pk[kg] = __builtin_bit_cast(bf16x8, pack8(pe));
                }
                lsum[c] += (psv[0] + psv[1]) + (psv[2] + psv[3]);
#if defined(ATT_ABL) && ATT_ABL == 1
                asm volatile("" :: "v"(pk[0]), "v"(pk[1]));
#else
#pragma unroll
                for (int vb = 0; vb < 8; ++vb) {
#pragma unroll
                    for (int kg = 0; kg < 2; ++kg)
                        O[c][vb] = mfma16(*(const LAS bf16x8*)(vb_ + 16 * vb * ATT_VROW + voff[kg]), pk[kg], O[c][vb]); }
#endif
#ifndef ATT_NO_SCHED_BAR
                __builtin_amdgcn_sched_barrier(0);
#endif
            }
        }
#if !(defined(ATT_ABL) && ATT_ABL == 4)
        if (t + 1 < ntiles) store_tile((t + 1) & 1);
        if (t + 2 < ntiles) load_tile(t + 2);
        __syncthreads();
#endif
    }
#if defined(ATT_ABL) && ATT_ABL == 4
    __syncthreads();
#endif
    float linv[NC];
#pragma unroll
    for (int c = 0; c < NC; ++c) { float l = lsum[c]; l += __shfl_xor(l, 16); l += __shfl_xor(l, 32); linv[c] = 1.f / l;
#if defined(ATT_ABL) && ATT_ABL == 3
        linv[c] = 1.f;
#endif
    }
    if (MODE == 0) {
        const float i0 = linv[0], i1 = lam * linv[1];
        float ss = 0.f; f32x4 y[8];
#pragma unroll
        for (int vb = 0; vb < 8; ++vb) { y[vb] = O[0][vb] * i0 - O[NC - 1][vb] * i1; ss += (y[vb][0] * y[vb][0] + y[vb][1] * y[vb][1]) + (y[vb][2] * y[vb][2] + y[vb][3] * y[vb][3]); }
        ss += __shfl_xor(ss, 16); ss += __shfl_xor(ss, 32);
        const float r = rsqrtf(ss * (1.f / 128.f) + EPS) * 0.8f;
#pragma unroll
        for (int vb = 0; vb < 8; ++vb) { const f32x4 gv = *(const f32x4*)(gvec + 16 * vb + 4 * g); const f32x4 o = y[vb] * r * gv;
            u32x2 w; w.x = pk_bf16(o[0], o[1]); w.y = pk_bf16(o[2], o[3]);
            *(u32x2*)(outp + (size_t)qpos * DM + 16 * vb + 4 * g) = w; }
    } else {
#pragma unroll
        for (int vb = 0; vb < 8; ++vb) { const f32x4 o = O[0][vb] * linv[0];
            u32x2 w; w.x = pk_bf16(o[0], o[1]); w.y = pk_bf16(o[2], o[3]);
            *(u32x2*)(outp + (size_t)qpos * DM + 16 * vb + 4 * g) = w; }
    }
}

__device__ __forceinline__ void mlstm_scan(const Params& p, int idx) {
    unsigned char* ws = p.ws;
    const int bh = idx >> 12, ch = idx & 4095;
    const float* chs = (const float*)(ws + WS_CHS) + (size_t)bh * 64;
    const bf16_t* Cl = (const bf16_t*)(ws + WS_CLOC) + (size_t)bh * 32 * 32768 + (size_t)ch * 8;
    bf16_t* Cp = (bf16_t*)(ws + WS_CPREV) + (size_t)bh * 32 * 32768 + (size_t)ch * 8;
    const bool do_n = ch < 16;
    const float* nl = (const float*)(ws + WS_NLOC) + (size_t)bh * 32 * 128 + ch * 8;
    float* np = (float*)(ws + WS_NPREV) + (size_t)bh * 32 * 128 + ch * 8;
    float st[8], nst[8];
#pragma unroll
    for (int e = 0; e < 8; ++e) { st[e] = 0.f; nst[e] = 0.f; }
    float m = 0.f;
#pragma unroll 8
    for (int c = 0; c < 32; ++c) {
        const u32x4 cl = *(const u32x4*)(Cl + (size_t)c * 32768);
        *(u32x4*)(Cp + (size_t)c * 32768) = pack8(st);
        if (do_n) { *(f32x4*)(np + c * 128) = (f32x4){nst[0], nst[1], nst[2], nst[3]}; *(f32x4*)(np + c * 128 + 4) = (f32x4){nst[4], nst[5], nst[6], nst[7]}; }
        if (ch == 0) ((float*)(ws + WS_MPREV))[bh * 32 + c] = m;
        const float gc = chs[2 * c], ml = chs[2 * c + 1];
        const float mn = fmaxf(gc + m, ml), a = __expf(gc + m - mn), b = __expf(ml - mn);
        float f[8]; unpack8(cl, f);
#pragma unroll
        for (int e = 0; e < 8; ++e) st[e] = a * st[e] + b * f[e];
        if (do_n) { const f32x4 n0 = *(const f32x4*)(nl + c * 128), n1 = *(const f32x4*)(nl + c * 128 + 4);
#pragma unroll
            for (int e = 0; e < 4; ++e) { nst[e] = a * nst[e] + b * n0[e]; nst[4 + e] = a * nst[4 + e] + b * n1[e]; } }
        m = mn;
    }
}

__device__ __forceinline__ int swz256(int row, int ch) { return row * 256 + ((ch ^ (row & 15)) << 4); }
__device__ __forceinline__ void mlstm_out_unit(const Params& p, LAS unsigned char* lds, int unit, int tid, int lane, int wave) {
    const int c = unit & 31, h = (unit >> 5) & 3, b = unit >> 7, bh = b * 4 + h;
    unsigned char* ws = p.ws;
    LAS unsigned char* Cp = lds;
    LAS unsigned char* Vt = lds + 65536;
    LAS float* sc = (LAS float*)(lds + 131072);
    const int s0 = c * 128;
    if (wave == 0) {
        float mp = ((const float*)(ws + WS_MPREV))[bh * 32 + c];
        if (lane == 0) sc[544] = mp;
        const float* lf = (const float*)(ws + WS_LF) + (size_t)bh * SEQ + s0;
        const float* li = (const float*)(ws + WS_LI) + (size_t)bh * SEQ + s0;
        const float e0 = lf[2 * lane], e1 = lf[2 * lane + 1];
        float incl = e0 + e1;
#pragma unroll
        for (int o = 1; o < 64; o <<= 1) { const float t = __shfl_up(incl, o); if (lane >= o) incl += t; }
        const float b0 = incl - e1, b1 = incl;
        const float u0 = li[2 * lane] - b0, u1 = li[2 * lane + 1] - b1;
        float cm = fmaxf(u0, u1);
#pragma unroll
        for (int o = 1; o < 64; o <<= 1) { const float t = __shfl_up(cm, o); if (lane >= o) cm = fmaxf(cm, t); }
        float pm = __shfl_up(cm, 1); if (lane == 0) pm = -INFINITY;
        sc[160 + 2 * lane] = b0; sc[160 + 2 * lane + 1] = b1;
        sc[288 + 2 * lane] = u0; sc[288 + 2 * lane + 1] = u1;
        sc[416 + 2 * lane] = fmaxf(mp, fmaxf(pm, u0)); sc[416 + 2 * lane + 1] = fmaxf(mp, cm);
    }
    __syncthreads();
    {
        if (c > 0) {
            const bf16_t* Cpg = (const bf16_t*)(ws + WS_CPREV) + (size_t)(bh * 32 + c) * 32768;
#pragma unroll
            for (int i = 0; i < 8; ++i) { const int id = tid + NTHREADS * i; *(LAS u32x4*)(Cp + swz256(id >> 4, id & 15)) = *(const u32x4*)(Cpg + (size_t)id * 8); }
            if (tid < 128) sc[32 + tid] = ((const float*)(ws + WS_NPREV))[(size_t)(bh * 32 + c) * 128 + tid];
        }
        const bf16_t* Vtm = (const bf16_t*)(ws + WS_VTM) + ((size_t)bh * 256) * SEQ + s0;
#pragma unroll
        for (int i = 0; i < 8; ++i) { const int id = tid + NTHREADS * i, v = id >> 4, ch = id & 15;
            *(LAS u32x4*)(Vt + swz256(v, ch)) = *(const u32x4*)(Vtm + (size_t)v * SEQ + ch * 8); }
    }
    __syncthreads();
    const int r16 = lane & 15, g = lane >> 4;
    const int tl = 16 * wave + r16;
    const float mprev = sc[544], Mt = sc[416 + tl], bc = sc[160 + tl];
    const float winter = __expf(mprev - Mt);
    const bf16_t* Qm = (const bf16_t*)(ws + WS_QM) + ((size_t)bh * SEQ + s0) * 128;
    const bf16_t* Km = (const bf16_t*)(ws + WS_KM) + ((size_t)bh * SEQ + s0) * 128;
    bf16x8 qf[4];
#pragma unroll
    for (int ks = 0; ks < 4; ++ks) qf[ks] = *(const bf16x8*)(Qm + (size_t)tl * 128 + 32 * ks + 8 * g);
    f32x4 acc[16];
#pragma unroll
    for (int vb = 0; vb < 16; ++vb) acc[vb] = (f32x4){0.f, 0.f, 0.f, 0.f};
    float den = 0.f;
    if (c > 0) {
#pragma unroll
        for (int vb = 0; vb < 16; ++vb) {
#pragma unroll
            for (int ks = 0; ks < 4; ++ks) acc[vb] = mfma16(*(const LAS bf16x8*)(Cp + swz256(16 * vb + r16, 4 * ks + g)), qf[ks], acc[vb]);
            acc[vb] *= winter;
        }
        float qn = 0.f;
#pragma unroll
        for (int ks = 0; ks < 4; ++ks) { float f[8]; unpack8(__builtin_bit_cast(u32x4, qf[ks]), f);
#pragma unroll
            for (int e = 0; e < 8; ++e) qn += f[e] * sc[32 + 32 * ks + 8 * g + e]; }
        qn += __shfl_xor(qn, 16); qn += __shfl_xor(qn, 32);
        den = winter * qn * 0.25f;
    }
    const int nsb = (wave >> 1) + 1;
    for (int sb = 0; sb < nsb; ++sb) {
        f32x4 sv[2];
#pragma unroll
        for (int kb = 0; kb < 2; ++kb) {
            f32x4 a = (f32x4){0.f, 0.f, 0.f, 0.f};
            const bf16_t* kr = Km + (size_t)(32 * sb + 8 * (r16 >> 2) + 4 * kb + (r16 & 3)) * 128 + 8 * g;
#pragma unroll
            for (int ks = 0; ks < 4; ++ks) a = mfma16(*(const bf16x8*)(kr + 32 * ks), qf[ks], a);
            sv[kb] = a;
        }
        float pe[8];
#pragma unroll
        for (int kb = 0; kb < 2; ++kb)
#pragma unroll
            for (int e = 0; e < 4; ++e) { const int s = 32 * sb + 8 * g + 4 * kb + e;
                const float w = (s <= tl) ? __expf(sc[288 + s] - Mt) : 0.f; const float x = sv[kb][e] * w; pe[4 * kb + e] = x; den += x; }
        const bf16x8 pf = __builtin_bit_cast(bf16x8, pack8(pe));
#pragma unroll
        for (int vb = 0; vb < 16; ++vb) acc[vb] = mfma16(*(const LAS bf16x8*)(Vt + swz256(16 * vb + r16, 4 * sb + g)), pf, acc[vb]);
    }
    den += __shfl_xor(den, 16); den += __shfl_xor(den, 32);
    const float dinv = 1.f / fmaxf(fabsf(den), __expf(-(bc + Mt)));
    float ss = 0.f;
#pragma unroll
    for (int vb = 0; vb < 16; ++vb) { acc[vb] *= dinv; ss += (acc[vb][0] * acc[vb][0] + acc[vb][1] * acc[vb][1]) + (acc[vb][2] * acc[vb][2] + acc[vb][3] * acc[vb][3]); }
    ss += __shfl_xor(ss, 16); ss += __shfl_xor(ss, 32);
    const float r = rsqrtf(ss * (1.f / 256.f) + EPS);
    const size_t trow = (size_t)b * SEQ + s0 + tl;
    const bf16_t* ao = (const bf16_t*)(ws + WS_PROJ) + trow * EVEN_IN + 2048 + h * 256;
    bf16_t* outp = (bf16_t*)(ws + WS_CAT) + trow * DM + h * 256;
    const float* hg = p.in[12] + h * 256;
#pragma unroll
    for (int vb = 0; vb < 16; ++vb) { const int v = 16 * vb + 4 * g;
        const u32x2 aw = *(const u32x2*)(ao + v); const f32x4 gv = *(const f32x4*)(hg + v);
        const float o0 = acc[vb][0] * r * gv[0] * sigmoidf_(bf_lo(aw.x)), o1 = acc[vb][1] * r * gv[1] * sigmoidf_(bf_hi(aw.x));
        const float o2 = acc[vb][2] * r * gv[2] * sigmoidf_(bf_lo(aw.y)), o3 = acc[vb][3] * r * gv[3] * sigmoidf_(bf_hi(aw.y));
        u32x2 w; w.x = pk_bf16(o0, o1); w.y = pk_bf16(o2, o3); *(u32x2*)(outp + v) = w; }
    __syncthreads();
}
__device__ __forceinline__ void moba_post_item(const Params& p, LAS unsigned char* lds, int item, int tid) {
    const int blk = item & 15, h = (item >> 4) & 7, b = item >> 7;
    bf16_t* proj = (bf16_t*)(p.ws + WS_PROJ);
    const float* tab = (const float*)(p.ws + WS_ROPE);
    const size_t row0 = (size_t)b * SEQ + blk * 256;
    {
        const int dc = tid & 15, tg = tid >> 4;
        float a[8];
#pragma unroll
        for (int e = 0; e < 8; ++e) a[e] = 0.f;
        for (int tt = 0; tt < 8; ++tt) {
            const size_t row = row0 + tg * 8 + tt;
            const bf16_t* kp = proj + row * ODD_IN + 1024 + h * 128;
            float x[8]; unpack8(*(const u32x4*)(kp + dc * 8), x);
            if (dc < 4) {
                float y[8]; unpack8(*(const u32x4*)(kp + (dc ^ 2) * 8), y);
                const float* tb = tab + row * 48 + 16 + 16 * (dc & 1);
#pragma unroll
                for (int e = 0; e < 8; ++e) { const float cs = tb[2 * e], sn = tb[2 * e + 1];
                    x[e] = (dc < 2) ? (x[e] * cs - y[e] * sn) : (x[e] * cs + y[e] * sn); }
            }
#pragma unroll
            for (int e = 0; e < 8; ++e) a[e] += x[e];
        }
        LAS float* part = (LAS float*)lds;
#pragma unroll
        for (int e = 0; e < 8; ++e) part[tg * 128 + dc * 8 + e] = a[e];
        __syncthreads();
        if (tid < 128) { float s = 0.f;
#pragma unroll 8
            for (int i = 0; i < 32; ++i) s += part[i * 128 + tid];
            ((float*)(p.ws + WS_KMEAN))[((size_t)(b * 8 + h) * 16 + blk) * 128 + tid] = s * (1.f / 256.f); }
        __syncthreads();
    }
    {
        const int tok = tid >> 1, qk = tid & 1;
        bf16_t* ptr = proj + (row0 + tok) * ODD_IN + qk * 1024 + h * 128;
        float x1[16], x2[16], o1[16], o2[16];
        unpack8(*(const u32x4*)ptr, x1); unpack8(*(const u32x4*)(ptr + 8), x1 + 8); unpack8(*(const u32x4*)(ptr + 16), x2); unpack8(*(const u32x4*)(ptr + 24), x2 + 8);
        const float* tb = tab + (row0 + tok) * 48 + 16;
#pragma unroll
        for (int e = 0; e < 16; ++e) { const float cs = tb[2 * e], sn = tb[2 * e + 1]; o1[e] = x1[e] * cs - x2[e] * sn; o2[e] = x2[e] * cs + x1[e] * sn; }
        *(u32x4*)ptr = pack8(o1); *(u32x4*)(ptr + 8) = pack8(o1 + 8); *(u32x4*)(ptr + 16) = pack8(o2); *(u32x4*)(ptr + 24) = pack8(o2 + 8);
    }
}

__device__ __forceinline__ void sgu_unit(const Params& p, LAS unsigned char* lds, int unit, int tid, int lane, int wave) {
    const int gq = unit & 7, c = (unit >> 3) & 31, b = unit >> 8;
    const bf16_t* proj = (const bf16_t*)(p.ws + WS_PROJ);
    LAS unsigned char* vnT = lds;
    const size_t row0 = (size_t)b * SEQ + c * 128;
    {
        const int pt = 16 * wave + (lane >> 2), sub = lane & 3;
        const bf16_t* src = proj + (row0 + pt) * ODD_IN + 4096 + gq * 128 + sub * 32;
        float x[32];
#pragma unroll
        for (int i = 0; i < 4; ++i) unpack8(*(const u32x4*)(src + 8 * i), x + 8 * i);
        float s1 = 0.f;
#pragma unroll
        for (int e = 0; e < 32; ++e) { x[e] = gelu_tanh(x[e]); s1 += x[e]; }
        s1 += __shfl_xor(s1, 1); s1 += __shfl_xor(s1, 2);
        const float mu = s1 * (1.f / 128.f);
        float s2 = 0.f;
#pragma unroll
        for (int e = 0; e < 32; ++e) { x[e] -= mu; s2 += x[e] * x[e]; }
        s2 += __shfl_xor(s2, 1); s2 += __shfl_xor(s2, 2);
        const float r = rsqrtf(s2 * (1.f / 128.f) + EPS);
        const float* lg = p.in[17] + gq * 128 + sub * 32; const float* lb = p.in[18] + gq * 128 + sub * 32;
#pragma unroll
        for (int e = 0; e < 32; ++e) { const int d = sub * 32 + e;
            *(LAS bf16_t*)(vnT + d * 272 + ((((pt >> 3) ^ ((d >> 3) & 15)) << 4) + (pt & 7) * 2)) = f2bf(x[e] * r * lg[e] + lb[e]); }
    }
    __syncthreads();
    const int r16 = lane & 15, g = lane >> 4;
    const int prow = 16 * wave + r16;
    f32x4 acc[8];
#pragma unroll
    for (int db = 0; db < 8; ++db) acc[db] = (f32x4){0.f, 0.f, 0.f, 0.f};
    const float* W = p.in[19] + ((size_t)gq * 128 + prow) * 128;
    const int nrs = (wave >> 1) + 1;
    for (int rs = 0; rs < nrs; ++rs) {
        const int r0 = 32 * rs + 8 * g;
        const f32x4 w0 = *(const f32x4*)(W + r0), w1 = *(const f32x4*)(W + r0 + 4);
        float wf[8] = {w0[0], w0[1], w0[2], w0[3], w1[0], w1[1], w1[2], w1[3]};
#pragma unroll
        for (int e = 0; e < 8; ++e) if (r0 + e > prow) wf[e] = 0.f;
        const bf16x8 af = __builtin_bit_cast(bf16x8, pack8(wf));
#pragma unroll
        for (int db = 0; db < 8; ++db) { const int d = 16 * db + r16; acc[db] = mfma16(*(const LAS bf16x8*)(vnT + d * 272 + (((4 * rs + g) ^ ((d >> 3) & 15)) << 4)), af, acc[db]); }
    }
    bf16_t* cat = (bf16_t*)(p.ws + WS_CAT);
    {
        const float bs = p.in[20][gq * 128 + prow];
        const bf16_t* up = proj + (row0 + prow) * ODD_IN + 3072 + gq * 128 + 4 * g;
        bf16_t* op = cat + (row0 + prow) * DM + 1024 + gq * 128 + 4 * g;
#pragma unroll
        for (int db = 0; db < 8; ++db) { const u32x2 uw = *(const u32x2*)(up + 16 * db);
            u32x2 w; w.x = pk_bf16(gelu_tanh(bf_lo(uw.x)) * (acc[db][0] + bs), gelu_tanh(bf_hi(uw.x)) * (acc[db][1] + bs));
            w.y = pk_bf16(gelu_tanh(bf_lo(uw.y)) * (acc[db][2] + bs), gelu_tanh(bf_hi(uw.y)) * (acc[db][3] + bs));
            *(u32x2*)(op + 16 * db) = w; }
    }
    __syncthreads();
}

__device__ __forceinline__ void ins16(float (&val)[16], float v) {
#pragma unroll
    for (int i = 0; i < 16; ++i) { const float hi = fmaxf(val[i], v); v = fminf(val[i], v); val[i] = hi; }
}
template <int N>
__device__ __forceinline__ void bitonic_sort_desc(float (&v)[N]) {
#pragma unroll
    for (int k = 2; k <= N; k <<= 1)
#pragma unroll
        for (int j = k >> 1; j > 0; j >>= 1)
#pragma unroll
            for (int i = 0; i < N; ++i) { const int l = i ^ j;
                if (l > i) { const bool desc = ((i & k) == 0); const float a = v[i], b = v[l], hi = fmaxf(a, b), lo = fminf(a, b); v[i] = desc ? hi : lo; v[l] = desc ? lo : hi; } }
}
template <int XM>
__device__ __forceinline__ void merge_top16(float (&t)[16]) {
    float w[16];
#pragma unroll
    for (int i = 0; i < 16; ++i) w[i] = fmaxf(t[i], __shfl_xor(t[15 - i], XM));
#pragma unroll
    for (int j = 8; j > 0; j >>= 1)
#pragma unroll
        for (int i = 0; i < 16; ++i) { const int l = i ^ j; if (l > i) { const float a = w[i], b = w[l]; w[i] = fmaxf(a, b); w[l] = fminf(a, b); } }
#pragma unroll
    for (int i = 0; i < 16; ++i) t[i] = w[i];
}
template <bool LAST>
__device__ __forceinline__ void peer_tile(const Params& p, LAS unsigned char* lds, int layer, int tile, int tid, int lane, int wave) {
    unsigned char* ws = p.ws;
    LAS unsigned* eL = (LAS unsigned*)lds;
    LAS float* wL = (LAS float*)(lds + 32768);
    const int r16 = lane & 15, g = lane >> 4;
    const size_t tok0 = (size_t)tile * 64;
    {
        LAS unsigned* ctr0 = (LAS unsigned*)(lds + 114688);
        if (tid < 96) ctr0[tid] = 0u;
        LAS float* part0 = (LAS float*)(lds + 65536);
#pragma unroll
        for (int i = 0; i < 16; ++i) part0[tid + NTHREADS * i] = 0.f;
    }
    {
        const int tg = wave & 3, hs = wave >> 2;
        const bf16_t* SK = (const bf16_t*)(ws + WS_SK) + (size_t)layer * 8 * 2 * 128 * 128;
#pragma unroll 1
        for (int hh = 0; hh < 4; ++hh) {
            const int h = 4 * hs + hh;
            int r16q = r16; asm volatile("" : "+v"(r16q));
            const bf16_t* qrow = (const bf16_t*)(ws + WS_QP) + (tok0 + 16 * tg + r16q) * DM;
            float L[2][16];
#pragma unroll 1
            for (int c = 0; c < 2; ++c) {
                bf16x8 qf[4];
#pragma unroll
                for (int ks = 0; ks < 4; ++ks) qf[ks] = *(const bf16x8*)(qrow + h * 256 + c * 128 + 32 * ks + 8 * g);
                const bf16_t* skc = SK + (size_t)(h * 2 + c) * 128 * 128;
                float scv[32];
#pragma unroll
                for (int nb = 0; nb < 8; ++nb) {
                    f32x4 a = (f32x4){0.f, 0.f, 0.f, 0.f};
#pragma unroll
                    for (int ks = 0; ks < 4; ++ks) a = mfma16(*(const bf16x8*)(skc + (size_t)(16 * nb + r16) * 128 + 32 * ks + 8 * g), qf[ks], a);
#pragma unroll
                    for (int e = 0; e < 4; ++e) { const int n = 16 * nb + 4 * g + e;
                        scv[4 * nb + e] = __uint_as_float((__float_as_uint(a[e]) & 0xffffff80u) | (unsigned)(127 - n)); }
                }
                float Lc[16], Ld[16];
#pragma unroll
                for (int k = 0; k < 16; ++k) { Lc[k] = scv[k]; Ld[k] = scv[16 + k]; }
                bitonic_sort_desc<16>(Lc); bitonic_sort_desc<16>(Ld);
#pragma unroll
                for (int k = 0; k < 16; ++k) Lc[k] = fmaxf(Lc[k], Ld[15 - k]);
#pragma unroll
                for (int j = 8; j > 0; j >>= 1)
#pragma unroll
                    for (int i = 0; i < 16; ++i) { const int l = i ^ j; if (l > i) { const float a = Lc[i], b = Lc[l]; Lc[i] = fmaxf(a, b); Lc[l] = fminf(a, b); } }
                merge_top16<16>(Lc); merge_top16<32>(Lc);
#pragma unroll
                for (int k = 0; k < 16; ++k) { if (c == 0) L[0][k] = Lc[k]; else L[1][k] = Lc[k]; }
            }
            float top[16];
#pragma unroll
            for (int q = 0; q < 16; ++q) top[q] = -INFINITY;
            {
                int cix = 0;
#pragma unroll
                for (int i = 0; i < 16; ++i)
#pragma unroll
                    for (int jj = 0; jj < 16; ++jj)
                        if ((i + 1) * (jj + 1) <= 16) {
                            const float key = __uint_as_float((__float_as_uint(L[0][i] + L[1][jj]) & 0xffffff00u) | (unsigned)(i * 16 + jj));
                            top[cix >> 2] = ((cix & 3) == g) ? key : top[cix >> 2];
                            ++cix;
                        }
            }
            bitonic_sort_desc<16>(top); merge_top16<16>(top); merge_top16<32>(top);
            const float mx = top[0]; float e16[16]; float se = 0.f;
#pragma unroll
            for (int k = 0; k < 16; ++k) { e16[k] = __expf(top[k] - mx); se += e16[k]; }
            const float inv = 1.f / se;
            LAS unsigned char* ixb = (LAS unsigned char*)(lds + 98304 + wave * 2048) + lane;
#pragma unroll
            for (int q = 0; q < 16; ++q) { ixb[q * 64] = (unsigned char)(127u - (__float_as_uint(L[0][q]) & 127u)); ixb[(16 + q) * 64] = (unsigned char)(127u - (__float_as_uint(L[1][q]) & 127u)); }
#pragma unroll
            for (int k = 0; k < 16; ++k) {
                const unsigned id = __float_as_uint(top[k]) & 0xffu; const unsigned ii = id >> 4, jj = id & 15u;
                const unsigned ex = (unsigned)ixb[ii * 64] * 128u + (unsigned)ixb[(16 + jj) * 64];
                if (g == 0) { eL[(16 * tg + r16) * 128 + h * 16 + k] = ex; wL[(16 * tg + r16) * 128 + h * 16 + k] = e16[k] * inv; }
            }
        }
    }
    __syncthreads();
#ifdef PEER_STAMP
    if (layer == 0) { PEER_STAMP; }
#endif
    { unsigned z2 = 0; asm volatile("" : "+s"(z2)); lane = (int)__builtin_amdgcn_mbcnt_hi(~0u, __builtin_amdgcn_mbcnt_lo(~0u, z2)); }
    const int g8 = lane >> 3, j8 = lane & 7;
    const bool b0 = lane & 1, b1 = (lane >> 1) & 1, b2 = (lane >> 2) & 1;
    LAS float* part = (LAS float*)(lds + 65536);
    const unsigned char* U8 = ws + WS_U + (size_t)layer * 16384 * 1024;
    LAS unsigned* ctr = (LAS unsigned*)(lds + 114688);
    LAS unsigned* done = ctr + 32;
#define PEER_GRAB(which_) ({ unsigned v_ = 0u; if (lane == 0) v_ = __hip_atomic_fetch_add(ctr + (which_), 1u, __ATOMIC_RELAXED, __HIP_MEMORY_SCOPE_WORKGROUP); (int)__builtin_amdgcn_readfirstlane(v_); })
#define PEER_ISSUE(dst, base, jo_, tl_, hf_, gq) do { _Pragma("unroll") for (int bb = 0; bb < 8; ++bb) { const unsigned ex_ = eL[(tl_) * 128 + 64 * (hf_) + 8 * bb + (gq)]; \
        dst[bb] = *(const GAS u32x4*)((base) + (unsigned)(ex_ * 128u + (jo_))); } } while (0)
#define PEER_CVT4(w_, k_) __builtin_amdgcn_cvt_scalef32_pk_f32_fp4((unsigned)(w_), 1.0f, k_)
#define PEER_UDOT(src, hf_) do { float pd[8]; \
        _Pragma("unroll") for (int bb = 0; bb < 8; ++bb) { int aL = 0, aH = 0; asm volatile("" : "+v"(src[bb])); \
            _Pragma("unroll") for (int d = 0; d < 4; ++d) { const int w = (int)src[bb][d]; \
                aL = __builtin_amdgcn_sdot4(w & 0x0F0F0F0F, xw[2 * d], aL, false); aH = __builtin_amdgcn_sdot4(w & (int)0xF0F0F0F0u, xw[2 * d + 1], aH, false); } \
            pd[bb] = (float)(aL * 16 + aH) * 0.0625f + cx; __builtin_amdgcn_sched_barrier(0); } \
        float r4[4], r2[2]; \
        _Pragma("unroll") for (int i = 0; i < 4; ++i) r4[i] = (b2 ? pd[4 + i] : pd[i]) + dpp_xor4(b2 ? pd[i] : pd[4 + i]); \
        _Pragma("unroll") for (int i = 0; i < 2; ++i) r2[i] = (b1 ? r4[2 + i] : r4[i]) + dpp_xor2(b1 ? r4[i] : r4[2 + i]); \
        const float r1 = (b0 ? r2[1] : r2[0]) + dpp_xor1(b0 ? r2[0] : r2[1]); \
        part[tl * 128 + 64 * (hf_) + 8 * j8 + g8] += r1; } while (0)
    {
        const GAS unsigned char* U8g = (const GAS unsigned char*)U8; const unsigned jo = 16u * (unsigned)j8;
        const GAS unsigned char* xlane = (const GAS unsigned char*)(ws + WS_HN8) + tok0 * DM + 32 * j8;
        u32x4 ua[8], ub[8], xc[2];
        int cur = PEER_GRAB(0);
        if (cur < 512) {
            PEER_ISSUE(ua, U8g + (size_t)(cur >> 6) * (16384 * 128), jo, cur & 63, 0, g8);
#pragma unroll
            for (int i = 0; i < 2; ++i) xc[i] = *(const GAS u32x4*)(xlane + (unsigned)((cur & 63) * DM + (cur >> 6) * 256 + 16 * i));
        }
#pragma unroll 1
        while (cur < 512) {
            const int cb = cur >> 6, tl = cur & 63;
            const int nxt = PEER_GRAB(0);
            const GAS unsigned char* Ucb = U8g + (size_t)cb * (16384 * 128);
            PEER_ISSUE(ub, Ucb, jo, tl, 1, g8);
            int xw[8];
#pragma unroll
            for (int i = 0; i < 2; ++i) { xw[4 * i] = (int)xc[i].x; xw[4 * i + 1] = (int)xc[i].y; xw[4 * i + 2] = (int)xc[i].z; xw[4 * i + 3] = (int)xc[i].w; }
            int sL = 0, sH = 0;
#pragma unroll
            for (int d = 0; d < 4; ++d) { sL = __builtin_amdgcn_sdot4(xw[2 * d], 0x01010101, sL, false); sH = __builtin_amdgcn_sdot4(xw[2 * d + 1], 0x01010101, sH, false); }
            const float cx = 0.5f * (float)sH - 7.5f * (float)sL;
            if (nxt < 512) {
#pragma unroll
                for (int i = 0; i < 2; ++i) xc[i] = *(const GAS u32x4*)(xlane + (unsigned)((nxt & 63) * DM + (nxt >> 6) * 256 + 16 * i)); }
            while ((int)__builtin_amdgcn_readfirstlane(((volatile LAS unsigned*)done)[tl]) != cb) __builtin_amdgcn_s_sleep(1);
            __builtin_amdgcn_sched_barrier(0);
            PEER_UDOT(ua, 0);
            if (nxt < 512) PEER_ISSUE(ua, U8g + (size_t)(nxt >> 6) * (16384 * 128), jo, nxt & 63, 0, g8);
            __builtin_amdgcn_sched_barrier(0);
            PEER_UDOT(ub, 1);
            if (lane == 0) ((volatile LAS unsigned*)done)[tl] = (unsigned)(cb + 1);
            cur = nxt;
        }
    }
    __syncthreads();
#undef PEER_UDOT
#ifdef PEER_STAMP
    if (layer == 0 && TSEL_A >= 0 && blockIdx.x == PSB && threadIdx.x == PST) ((unsigned long long*)(p.ws + (512 * 1024) + 1024))[22] = __builtin_amdgcn_s_memrealtime();
#endif
    unsigned char* wsw = ws; asm volatile("" : "+s"(wsw));
    const GAS float* SCU = (const GAS float*)(wsw + WS_SCL) + layer * 16384;
    const GAS float* SCV = (const GAS float*)(wsw + WS_SCL) + 32768 + layer * 16384;
#pragma unroll 1
    for (int tt = 0; tt < 8; ++tt) { const int tl = 8 * wave + tt;
        const float xs = ((const GAS float*)(wsw + WS_XS))[tok0 + tl];
#pragma unroll
        for (int i = 0; i < 2; ++i) { const int pk_ = tl * 128 + lane + 64 * i; const unsigned ex = eL[pk_];
            wL[pk_] = wL[pk_] * gelu_tanh(part[pk_] * (SCU[ex] * xs)) * SCV[ex]; } }
    unsigned char* wsv = ws; asm volatile("" : "+s"(wsv));
    const unsigned char* V8 = wsv + WS_V + (size_t)layer * 16384 * 1024;
    bf16_t* OUTT = (bf16_t*)(wsv + WS_PROJ);
    int lane_v = lane; asm volatile("" : "+v"(lane_v));
    const int g8v = lane_v >> 3, j8v = lane_v & 7; const bool c3 = (lane_v >> 3) & 1, c4 = (lane_v >> 4) & 1, c5 = (lane_v >> 5) & 1;
#define PEER_VACC(src, hf_) do { _Pragma("unroll") for (int bb = 0; bb < 8; ++bb) { const float wq = wL[tl * 128 + 64 * (hf_) + 8 * bb + g8v]; asm volatile("" : "+v"(src[bb])); \
            const f32x2_t wq2 = {wq, wq}; \
            _Pragma("unroll") for (int d = 0; d < 4; ++d) { const unsigned w = src[bb][d]; \
                ac2[4 * d] = __builtin_elementwise_fma(PEER_CVT4(w, 0), wq2, ac2[4 * d]); ac2[4 * d + 1] = __builtin_elementwise_fma(PEER_CVT4(w, 1), wq2, ac2[4 * d + 1]); \
                ac2[4 * d + 2] = __builtin_elementwise_fma(PEER_CVT4(w, 2), wq2, ac2[4 * d + 2]); ac2[4 * d + 3] = __builtin_elementwise_fma(PEER_CVT4(w, 3), wq2, ac2[4 * d + 3]); } \
            __builtin_amdgcn_sched_barrier(0); } } while (0)
    __syncthreads();
    {
        const GAS unsigned char* V8g = (const GAS unsigned char*)V8; const unsigned jov = 16u * (unsigned)j8v;
        u32x4 va[8], vb[8];
        int cur = PEER_GRAB(1);
        if (cur < 512) PEER_ISSUE(va, V8g + (size_t)(cur >> 6) * (16384 * 128), jov, cur & 63, 0, g8v);
#pragma unroll 1
        while (cur < 512) {
            const int cb = cur >> 6, tl = cur & 63; const size_t tok = tok0 + tl;
            const int nxt = PEER_GRAB(1);
            PEER_ISSUE(vb, V8g + (size_t)cb * (16384 * 128), jov, tl, 1, g8v);
            f32x2_t ac2[16];
#pragma unroll
            for (int c = 0; c < 16; ++c) ac2[c] = (f32x2_t){0.f, 0.f};
            __builtin_amdgcn_sched_barrier(0);
            PEER_VACC(va, 0);
            if (nxt < 512) PEER_ISSUE(va, V8g + (size_t)(nxt >> 6) * (16384 * 128), jov, nxt & 63, 0, g8v);
            __builtin_amdgcn_sched_barrier(0);
            PEER_VACC(vb, 1);
            float ac[32];
#pragma unroll
            for (int c = 0; c < 16; ++c) { ac[2 * c] = ac2[c][0]; ac[2 * c + 1] = ac2[c][1]; }
            float q16[16], q8[8], q4[4];
#pragma unroll
            for (int i = 0; i < 16; ++i) q16[i] = swap32_add(ac[i], ac[16 + i]);
#pragma unroll
            for (int i = 0; i < 8; ++i) q8[i] = swap16_add(q16[i], q16[8 + i]);
#pragma unroll
            for (int i = 0; i < 4; ++i) q4[i] = (c3 ? q8[4 + i] : q8[i]) + dpp_xor8(c3 ? q8[i] : q8[4 + i]);
            u32x2 ow; ow.x = pk_bf16(q4[0], q4[1]); ow.y = pk_bf16(q4[2], q4[3]);
            *(GAS u32x2*)(OUTT + tok * DM + cb * 256 + 32 * j8v + 4 * g8v) = ow;
            cur = nxt;
        }
    }
#undef PEER_VACC
#undef PEER_CVT4
#undef PEER_ISSUE
#undef PEER_GRAB
#ifdef PEER_STAMP
    if (layer == 0 && TSEL_A >= 0 && blockIdx.x == PSB && threadIdx.x == PST) ((unsigned long long*)(p.ws + (512 * 1024) + 1024))[23] = __builtin_amdgcn_s_memrealtime();
#endif
    asm volatile("s_waitcnt vmcnt(0)" ::: "memory");
    __syncthreads();
    unsigned char* wse = ws; asm volatile("" : "+s"(wse));
    const GAS float* mod = (const GAS float*)(wse + WS_MOD) + (size_t)layer * 4 * 12288;
    const GAS bf16_t* OUTE = (const GAS bf16_t*)(wse + WS_PROJ);
    int lane_e = lane; asm volatile("" : "+v"(lane_e));
    const int bt = (int)(tok0 / SEQ);
    float gv2[32], av[32], sv2[32];
    {
        const GAS float* g2 = mod + (size_t)bt * 12288 + 10240 + 16 * lane_e;
        const GAS float* modn = (const GAS float*)(wse + WS_MOD) + (size_t)(LAST ? layer : layer + 1) * 4 * 12288 + (size_t)bt * 12288 + 16 * lane_e;
        const GAS float* ng = (const GAS float*)(LAST ? p.in[6] : p.in[5] + (size_t)(layer + 1) * 2 * DM) + 16 * lane_e;
#pragma unroll
        for (int j = 0; j < 2; ++j)
#pragma unroll
            for (int d = 0; d < 4; ++d) { const f32x4 a = *(const GAS f32x4*)(g2 + 1024 * j + 4 * d), g = *(const GAS f32x4*)(ng + 1024 * j + 4 * d);
                f32x4 sc = (f32x4){0.f, 0.f, 0.f, 0.f}, sh = (f32x4){0.f, 0.f, 0.f, 0.f};
                if (!LAST) { sc = *(const GAS f32x4*)(modn + 2048 + 1024 * j + 4 * d); sh = *(const GAS f32x4*)(modn + 1024 * j + 4 * d); }
#pragma unroll
                for (int e = 0; e < 4; ++e) { gv2[16 * j + 4 * d + e] = a[e]; av[16 * j + 4 * d + e] = g[e] * (1.f + sc[e]); sv2[16 * j + 4 * d + e] = sh[e]; } }
    }
#pragma unroll 1
    for (int tt = 0; tt < 8; ++tt) {
        const int tl = 8 * wave + tt; const size_t tok = tok0 + tl;
        GAS float* hrow = (GAS float*)(p.out + tok * DM + 16 * lane_e);
        GAS bf16_t* hb = (GAS bf16_t*)(wse + WS_H) + tok * DM + 16 * lane_e;
        const GAS bf16_t* orow = OUTE + tok * DM + 16 * lane_e;
        float hv[32]; float ss = 0.f;
#pragma unroll
        for (int j = 0; j < 2; ++j) {
            float of[16]; unpack8(*(const GAS u32x4*)(orow + 1024 * j), of); unpack8(*(const GAS u32x4*)(orow + 1024 * j + 8), of + 8);
            float hf[16]; unpack8(*(const GAS u32x4*)(hb + 1024 * j), hf); unpack8(*(const GAS u32x4*)(hb + 1024 * j + 8), hf + 8);
#pragma unroll
            for (int e = 0; e < 16; ++e) { const float hh = hf[e] + gv2[16 * j + e] * of[e]; hv[16 * j + e] = hh; ss += hh * hh; }
        }
        const float r = rsqrtf(wave_sum(ss) * (1.f / DM) + EPS);
        if (LAST) {
#pragma unroll
            for (int j = 0; j < 2; ++j)
#pragma unroll
                for (int d = 0; d < 4; ++d) { f32x4 o;
#pragma unroll
                    for (int e = 0; e < 4; ++e) o[e] = hv[16 * j + 4 * d + e] * r * av[16 * j + 4 * d + e];
                    *(GAS f32x4*)(hrow + 1024 * j + 4 * d) = o; }
        } else {
#pragma unroll
            for (int j = 0; j < 2; ++j) { *(GAS u32x4*)(hb + 1024 * j) = pack8(hv + 16 * j); *(GAS u32x4*)(hb + 1024 * j + 8) = pack8(hv + 16 * j + 8); }
            float mx = 0.f;
#pragma unroll
            for (int e = 0; e < 32; ++e) { hv[e] = hv[e] * r * av[e] + sv2[e]; mx = fmaxf(mx, fabsf(hv[e])); }
            mx = fmaxf(wave_max(mx), 1e-20f);
            const float inv = 127.f / mx;
            GAS unsigned char* h8 = (GAS unsigned char*)(wse + WS_HN8) + tok * DM + 16 * lane_e;
#pragma unroll
            for (int j = 0; j < 2; ++j) { u32x4 o;
                o.x = pack4_i8(hv[16 * j], hv[16 * j + 1], hv[16 * j + 2], hv[16 * j + 3], inv); o.y = pack4_i8(hv[16 * j + 4], hv[16 * j + 5], hv[16 * j + 6], hv[16 * j + 7], inv);
                o.z = pack4_i8(hv[16 * j + 8], hv[16 * j + 9], hv[16 * j + 10], hv[16 * j + 11], inv); o.w = pack4_i8(hv[16 * j + 12], hv[16 * j + 13], hv[16 * j + 14], hv[16 * j + 15], inv);
                *(GAS u32x4*)(h8 + 1024 * j) = o; }
            if (lane_e == 0) ((GAS float*)(wse + WS_XS))[tok] = mx * (1.f / 127.f);
        }
    }
#ifdef PEER_STAMP
    if (layer == 0 && TSEL_A >= 0 && blockIdx.x == PSB && threadIdx.x == PST) ((unsigned long long*)(p.ws + (512 * 1024) + 1024))[24] = __builtin_amdgcn_s_memrealtime();
    if (layer == 0 && TSEL_A >= 0 && threadIdx.x == PST) __hip_atomic_fetch_max((unsigned long long*)(p.ws + (512 * 1024) + 1024) + 25, (unsigned long long)__builtin_amdgcn_s_memrealtime(), __ATOMIC_RELAXED, __HIP_MEMORY_SCOPE_AGENT);
#endif
    __syncthreads();
}
template <class Epi>
__device__ __forceinline__ void run_gemm(LAS unsigned char* lds, const bf16_t* A, const bf16_t* Bt, int N, const Epi& E, int tid, int bid, int G) {
    pg8::Gemm gm{A, Bt, NT, N, DM, nullptr, nullptr}; pg8::StaticOrder S; S.init(NT, N, G, bid);
    pg8::gemm_phase<Epi, pg8::StaticOrder, true, true>(lds, gm, S, E, tid);
}
template <class Epi>
__device__ __forceinline__ void run_gemm_i8(LAS unsigned char* lds, const unsigned char* A8, const unsigned char* Bt8, int N, const float* sa, const float* sw, const Epi& E, int tid, int bid, int G) {
    pg8::Gemm gm{(const bf16_t*)A8, (const bf16_t*)Bt8, NT, N, DM / 2, sa, sw}; pg8::StaticOrder S; S.init(NT, N, G, bid);
    pg8::gemm_phase<Epi, pg8::StaticOrder, true, true, true>(lds, gm, S, E, tid);
}


typedef __attribute__((address_space(4))) const unsigned char* karg_t;
__device__ __forceinline__ Params load_params() {
    int z; asm volatile("s_mov_b32 %0, 0" : "=s"(z));
    karg_t ka = (karg_t)__builtin_amdgcn_kernarg_segment_ptr() + z;
    Params q;
#pragma unroll
    for (int k = 0; k < 25; ++k) q.in[k] = *(const float* const __attribute__((address_space(4)))*)(ka + 8 * k);
    q.out = *(float* const __attribute__((address_space(4)))*)(ka + 200);
    q.ws = *(unsigned char* const __attribute__((address_space(4)))*)(ka + 208);
    q.pad = 0;
    return q;
}

constexpr size_t WS_BAR = WS_MISC + 65536;
constexpr int BAR_LDS_OFF = LDS_BYTES - 64;
#define GRID_BAR() do { const Params pb = load_params(); XcdBarrier xb; xb.bar = (unsigned*)(pb.ws + WS_BAR); xb.x = xb_xcc_id(); xb.st = (volatile LAS unsigned*)(lds + BAR_LDS_OFF); xcd_barrier(xb); } while (0)
#define STAMP(k) do { if (TSEL_A >= 0 && blockIdx.x == 0 && wave_s == 0 && __builtin_amdgcn_mbcnt_lo(~0u, 0u) == 0 && __builtin_amdgcn_mbcnt_hi(~0u, 0u) == 0) { const Params pt = load_params(); ((unsigned long long*)(pt.ws + WS_MISC + 1024))[(k)] = __builtin_amdgcn_s_memrealtime(); } } while (0)
#ifndef DUMP_STAGE
#define DUMP_STAGE 0
#endif
__device__ __forceinline__ void dump_bf16(float* out, const bf16_t* src, size_t ld) {
    for (size_t i = (size_t)blockIdx.x * NTHREADS + threadIdx.x; i < (size_t)NT * DM; i += (size_t)gridDim.x * NTHREADS) {
        const size_t t = i / DM, c = i % DM; float v = bf2f(src[t * ld + c]); if (!(v == v) || fabsf(v) > 1e30f) v = 1.0e4f; out[i] = v; }
}
__device__ __forceinline__ void dump_f32(float* out, const float* src, size_t n) {
    for (size_t i = (size_t)blockIdx.x * NTHREADS + threadIdx.x; i < (size_t)NT * DM; i += (size_t)gridDim.x * NTHREADS) out[i] = src[i % n];
}
#define DUMPF_AT(n, srcexpr, cnt) if (DUMP_STAGE == (n)) { const Params pd = load_params(); unsigned char* ws = pd.ws; dump_f32(pd.out, (const float*)(srcexpr), (cnt)); return; }
#define DUMP_AT(n, srcexpr, ld) if (DUMP_STAGE == (n)) { const Params pd = load_params(); unsigned char* ws = pd.ws; dump_bf16(pd.out, (const bf16_t*)(srcexpr), (ld)); return; }

__global__ void __launch_bounds__(NTHREADS, 2) fwd_megakernel(Params p_unused) {
    extern __shared__ __attribute__((aligned(16))) unsigned char lds_raw[];
    LAS unsigned char* lds = (LAS unsigned char*)lds_raw;
    cg::grid_group grid = cg::this_grid();
    const int wave_s = __builtin_amdgcn_readfirstlane(threadIdx.x >> 6);
    STAMP(0);
    {
        if (threadIdx.x < 16) ((volatile LAS unsigned*)(lds + BAR_LDS_OFF))[threadIdx.x] = 0u;
        if (blockIdx.x == 0) { const Params pz = load_params(); unsigned* bw = (unsigned*)(pz.ws + WS_BAR);
            for (int i = threadIdx.x; i < XCD_BAR_WORDS + 128; i += NTHREADS) __hip_atomic_store(bw + i, 0u, __ATOMIC_RELAXED, __HIP_MEMORY_SCOPE_AGENT);
            if (TSEL_A >= 0 && threadIdx.x == 0) ((unsigned long long*)(pz.ws + WS_MISC + 1024))[25] = 0ull; }
        __syncthreads();
    }
#define PHASE_BEGIN const Params p = load_params(); unsigned char* ws = p.ws; (void)ws; \
    int bid = blockIdx.x, G = gridDim.x; unsigned zq = 0; asm volatile("" : "+s"(bid), "+s"(G), "+s"(zq)); \
    int tid = (wave_s << 6) | (int)__builtin_amdgcn_mbcnt_hi(~0u, __builtin_amdgcn_mbcnt_lo(~0u, zq)); asm volatile("" : "+v"(tid)); const int lane = tid & 63, wave = wave_s; (void)lane; (void)wave; \


    { PHASE_BEGIN phase0a(p, lds, tid, lane, wave, bid, G); }
    grid.sync(); { const Params pb = load_params(); (void)xcd_barrier_post((unsigned*)(pb.ws + WS_BAR), (volatile LAS unsigned*)(lds + BAR_LDS_OFF)); } STAMP(1);
    { PHASE_BEGIN quant_weights(ws, lane, bid * 8 + wave, G * 8); phase_rows<true>(p, lds, p.in[0], p.in[5], (const float*)(ws + WS_MOD), 2048, 0, tid, lane, wave, bid, G); }
    GRID_BAR(); STAMP(2);
    DUMP_AT(1, ws + WS_HN, DM)
    DUMPF_AT(10, ws + WS_LF, 131072)
    DUMPF_AT(12, ws + WS_MOD, 98304)
    DUMP_AT(2, ws + WS_WIN0, DM)
    { PHASE_BEGIN EpiProj<0> E{(bf16_t*)(ws + WS_PROJ), EVEN_IN, (bf16_t*)(ws + WS_VTM), (bf16_t*)(ws + WS_VTD)}; run_gemm_i8(lds, ws + WS_HN8, ws + WS_W8, EVEN_IN, (const float*)(ws + WS_XS), (const float*)(ws + WS_WSC), E, tid, bid, G); }
    GRID_BAR(); STAMP(3);
    DUMP_AT(3, ws + WS_PROJ, EVEN_IN)
    DUMP_AT(4, ws + WS_PROJ + 2 * 3072, EVEN_IN)
    { PHASE_BEGIN
      for (int it = bid; it < 1024; it += G) {
        if (it < 512) mlstm_cloc_unit(p, lds, it, tid, lane, wave); else diff_post_item(p, lds, it - 512, tid);
      } }
    GRID_BAR(); STAMP(4);
    DUMP_AT(5, ws + WS_PROJ + 2 * 3072, EVEN_IN)
    DUMP_AT(6, ws + WS_CLOC, DM)
    DUMPF_AT(11, ws + WS_CHS, 1024)
    DUMPF_AT(13, ws + WS_NLOC, 65536)
    DUMP_AT(7, ws + WS_VTD, DM)
    DUMP_AT(8, ws + WS_QM, DM)
    {
        PHASE_BEGIN
        {
            for (int idx = bid * NTHREADS + tid; idx < 65536; idx += G * NTHREADS) mlstm_scan(p, idx);
            asm volatile("s_waitcnt vmcnt(0)" ::: "memory");
            __syncthreads();
            if (tid == 0) { __builtin_amdgcn_fence(__ATOMIC_RELEASE, "agent"); asm volatile("s_waitcnt vmcnt(0)" ::: "memory");
                __hip_atomic_fetch_add((unsigned*)(ws + WS_BAR) + XCD_BAR_WORDS + 64, 1u, __ATOMIC_RELAXED, __HIP_MEMORY_SCOPE_AGENT); }
        }
    }
#pragma unroll 1
    for (int st = 0; st < 3; ++st) {
        { PHASE_BEGIN if (((bid >> 3) & 3) == st) convert_tables(p, lane, bid * 8 + wave, G * 8); }
        if (st < 2) {
            PHASE_BEGIN
            const float lam = ((const float*)(ws + WS_MISC))[0];
            for (int pr = bid + st * G; pr < 512; pr += (st == 0 ? 512 : G)) {
                const int bh = pr >> 4, jj = pr & 15, b = bh >> 3, h = bh & 7;
                const bf16_t* PROJ = (const bf16_t*)(ws + WS_PROJ);
                const bf16_t* Qb = PROJ + (size_t)b * SEQ * EVEN_IN + 3072 + h * 128;
                const bf16_t* Kb = PROJ + (size_t)b * SEQ * EVEN_IN + 4096 + h * 128;
                const bf16_t* Vt = (const bf16_t*)(ws + WS_VTD) + ((size_t)bh * 128) * SEQ;
                bf16_t* outp = (bf16_t*)(ws + WS_CAT) + (size_t)b * SEQ * DM + 1024 + h * 128;
#pragma unroll 1
                for (int rep = 0; rep < 2; ++rep)
                    attn_unit<0>(lds, Qb, Kb, EVEN_IN, Vt, rep ? jj : 31 - jj, nullptr, outp, p.in[14] + h * 128, lam, tid, lane, wave);
            }
        }
    }
    STAMP(21);
    {
        PHASE_BEGIN
        if (tid == 0) {
            unsigned* cnt = (unsigned*)(ws + WS_BAR) + XCD_BAR_WORDS + 64; unsigned sp = 0;
            while (__hip_atomic_load(cnt, __ATOMIC_RELAXED, __HIP_MEMORY_SCOPE_AGENT) < (unsigned)G && ++sp < (1u << 22)) __builtin_amdgcn_s_sleep(2);
            __builtin_amdgcn_fence(__ATOMIC_ACQUIRE, "agent"); asm volatile("s_waitcnt vmcnt(0)" ::: "memory");
        }
        __syncthreads();
        for (int pr = bid; pr < 256; pr += G) {
            const int bh = pr >> 4, cc = pr & 15;
#pragma unroll 1
            for (int rep = 0; rep < 2; ++rep) mlstm_out_unit(p, lds, bh * 32 + (rep ? cc : 31 - cc), tid, lane, wave);
        }
    }
    { PHASE_BEGIN if (((bid >> 3) & 3) == 3) convert_tables(p, lane, bid * 8 + wave, G * 8); }
    GRID_BAR(); STAMP(5);
    DUMP_AT(9, ws + WS_CAT, DM)
    { PHASE_BEGIN EpiResid<true> E{p.in[0], (bf16_t*)(ws + WS_H), (const float*)(ws + WS_MOD) + 4096}; run_gemm(lds, (const bf16_t*)(ws + WS_CAT), (const bf16_t*)(ws + WS_WOUT0), DM, E, tid, bid, G); }
    GRID_BAR(); STAMP(6);
#if STOP_AFTER >= 2
    { PHASE_BEGIN phase_rows<false>(p, lds, ws + WS_H, p.in[5] + DM, (const float*)(ws + WS_MOD), 8192, 6144, tid, lane, wave, bid, G); }
    GRID_BAR(); STAMP(7);
    { PHASE_BEGIN EpiStoreBf16 E{(bf16_t*)(ws + WS_QP), DM}; run_gemm_i8(lds, ws + WS_HN8, ws + WS_W8 + (size_t)(6144 + 5120) * 2048, DM, (const float*)(ws + WS_XS), (const float*)(ws + WS_WSC) + 6144 + 5120, E, tid, bid, G); }
    GRID_BAR(); STAMP(8);
    { PHASE_BEGIN for (int tile = bid; tile < 256; tile += G) peer_tile<false>(p, lds, 0, tile, tid, lane, wave); }
    GRID_BAR(); STAMP(9);
#endif
#if STOP_AFTER >= 3
    { PHASE_BEGIN EpiProj<1> E{(bf16_t*)(ws + WS_PROJ), ODD_IN, (bf16_t*)(ws + WS_VTM), (bf16_t*)(ws + WS_VTD)}; run_gemm_i8(lds, ws + WS_HN8, ws + WS_W8 + (size_t)6144 * 2048, ODD_IN, (const float*)(ws + WS_XS), (const float*)(ws + WS_WSC) + 6144, E, tid, bid, G); }
    GRID_BAR(); STAMP(10);
    { PHASE_BEGIN
      for (int it = bid; it < 1536; it += G) {
        if (it < 512) moba_post_item(p, lds, it, tid); else sgu_unit(p, lds, it - 512, tid, lane, wave);
      } }
    GRID_BAR(); STAMP(11);
    { PHASE_BEGIN
      for (int pr = bid; pr < 512; pr += G) {
        const int bh = pr >> 4, jj = pr & 15, b = bh >> 3, h = bh & 7;
        const bf16_t* PROJ = (const bf16_t*)(ws + WS_PROJ);
        const bf16_t* Qb = PROJ + (size_t)b * SEQ * ODD_IN + h * 128;
        const bf16_t* Kb = PROJ + (size_t)b * SEQ * ODD_IN + 1024 + h * 128;
        const bf16_t* Vt = (const bf16_t*)(ws + WS_VTD) + ((size_t)bh * 128) * SEQ;
        const float* km = (const float*)(ws + WS_KMEAN) + (size_t)bh * 16 * 128;
        bf16_t* outp = (bf16_t*)(ws + WS_CAT) + (size_t)b * SEQ * DM + h * 128;
#pragma unroll 1
        for (int rep = 0; rep < 2; ++rep)
            attn_unit<1>(lds, Qb, Kb, ODD_IN, Vt, rep ? jj : 31 - jj, km, outp, nullptr, 0.f, tid, lane, wave);
      } }
    GRID_BAR(); STAMP(12);
    { PHASE_BEGIN EpiResid<false> E{(const bf16_t*)(ws + WS_H), (bf16_t*)(ws + WS_H), (const float*)(ws + WS_MOD) + 4 * 12288 + 4096}; run_gemm(lds, (const bf16_t*)(ws + WS_CAT), (const bf16_t*)(ws + WS_WOUT1), DM, E, tid, bid, G); }
    GRID_BAR(); STAMP(13);
#endif
#if STOP_AFTER >= 4
    { PHASE_BEGIN phase_rows<false>(p, lds, ws + WS_H, p.in[5] + 3 * DM, (const float*)(ws + WS_MOD) + 4 * 12288, 8192, 6144, tid, lane, wave, bid, G); }
    GRID_BAR(); STAMP(14);
    { PHASE_BEGIN EpiStoreBf16 E{(bf16_t*)(ws + WS_QP), DM}; run_gemm_i8(lds, ws + WS_HN8, ws + WS_W8 + (size_t)(6144 + 5120 + 2048) * 2048, DM, (const float*)(ws + WS_XS), (const float*)(ws + WS_WSC) + 6144 + 5120 + 2048, E, tid, bid, G); }
    GRID_BAR(); STAMP(15);
    { PHASE_BEGIN for (int tile = bid; tile < 256; tile += G) peer_tile<true>(p, lds, 1, tile, tid, lane, wave); }
    STAMP(31);
    if (TSEL_A >= 0 && blockIdx.x == 0 && wave_s == 0 && __builtin_amdgcn_mbcnt_lo(~0u, 0u) == 0 && __builtin_amdgcn_mbcnt_hi(~0u, 0u) == 0) { const Params pt = load_params(); const unsigned long long* ts = (const unsigned long long*)(pt.ws + WS_MISC + 1024);
        pt.out[0] += (float)(ts[TSEL_B] - ts[TSEL_A]) * (0.01f / TSCALE); }
#else
    {
        PHASE_BEGIN
        const int gw = bid * 8 + wave, NGW = G * 8;
        for (int m = gw; m < NT; m += NGW) {
            float* hr = p.out + (size_t)m * DM;
            f32x4 v[8]; float s = 0.f;
#pragma unroll
            for (int j = 0; j < 8; ++j) { v[j] = ((const f32x4*)hr)[lane + 64 * j]; s += (v[j][0] * v[j][0] + v[j][1] * v[j][1]) + (v[j][2] * v[j][2] + v[j][3] * v[j][3]); }
            const float r = rsqrtf(wave_sum(s) * (1.f / DM) + EPS);
#pragma unroll
            for (int j = 0; j < 8; ++j) ((f32x4*)hr)[lane + 64 * j] = v[j] * r * ((const f32x4*)p.in[6])[lane + 64 * j];
        }
    }
#endif
}

extern "C" void kernel_launch(void* const* d_in, const int* in_sizes, int n_in, void* d_out, int out_size, void* d_ws, size_t ws_size,
                              hipStream_t stream) {
    static int grid_blocks = 0;
    if (!grid_blocks) {
        int dev = 0, cus = 0, per_cu = 0;
        (void)hipGetDevice(&dev);
        (void)hipDeviceGetAttribute(&cus, hipDeviceAttributeMultiprocessorCount, dev);
        (void)hipFuncSetAttribute((const void*)fwd_megakernel, hipFuncAttributeMaxDynamicSharedMemorySize, LDS_BYTES);
        (void)hipOccupancyMaxActiveBlocksPerMultiprocessor(&per_cu, (const void*)fwd_megakernel, NTHREADS, LDS_BYTES);
        if (per_cu < 1) { fprintf(stderr, "kernel_launch: occupancy query says %d blocks per CU\n", per_cu); per_cu = 1; }
        grid_blocks = cus;
        if (n_in != 25 || ws_size < WS_END) fprintf(stderr, "kernel_launch: unexpected n_in %d or ws_size %zu (< %zu)\n", n_in, ws_size, (size_t)WS_END);
    }
    Params p{};
    for (int i = 0; i < 25 && i < n_in; ++i) p.in[i] = (const float*)d_in[i];
    p.out = (float*)d_out; p.ws = (unsigned char*)d_ws;
    void* args[] = {&p};
    hipError_t e = hipLaunchCooperativeKernel((const void*)fwd_megakernel, dim3(grid_blocks), dim3(NTHREADS), args, LDS_BYTES, stream);
    if (e != hipSuccess) fprintf(stderr, "cooperative launch failed: %s (grid %d)\n", hipGetErrorString(e), grid_blocks);
}
```

```cpp
#include <hip/hip_runtime.h>
#include <hip/hip_cooperative_groups.h>
#include <cstdio>
#include <cstdint>
namespace cg = cooperative_groups;
#ifndef STOP_AFTER
#define STOP_AFTER 99
#define DUMP_STAGE 0
#endif
#define PSB 0
#define PST 0
#define ATT_ABL 0
#define TSCALE 4.f
#ifndef TSEL_A
#define TSEL_A -1
#define TSEL_B -1
#endif
#define PEER_STAMP do { if (TSEL_A >= 0 && blockIdx.x == PSB && threadIdx.x == PST) ((unsigned long long*)(p.ws + (512 * 1024) + 1024))[20] = __builtin_amdgcn_s_memrealtime(); } while (0)
namespace pg8 {
#define PG8_LAS __attribute__((address_space(3)))
typedef unsigned short bf16_t;
typedef short bf16x8 __attribute__((ext_vector_type(8)));
typedef float f32x4 __attribute__((ext_vector_type(4)));
typedef unsigned u32x4 __attribute__((ext_vector_type(4)));
typedef int i32x4 __attribute__((ext_vector_type(4)));
constexpr int BM = 256, BK = 64, HALF = 128, HTB = HALF * BK * 2  , STAGE_BYTES = 8 * HTB, NXCD = 8, WGM = 8;

__host__ __device__ __forceinline__ int lds_byte(int r, int c) { const int st = (r >> 4) * 2 + (c >> 5), rr = r & 15, cc = c & 31, ob = rr * 64 + cc * 2; return st * 1024 + (ob ^ (((ob >> 9) & 1) << 5)); }
__host__ __device__ __forceinline__ void stage_rc(int b, int& R, int& C) { const int st = b / 1024, sb = b % 1024, swz = sb ^ (((sb >> 9) & 1) << 5); R = (st >> 1) * 16 + swz / 64; C = (st & 1) * 32 + (swz % 64) / 2; }
__host__ __device__ __forceinline__ int perm32(int rho) { const int n = rho >> 4, i = rho & 15; return 8 * (i >> 2) + 4 * n + (i & 3); }

struct Unit { int pm, pn; };
struct Gemm { const bf16_t* A; const bf16_t* Bt; int M, N, K; const float* sa; const float* sw; };

struct StaticOrder {
    int nM, nN, nwg, G, c;
    __host__ __device__ void init(int M, int N, int G_, int c_) { nM = M / BM; nN = N / BM; nwg = nM * nN; G = G_; c = c_; }
    __host__ __device__ bool next(int i, Unit& u) const {
        const long L = (long)i * G + c; if (L >= nwg) return false;
        int wgid = (int)L; { const int q = nwg / NXCD, r = nwg % NXCD, xcd = wgid % NXCD, off = wgid / NXCD; wgid = (xcd < r ? xcd * (q + 1) : r * (q + 1) + (xcd - r) * q) + off; }
        const int nig = WGM * nN, gid = wgid / nig, fm = gid * WGM, gsz = (nM - fm) < WGM ? (nM - fm) : WGM;
        u.pm = fm + ((wgid % nig) % gsz); u.pn = (wgid % nig) / gsz; return true;
    }
    __device__ __forceinline__ void a_ready(const Unit&) const {}
    __device__ __forceinline__ void done(const Unit&) const {}
};
template <class Epi, class Sched, bool ALIGN_EPI = false, bool SP2 = false, bool I8 = false>
__device__ __forceinline__ void gemm_phase(PG8_LAS unsigned char* lds, const Gemm g, const Sched& S, const Epi& E, const int tid) {
    const int wid = __builtin_amdgcn_readfirstlane(tid >> 6), lane = tid & 63, wr = wid >> 2, wc = wid & 3, fr = lane & 15, fq = lane >> 4;
    const int K = g.K, nt = K / BK;
    unsigned voffA[2], voffB[2];
#pragma unroll
    for (int i = 0; i < 2; ++i) { int R, C; stage_rc(tid * 16 + i * 8192, R, C); const int Rb = Epi::PERM ? ((R & ~31) + perm32(R & 31)) : R;
        voffA[i] = (unsigned)(R * K + C) * 2u; voffB[i] = (unsigned)(Rb * K + C) * 2u; }
    const size_t kstep = (size_t)(BK * 2);
    const size_t hstep = (size_t)HALF * K * 2;
    const size_t tstep = 2 * hstep;
    const unsigned ldsw = (unsigned)wid * 1024u;
    const int aoff = lds_byte(wr * 64 + fr, fq * 8), boff = lds_byte(wc * 32 + fr, fq * 8);
#define PG8_SA(b, h) (((b) * 2 + (h)) * HTB)
#define PG8_SB(b, h) ((4 + (b) * 2 + (h)) * HTB)
#define PG8_STAGE(bufoff, gbase, voff) do { _Pragma("unroll") for (int _i = 0; _i < 2; ++_i) \
        __builtin_amdgcn_global_load_lds((const unsigned*)((const char*)(gbase) + (voff)[_i]), (PG8_LAS unsigned*)(lds + (bufoff) + ldsw + _i * 8192), 16, 0, 0); } while (0)
#define PG8_LDA(dst, b, h) do { _Pragma("unroll") for (int m = 0; m < 4; ++m) _Pragma("unroll") for (int k = 0; k < 2; ++k) dst[m][k] = *(const PG8_LAS bf16x8*)(lds + PG8_SA(b, h) + aoff + m * 2048 + k * 1024); } while (0)
#define PG8_LDB(dst, b, h) do { _Pragma("unroll") for (int n = 0; n < 2; ++n) _Pragma("unroll") for (int k = 0; k < 2; ++k) dst[n][k] = *(const PG8_LAS bf16x8*)(lds + PG8_SB(b, h) + boff + n * 2048 + k * 1024); } while (0)
#define PG8_MMA(ai, bj, At, Bt) do { __builtin_amdgcn_s_setprio(1); _Pragma("unroll") for (int m = 0; m < 4; ++m) _Pragma("unroll") for (int n = 0; n < 2; ++n) _Pragma("unroll") for (int k = 0; k < 2; ++k) \
        { if constexpr (I8) acc[ai][bj][m][n] = __builtin_bit_cast(f32x4, __builtin_amdgcn_mfma_i32_16x16x64_i8(__builtin_bit_cast(i32x4, Bt[n][k]), __builtin_bit_cast(i32x4, At[m][k]), __builtin_bit_cast(i32x4, acc[ai][bj][m][n]), 0, 0, 0)); \
          else acc[ai][bj][m][n] = __builtin_amdgcn_mfma_f32_16x16x32_bf16(Bt[n][k], At[m][k], acc[ai][bj][m][n], 0, 0, 0); } __builtin_amdgcn_s_setprio(0); } while (0)
#define PG8_WAIT_V(n) asm volatile("s_waitcnt vmcnt(" #n ")" ::: "memory")
#define PG8_WAIT_L(n) asm volatile("s_waitcnt lgkmcnt(" #n ")" ::: "memory")
#define PG8_BAR __builtin_amdgcn_s_barrier()
#define PG8_SCHED __builtin_amdgcn_sched_barrier(0)
    Unit cur, nxt; int ui = 0;
    if (!S.next(0, cur)) return;
    f32x4 acc[2][2][4][2];
#pragma unroll
    for (int a = 0; a < 2; ++a)
#pragma unroll
        for (int b = 0; b < 2; ++b)
#pragma unroll
            for (int m = 0; m < 4; ++m)
#pragma unroll
                for (int n = 0; n < 2; ++n) acc[a][b][m][n] = (f32x4){0.f, 0.f, 0.f, 0.f};
    bf16x8 At[4][2], B0[2][2], B1[2][2];
    const char* cA = (const char*)g.A + (size_t)cur.pm * tstep; const char* cB = (const char*)g.Bt + (size_t)cur.pn * tstep;
    S.a_ready(cur);
    if constexpr (SP2) {
        PG8_STAGE(PG8_SB(0, 0), cB, voffB); PG8_STAGE(PG8_SB(0, 1), cB + hstep, voffB); PG8_STAGE(PG8_SA(0, 0), cA, voffA); PG8_STAGE(PG8_SA(0, 1), cA + hstep, voffA);
        if (wr == 1) PG8_BAR;
        PG8_WAIT_V(2); PG8_BAR;
        PG8_STAGE(PG8_SB(1, 0), cB + kstep, voffB); PG8_STAGE(PG8_SA(1, 0), cA + kstep, voffA); PG8_STAGE(PG8_SB(1, 1), cB + hstep + kstep, voffB);
        PG8_WAIT_V(6); PG8_BAR;
    } else {
        PG8_STAGE(PG8_SB(0, 0), cB, voffB); PG8_STAGE(PG8_SA(0, 0), cA, voffA); PG8_STAGE(PG8_SB(0, 1), cB + hstep, voffB); PG8_STAGE(PG8_SA(0, 1), cA + hstep, voffA);
        if (wr == 1) PG8_BAR;
        PG8_WAIT_V(4); PG8_BAR;
        PG8_STAGE(PG8_SB(1, 0), cB + kstep, voffB); PG8_STAGE(PG8_SA(1, 0), cA + kstep, voffA); PG8_STAGE(PG8_SB(1, 1), cB + hstep + kstep, voffB);
        PG8_WAIT_V(6); PG8_BAR;
    }
    for (;;) {
        const bool has_next = S.next(ui + 1, nxt);
        const char* nA = has_next ? (const char*)g.A + (size_t)nxt.pm * tstep : cA; const char* nB = has_next ? (const char*)g.Bt + (size_t)nxt.pn * tstep : cB;
        for (int t = 0; t < nt; t += 2) {
            const bool last = (t == nt - 2);
            const char* a1 = cA + (size_t)(t + 1) * kstep;
            const char* a2 = last ? nA : cA + (size_t)(t + 2) * kstep; const char* b2 = last ? nB : cB + (size_t)(t + 2) * kstep;
            const char* a3 = a2 + kstep; const char* b3 = b2 + kstep;
            if (last && has_next) S.a_ready(nxt);
            if constexpr (SP2) {
            PG8_LDB(B0, 0, 0); PG8_LDB(B1, 0, 1); PG8_SCHED; PG8_LDA(At, 0, 0); PG8_STAGE(PG8_SA(1, 1), a1 + hstep, voffA);
            PG8_WAIT_V(8); PG8_WAIT_L(0); PG8_BAR; PG8_MMA(0, 0, At, B0); PG8_MMA(0, 1, At, B1); PG8_BAR; PG8_SCHED;
            PG8_LDA(At, 0, 1); PG8_STAGE(PG8_SB(0, 0), b2, voffB); PG8_STAGE(PG8_SB(0, 1), b2 + hstep, voffB); PG8_STAGE(PG8_SA(0, 0), a2, voffA);
            PG8_WAIT_V(8); PG8_WAIT_L(0); PG8_BAR; PG8_MMA(1, 0, At, B0); PG8_MMA(1, 1, At, B1); PG8_BAR; PG8_SCHED;
            PG8_LDB(B0, 1, 0); PG8_LDB(B1, 1, 1); PG8_SCHED; PG8_LDA(At, 1, 0); PG8_STAGE(PG8_SA(0, 1), a2 + hstep, voffA);
            PG8_WAIT_V(8); PG8_WAIT_L(0); PG8_BAR; PG8_MMA(0, 0, At, B0); PG8_MMA(0, 1, At, B1); PG8_BAR; PG8_SCHED;
            PG8_LDA(At, 1, 1); PG8_STAGE(PG8_SB(1, 0), b3, voffB); PG8_STAGE(PG8_SB(1, 1), b3 + hstep, voffB); PG8_STAGE(PG8_SA(1, 0), a3, voffA);
            PG8_WAIT_V(8); PG8_WAIT_L(0); PG8_BAR; PG8_MMA(1, 0, At, B0); PG8_MMA(1, 1, At, B1); PG8_BAR; PG8_SCHED;
            } else {
            PG8_LDB(B0, 0, 0); PG8_SCHED; PG8_LDA(At, 0, 0); PG8_STAGE(PG8_SA(1, 1), a1 + hstep, voffA);
            PG8_WAIT_L(8); PG8_BAR; PG8_WAIT_L(0); PG8_MMA(0, 0, At, B0); PG8_BAR; PG8_SCHED;
            PG8_LDB(B1, 0, 1); PG8_STAGE(PG8_SB(0, 0), b2, voffB);
            PG8_BAR; PG8_WAIT_L(0); PG8_MMA(0, 1, At, B1); PG8_BAR;
            PG8_LDA(At, 0, 1); PG8_STAGE(PG8_SA(0, 0), a2, voffA);
            PG8_BAR; PG8_WAIT_L(0); PG8_MMA(1, 0, At, B0); PG8_BAR; PG8_SCHED;
            PG8_STAGE(PG8_SB(0, 1), b2 + hstep, voffB);
            PG8_WAIT_V(6); PG8_BAR; PG8_MMA(1, 1, At, B1); PG8_BAR;
            PG8_LDB(B0, 1, 0); PG8_SCHED; PG8_LDA(At, 1, 0); PG8_STAGE(PG8_SA(0, 1), a2 + hstep, voffA);
            PG8_WAIT_L(8); PG8_BAR; PG8_WAIT_L(0); PG8_MMA(0, 0, At, B0); PG8_BAR; PG8_SCHED;
            PG8_LDB(B1, 1, 1); PG8_STAGE(PG8_SB(1, 0), b3, voffB);
            PG8_BAR; PG8_WAIT_L(0); PG8_MMA(0, 1, At, B1); PG8_BAR;
            PG8_LDA(At, 1, 1); PG8_STAGE(PG8_SA(1, 0), a3, voffA);
            PG8_BAR; PG8_WAIT_L(0); PG8_MMA(1, 0, At, B0); PG8_BAR; PG8_SCHED;
            PG8_STAGE(PG8_SB(1, 1), b3 + hstep, voffB);
            PG8_WAIT_V(6); PG8_BAR; PG8_MMA(1, 1, At, B1); PG8_BAR;
            }
        }
        if constexpr (ALIGN_EPI) { if (wr == 0) PG8_BAR; }
        if constexpr (I8) {
            const float* sap = g.sa + cur.pm * 256 + wr * 64 + fr; const float* swp = g.sw + cur.pn * 256 + wc * 32 + 8 * fq;
            f32x4 cw[2][2];
#pragma unroll
            for (int b = 0; b < 2; ++b)
#pragma unroll
                for (int n = 0; n < 2; ++n) cw[b][n] = *(const f32x4*)(swp + b * 128 + 4 * n);
#pragma unroll
            for (int a = 0; a < 2; ++a)
#pragma unroll
                for (int m = 0; m < 4; ++m) { const float ra = sap[a * 128 + m * 16];
#pragma unroll
                    for (int b = 0; b < 2; ++b)
#pragma unroll
                        for (int n = 0; n < 2; ++n) acc[a][b][m][n] = __builtin_convertvector(__builtin_bit_cast(i32x4, acc[a][b][m][n]), f32x4) * ra * cw[b][n]; }
        }
        if constexpr (!Epi::AFTER_DRAIN) { E(acc, cur, wr, wc, fr, fq); S.done(cur); }
        if (!has_next) break;
#pragma unroll
        for (int a = 0; a < 2; ++a)
#pragma unroll
            for (int b = 0; b < 2; ++b)
#pragma unroll
                for (int m = 0; m < 4; ++m)
#pragma unroll
                    for (int n = 0; n < 2; ++n) acc[a][b][m][n] = (f32x4){0.f, 0.f, 0.f, 0.f};
        cur = nxt; cA = nA; cB = nB; ++ui;
        if constexpr (ALIGN_EPI) { if (wr == 1) PG8_BAR; }
    }
    PG8_WAIT_V(0);
    if constexpr (!ALIGN_EPI) { if (wr == 0) PG8_BAR; }
    PG8_BAR;
    if constexpr (Epi::AFTER_DRAIN) { E.fused(acc, cur, wr, wc, fr, fq, lds, wid, lane); S.done(cur); }
#undef PG8_SA
#undef PG8_SB
#undef PG8_STAGE
#undef PG8_LDA
#undef PG8_LDB
#undef PG8_MMA
#undef PG8_WAIT_V
#undef PG8_WAIT_L
#undef PG8_BAR
#undef PG8_SCHED
}
}
#define LAS __attribute__((address_space(3)))
#define GAS __attribute__((address_space(1)))
typedef unsigned short bf16_t;
typedef short bf16x8 __attribute__((ext_vector_type(8)));
typedef float f32x4 __attribute__((ext_vector_type(4)));
typedef unsigned u32x4 __attribute__((ext_vector_type(4)));
typedef unsigned u32x2 __attribute__((ext_vector_type(2)));

constexpr int NB = 4, SEQ = 4096, DM = 2048, NT = NB * SEQ;
constexpr int NTHREADS = 512;
constexpr int LDS_BYTES = 147456;
constexpr float EPS = 1e-6f;
constexpr int EVEN_IN_SRC = 6152, EVEN_IN = 6144, ODD_IN = 5120;

constexpr size_t MiB = 1048576;
constexpr size_t WS_MOD = 0;
constexpr size_t WS_MISC = 512 * 1024;
constexpr size_t WS_LF = 1 * MiB;
constexpr size_t WS_LI = WS_LF + 256 * 1024;
constexpr size_t WS_CHS = 2 * MiB;
constexpr size_t WS_NLOC = 2 * MiB + 512 * 1024;
constexpr size_t WS_KMEAN = 3 * MiB;
constexpr size_t WS_SCL = 3 * MiB + 512 * 1024;
constexpr size_t WS_SK = 4 * MiB;
constexpr size_t WS_ROPE = 5 * MiB;
constexpr size_t WS_WIN0 = 8 * MiB;
constexpr size_t WS_WOUT0 = 32 * MiB;
constexpr size_t WS_WIN1 = 40 * MiB;
constexpr size_t WS_WOUT1 = 60 * MiB;
constexpr size_t WS_WQ0 = 68 * MiB;
constexpr size_t WS_WQ1 = 76 * MiB;
constexpr size_t WS_U = 84 * MiB;
constexpr size_t WS_V = 212 * MiB;
constexpr size_t WS_HN8 = 148 * MiB;
constexpr size_t WS_XS = 180 * MiB;
constexpr size_t WS_W8 = 116 * MiB;
constexpr size_t WS_WSC = 181 * MiB;
constexpr size_t WS_HN = 340 * MiB;
constexpr size_t WS_PROJ = 404 * MiB;
constexpr size_t WS_CAT = 596 * MiB;
constexpr size_t WS_QP = 660 * MiB;
constexpr size_t WS_QM = 724 * MiB;
constexpr size_t WS_KM = 740 * MiB;
constexpr size_t WS_VTM = 756 * MiB;
constexpr size_t WS_CLOC = 788 * MiB;
constexpr size_t WS_VTD = 820 * MiB;
constexpr size_t WS_CPREV = 852 * MiB;
constexpr size_t WS_NPREV = 2 * MiB + 768 * 1024;
constexpr size_t WS_MPREV = 2 * MiB + 16384;
constexpr size_t WS_H = 884 * MiB;
constexpr size_t WS_END = 948 * MiB;

struct Params { const float* in[25]; float* out; unsigned char* ws; long long pad; };

__device__ __forceinline__ float bf_lo(unsigned w) { return __uint_as_float(w << 16); }
__device__ __forceinline__ float bf_hi(unsigned w) { return __uint_as_float(w & 0xffff0000u); }
__device__ __forceinline__ float bf2f(bf16_t h) { return __uint_as_float((unsigned)h << 16); }
typedef float f32x2_t __attribute__((ext_vector_type(2))); typedef __bf16 bf16x2_t __attribute__((ext_vector_type(2)));
__device__ __forceinline__ unsigned pk_bf16(float lo, float hi) { const f32x2_t v = {lo, hi}; const bf16x2_t b = __builtin_convertvector(v, bf16x2_t); return __builtin_bit_cast(unsigned, b); }
__device__ __forceinline__ bf16_t f2bf(float f) { return (bf16_t)(pk_bf16(f, 0.f) & 0xffffu); }
__device__ __forceinline__ float wave_sum(float v) {
#pragma unroll
    for (int o = 1; o < 64; o <<= 1) v += __shfl_xor(v, o);
    return v;
}
__device__ __forceinline__ float wave_max(float v) {
#pragma unroll
    for (int o = 1; o < 64; o <<= 1) v = fmaxf(v, __shfl_xor(v, o));
    return v;
}
__device__ __forceinline__ float swap32_add(float x, float y) { const auto r = __builtin_amdgcn_permlane32_swap(__float_as_uint(x), __float_as_uint(y), false, false); return __uint_as_float(r[0]) + __uint_as_float(r[1]); }
__device__ __forceinline__ float swap16_add(float x, float y) { const auto r = __builtin_amdgcn_permlane16_swap(__float_as_uint(x), __float_as_uint(y), false, false); return __uint_as_float(r[0]) + __uint_as_float(r[1]); }
__device__ __forceinline__ float dpp_xor8(float v) { return __uint_as_float(__builtin_amdgcn_update_dpp(0u, __float_as_uint(v), 0x128, 0xF, 0xF, false)); }
__device__ __forceinline__ float dpp_xor1(float v) { return __uint_as_float(__builtin_amdgcn_update_dpp(0u, __float_as_uint(v), 0xB1, 0xF, 0xF, false)); }
__device__ __forceinline__ float dpp_xor2(float v) { return __uint_as_float(__builtin_amdgcn_update_dpp(0u, __float_as_uint(v), 0x4E, 0xF, 0xF, false)); }
__device__ __forceinline__ float dpp_xor4(float v) { const unsigned t = __builtin_amdgcn_update_dpp(0u, __float_as_uint(v), 0x141, 0xF, 0xF, false);
    return __uint_as_float(__builtin_amdgcn_update_dpp(0u, t, 0x1B, 0xF, 0xF, false)); }
__device__ __forceinline__ float sigmoidf_(float a) { return 1.f / (1.f + __expf(-a)); }
__device__ __forceinline__ float gelu_tanh(float x) { const float z = 0.7978845608f * (x + 0.044715f * x * x * x); return x / (1.f + __expf(-2.f * z)); }
__device__ __forceinline__ f32x4 mfma16(bf16x8 a, bf16x8 b, f32x4 c) { return __builtin_amdgcn_mfma_f32_16x16x32_bf16(a, b, c, 0, 0, 0); }
__device__ __forceinline__ void unpack8(u32x4 w, float* f) {
    f[0] = bf_lo(w.x); f[1] = bf_hi(w.x); f[2] = bf_lo(w.y); f[3] = bf_hi(w.y); f[4] = bf_lo(w.z); f[5] = bf_hi(w.z); f[6] = bf_lo(w.w); f[7] = bf_hi(w.w);
}
__device__ __forceinline__ u32x4 pack8(const float* f) { u32x4 w; w.x = pk_bf16(f[0], f[1]); w.y = pk_bf16(f[2], f[3]); w.z = pk_bf16(f[4], f[5]); w.w = pk_bf16(f[6], f[7]); return w; }

struct EpiStoreBf16 {
    static constexpr bool PERM = true, AFTER_DRAIN = false;
    bf16_t* O; int ldc;
    __device__ __forceinline__ void operator()(const f32x4 (&acc)[2][2][4][2], const pg8::Unit& u, int wr, int wc, int fr, int fq) const {
        const int row0 = u.pm * 256 + wr * 64 + fr, col0 = u.pn * 256 + wc * 32 + 8 * fq;
#pragma unroll
        for (int ai = 0; ai < 2; ++ai)
#pragma unroll
            for (int m = 0; m < 4; ++m) { bf16_t* rowp = O + (size_t)(row0 + ai * 128 + m * 16) * ldc + col0;
#pragma unroll
                for (int bj = 0; bj < 2; ++bj) { const f32x4 v0 = acc[ai][bj][m][0], v1 = acc[ai][bj][m][1];
                    u32x4 w; w.x = pk_bf16(v0[0], v0[1]); w.y = pk_bf16(v0[2], v0[3]); w.z = pk_bf16(v1[0], v1[1]); w.w = pk_bf16(v1[2], v1[3]);
                    *(u32x4*)(rowp + bj * 128) = w; } }
    }
};
template <int LAYER>
struct EpiProj {
    static constexpr bool PERM = true, AFTER_DRAIN = false;
    bf16_t* O; int ldc; bf16_t* vta; bf16_t* vtb;
    __device__ __forceinline__ void operator()(const f32x4 (&acc)[2][2][4][2], const pg8::Unit& u, int wr, int wc, int fr, int fq) const {
        const int row0 = u.pm * 256 + wr * 64 + fr, col0 = u.pn * 256 + wc * 32 + 8 * fq;
        const bool isva = (LAYER == 0) && (u.pn >= 4 && u.pn < 8);
        const bool isvb = (LAYER == 0) ? (u.pn >= 20) : (u.pn >= 8 && u.pn < 12);
        if (!isva && !isvb) {
#pragma unroll
            for (int ai = 0; ai < 2; ++ai)
#pragma unroll
                for (int m = 0; m < 4; ++m) { bf16_t* rowp = O + (size_t)(row0 + ai * 128 + m * 16) * ldc + col0;
#pragma unroll
                    for (int bj = 0; bj < 2; ++bj) { const f32x4 v0 = acc[ai][bj][m][0], v1 = acc[ai][bj][m][1];
                        u32x4 w; w.x = pk_bf16(v0[0], v0[1]); w.y = pk_bf16(v0[2], v0[3]); w.z = pk_bf16(v1[0], v1[1]); w.w = pk_bf16(v1[2], v1[3]);
                        *(u32x4*)(rowp + bj * 128) = w; } }
        } else {
            const int b = (u.pm * 256) / SEQ, s0 = (u.pm * 256) % SEQ + wr * 64 + fr;
            const int cbase = isva ? 1024 : (LAYER == 0 ? 5120 : 2048);
            const int hv = isva ? 256 : 128, nh = isva ? 4 : 8;
            bf16_t* vt = isva ? vta : vtb;
#pragma unroll
            for (int bj = 0; bj < 2; ++bj) {
                const int cc = col0 + bj * 128 - cbase; const int h = cc / hv, v0i = cc % hv;
                bf16_t* vp = vt + ((size_t)(b * nh + h) * hv + v0i) * SEQ + s0;
#pragma unroll
                for (int ai = 0; ai < 2; ++ai)
#pragma unroll
                    for (int m = 0; m < 4; ++m) { const int so = ai * 128 + m * 16;
#pragma unroll
                        for (int n = 0; n < 2; ++n)
#pragma unroll
                            for (int e = 0; e < 4; ++e) vp[(size_t)(4 * n + e) * SEQ + so] = f2bf(acc[ai][bj][m][n][e]); }
            }
        }
    }
};
template <bool IN_F32>
struct EpiResid {
    static constexpr bool PERM = true, AFTER_DRAIN = false;
    const void* hin; bf16_t* hout; const float* gate;
    __device__ __forceinline__ void operator()(const f32x4 (&acc)[2][2][4][2], const pg8::Unit& u, int wr, int wc, int fr, int fq) const {
        const int row0 = u.pm * 256 + wr * 64 + fr, col0 = u.pn * 256 + wc * 32 + 8 * fq;
        const float* gp = gate + (size_t)((u.pm * 256) / SEQ) * 12288 + col0;
        f32x4 gv[2][2];
#pragma unroll
        for (int bj = 0; bj < 2; ++bj) { gv[bj][0] = *(const f32x4*)(gp + bj * 128); gv[bj][1] = *(const f32x4*)(gp + bj * 128 + 4); }
#pragma unroll
        for (int ai = 0; ai < 2; ++ai)
#pragma unroll
            for (int m = 0; m < 4; ++m) { const size_t off = (size_t)(row0 + ai * 128 + m * 16) * DM + col0;
#pragma unroll
                for (int bj = 0; bj < 2; ++bj) {
                    float h8[8];
                    if (IN_F32) { const f32x4 a = *(const f32x4*)((const float*)hin + off + bj * 128), c = *(const f32x4*)((const float*)hin + off + bj * 128 + 4);
                        h8[0] = a[0]; h8[1] = a[1]; h8[2] = a[2]; h8[3] = a[3]; h8[4] = c[0]; h8[5] = c[1]; h8[6] = c[2]; h8[7] = c[3]; }
                    else unpack8(*(const u32x4*)((const bf16_t*)hin + off + bj * 128), h8);
                    const f32x4 v0 = acc[ai][bj][m][0] * gv[bj][0], v1 = acc[ai][bj][m][1] * gv[bj][1];
                    u32x4 w; w.x = pk_bf16(h8[0] + v0[0], h8[1] + v0[1]); w.y = pk_bf16(h8[2] + v0[2], h8[3] + v0[3]); w.z = pk_bf16(h8[4] + v1[0], h8[5] + v1[1]); w.w = pk_bf16(h8[6] + v1[2], h8[7] + v1[3]);
                    *(u32x4*)(hout + off + bj * 128) = w; } }
    }
};

__device__ __forceinline__ void rms_mod_row(const float* src, const float* ng, const float* sc, const float* sh, bf16_t* dst, int lane, f32x4 (&v)[8]) {
    const f32x4* xr = (const f32x4*)src + lane; float s = 0.f;
#pragma unroll
    for (int j = 0; j < 8; ++j) { v[j] = xr[64 * j]; s += (v[j][0] * v[j][0] + v[j][1] * v[j][1]) + (v[j][2] * v[j][2] + v[j][3] * v[j][3]); }
    const float r = rsqrtf(wave_sum(s) * (1.f / DM) + EPS);
    u32x2* o8 = (u32x2*)dst + lane;
#pragma unroll
    for (int j = 0; j < 8; ++j) {
        const f32x4 g = ((const f32x4*)ng)[lane + 64 * j], a = ((const f32x4*)sc)[lane + 64 * j], b = ((const f32x4*)sh)[lane + 64 * j];
        v[j] = v[j] * r * g * (a + 1.f) + b;
        u32x2 w; w.x = pk_bf16(v[j][0], v[j][1]); w.y = pk_bf16(v[j][2], v[j][3]); o8[64 * j] = w;
    }
}

__device__ __forceinline__ void p0_transpose_item(const float* W, int ldw, int c0, int k0, bf16_t* WT, int n0, LAS float* scr, int lane) {
#pragma unroll 8
    for (int i = 0; i < 32; ++i) { const int kk = 2 * i + (lane >> 5); scr[kk * 33 + (lane & 31)] = W[(size_t)(k0 + kk) * ldw + c0 + (lane & 31)]; }
    asm volatile("s_waitcnt lgkmcnt(0)" ::: "memory");
    const int c = lane & 7;
#pragma unroll
    for (int j = 0; j < 4; ++j) { const int n = (lane >> 3) + 8 * j; const LAS float* s = scr + (8 * c) * 33 + n;
        u32x4 o; o.x = pk_bf16(s[0 * 33], s[1 * 33]); o.y = pk_bf16(s[2 * 33], s[3 * 33]); o.z = pk_bf16(s[4 * 33], s[5 * 33]); o.w = pk_bf16(s[6 * 33], s[7 * 33]);
        *(u32x4*)(WT + (size_t)(n0 + n) * 2048 + k0 + 8 * c) = o; }
    asm volatile("s_waitcnt lgkmcnt(0)" ::: "memory");
}

__device__ __forceinline__ unsigned p0_enc8(const f32x4 lo4, const f32x4 hi4, float c, bool isU) {
    unsigned w = 0u;
    if (isU) {
#pragma unroll
        for (int b = 0; b < 4; ++b) { const int ql = (int)__builtin_amdgcn_fmed3f(floorf(lo4[b] * c), -8.f, 7.f), qh = (int)__builtin_amdgcn_fmed3f(floorf(hi4[b] * c), -8.f, 7.f);
            w |= (((unsigned)(ql + 8) & 15u) | (((unsigned)qh & 15u) << 4)) << (8 * b); }
    } else {
        w = __builtin_amdgcn_cvt_scalef32_pk_fp4_f32(w, __builtin_amdgcn_fmed3f(lo4[0] * c, -6.f, 6.f), __builtin_amdgcn_fmed3f(lo4[1] * c, -6.f, 6.f), 1.0f, 0);
        w = __builtin_amdgcn_cvt_scalef32_pk_fp4_f32(w, __builtin_amdgcn_fmed3f(lo4[2] * c, -6.f, 6.f), __builtin_amdgcn_fmed3f(lo4[3] * c, -6.f, 6.f), 1.0f, 1);
        w = __builtin_amdgcn_cvt_scalef32_pk_fp4_f32(w, __builtin_amdgcn_fmed3f(hi4[0] * c, -6.f, 6.f), __builtin_amdgcn_fmed3f(hi4[1] * c, -6.f, 6.f), 1.0f, 2);
        w = __builtin_amdgcn_cvt_scalef32_pk_fp4_f32(w, __builtin_amdgcn_fmed3f(hi4[2] * c, -6.f, 6.f), __builtin_amdgcn_fmed3f(hi4[3] * c, -6.f, 6.f), 1.0f, 3);
    }
    return w;
}
__device__ __forceinline__ void convert_tables(const Params& p, int lane, int gw, int NGW) {
    unsigned char* ws = p.ws;
    float* scl = (float*)(ws + WS_SCL);
#define CT_LOAD(dst0, dst1, r_) do { const int ra_ = (r_), rb_ = ((r_) + NGW < 65536) ? (r_) + NGW : (r_); \
        const f32x4* sa_ = (const f32x4*)((ra_ < 32768 ? p.in[23] : p.in[24]) + (size_t)(ra_ & 32767) * 2048); const f32x4* sb_ = (const f32x4*)((rb_ < 32768 ? p.in[23] : p.in[24]) + (size_t)(rb_ & 32767) * 2048); \
        _Pragma("unroll") for (int j = 0; j < 8; ++j) { dst0[j] = sa_[2 * lane + (j & 1) + 128 * (j >> 1)]; dst1[j] = sb_[2 * lane + (j & 1) + 128 * (j >> 1)]; } } while (0)
    f32x4 v0[8], v1[8];
    if (gw < 65536) CT_LOAD(v0, v1, gw);
#pragma unroll 1
    for (int r = gw; r < 65536; r += 2 * NGW) {
        const int r1 = r + NGW; const bool has1 = r1 < 65536; const int rb = has1 ? r1 : r;
        unsigned char* d0 = ws + (r < 32768 ? WS_U : WS_V) + (size_t)((r >> 14) & 1) * 16384 * 1024 + (size_t)(r & 16383) * 128;
        unsigned char* d1 = ws + (rb < 32768 ? WS_U : WS_V) + (size_t)((rb >> 14) & 1) * 16384 * 1024 + (size_t)(rb & 16383) * 128;
        f32x4 n0[8], n1[8];
        const bool more = r + 2 * NGW < 65536;
        if (more) CT_LOAD(n0, n1, r + 2 * NGW);
        float a0 = 0.f, a1 = 0.f;
#pragma unroll
        for (int j = 0; j < 8; ++j) { a0 += (v0[j][0] * v0[j][0] + v0[j][1] * v0[j][1]) + (v0[j][2] * v0[j][2] + v0[j][3] * v0[j][3]);
                                      a1 += (v1[j][0] * v1[j][0] + v1[j][1] * v1[j][1]) + (v1[j][2] * v1[j][2] + v1[j][3] * v1[j][3]); }
        a0 = wave_sum(a0); a1 = wave_sum(a1);
        const bool u0 = true, u1 = true;
        const float sc0 = (a0 > 0.f) ? (u0 ? 0.3352f : 0.5f) * sqrtf(a0 * (1.f / 2048.f)) : 1.f, sc1 = (a1 > 0.f) ? (u1 ? 0.3352f : 0.5f) * sqrtf(a1 * (1.f / 2048.f)) : 1.f;
        const float c0 = 1.f / sc0, c1 = 1.f / sc1;
#pragma unroll
        for (int jj = 0; jj < 4; ++jj) { const size_t off = (size_t)(2 * jj + (lane >> 5)) * (16384 * 128) + (lane & 31) * 4;
            *(unsigned*)(d0 + off) = p0_enc8(v0[2 * jj], v0[2 * jj + 1], c0, u0);
            if (has1) *(unsigned*)(d1 + off) = p0_enc8(v1[2 * jj], v1[2 * jj + 1], c1, u1); }
        if (lane == 0) { scl[r] = sc0; if (has1) scl[r1] = sc1; }
        if (more) {
#pragma unroll
            for (int j = 0; j < 8; ++j) { v0[j] = n0[j]; v1[j] = n1[j]; } }
    }
#undef CT_LOAD
}
__device__ __forceinline__ void phase0a(const Params& p, LAS unsigned char* lds, int tid, int lane, int wave, int bid, int G) {
    unsigned char* ws = p.ws;
    const int gw = bid * 8 + wave, NGW = G * 8;
    const int gt = bid * NTHREADS + tid, NGT = G * NTHREADS;
    {
        LAS float* scr = (LAS float*)(lds + wave * 8704);
        constexpr int NB0 = 192, NB1 = 64, NB2 = 160, NB3 = 64, NB4 = 64, NB5 = 64, NBT = NB0 + NB1 + NB2 + NB3 + NB4 + NB5;
        for (int it = gw; it < 32 * NBT; it += NGW) {
            const int kb = it / NBT; int nb = it % NBT; const int k0 = kb * 64;
            if (nb < NB0) { const int n0 = nb * 32; p0_transpose_item(p.in[7], EVEN_IN_SRC, n0 + (n0 >= 3072 ? 8 : 0), k0, (bf16_t*)(ws + WS_WIN0), n0, scr, lane); continue; } nb -= NB0;
            if (nb < NB1) { p0_transpose_item(p.in[8], 2048, nb * 32, k0, (bf16_t*)(ws + WS_WOUT0), nb * 32, scr, lane); continue; } nb -= NB1;
            if (nb < NB2) { p0_transpose_item(p.in[15], ODD_IN, nb * 32, k0, (bf16_t*)(ws + WS_WIN1), nb * 32, scr, lane); continue; } nb -= NB2;
            if (nb < NB3) { p0_transpose_item(p.in[16], 2048, nb * 32, k0, (bf16_t*)(ws + WS_WOUT1), nb * 32, scr, lane); continue; } nb -= NB3;
            if (nb < NB4) { p0_transpose_item(p.in[21], 2048, nb * 32, k0, (bf16_t*)(ws + WS_WQ0), nb * 32, scr, lane); continue; } nb -= NB4;
            p0_transpose_item(p.in[21] + (size_t)2048 * 2048, 2048, nb * 32, k0, (bf16_t*)(ws + WS_WQ1), nb * 32, scr, lane);
        }
    }
    {
        const size_t k8 = (size_t)2 * 8 * 2 * 128 * 128 / 8;
        const f32x4* sk = (const f32x4*)p.in[22]; u32x4* dk = (u32x4*)(ws + WS_SK);
        for (size_t i = gt; i < k8; i += NGT) { const f32x4 a = sk[2 * i], b = sk[2 * i + 1];
            u32x4 w; w.x = pk_bf16(a[0], a[1]); w.y = pk_bf16(a[2], a[3]); w.z = pk_bf16(b[0], b[1]); w.w = pk_bf16(b[2], b[3]); dk[i] = w; }
    }
    {
        const int* pos = (const int*)p.in[2]; float* tab = (float*)(ws + WS_ROPE);
        for (int i = gt; i < NT * 24; i += NGT) {
            const int t = i / 24, j = i % 24;
            const float e = (j < 8) ? (float)j * (1.f / 8.f) : (float)(j - 8) * (1.f / 16.f);
            const float inv = exp2f(-e * 18.931568569324174f);
            const float ang = (float)pos[t] * inv;
            float sn, cs; sincosf(ang, &sn, &cs);
            tab[2 * i] = cs; tab[2 * i + 1] = sn;
        }
    }
    {
        const float* cin = p.in[1]; float* mod = (float*)(ws + WS_MOD);
        LAS float* part = (LAS float*)(lds + 73728);
        for (int it = bid; it < 192; it += G) {
            const int ng = it % 96, l = it / 96;
            const int n0 = ng * 128 + 2 * lane;
            f32x2_t acc[4];
#pragma unroll
            for (int b = 0; b < 4; ++b) acc[b] = (f32x2_t){0.f, 0.f};
#pragma unroll 1
            for (int kc = 0; kc < 4; ++kc) {
                const int k0 = wave * 256 + kc * 64;
                float ca[4];
#pragma unroll
                for (int b = 0; b < 4; ++b) { const float cv = cin[b * DM + k0 + lane]; ca[b] = cv * sigmoidf_(cv); }
                const float* wp = p.in[3] + ((size_t)l * DM + k0) * 12288 + n0;
#pragma unroll 16
                for (int kk = 0; kk < 64; ++kk) {
                    const f32x2_t w = *(const f32x2_t*)(wp + (size_t)kk * 12288);
#pragma unroll
                    for (int b = 0; b < 4; ++b) acc[b] += w * __shfl(ca[b], kk);
                }
            }
#pragma unroll
            for (int b = 0; b < 4; ++b) *(LAS f32x2_t*)(part + (wave * 4 + b) * 128 + 2 * lane) = acc[b];
            __syncthreads();
            { const int o = tid, b = o >> 7, col = o & 127;
                float sm = p.in[4][l * 12288 + ng * 128 + col];
#pragma unroll
                for (int w = 0; w < 8; ++w) sm += part[(w * 4 + b) * 128 + col];
                mod[((size_t)l * 4 + b) * 12288 + ng * 128 + col] = sm; }
            __syncthreads();
        }
    }
    if (bid == 0 && wave == 0) {
        const float* lv = p.in[13];
        const float a = wave_sum(lv[lane] * lv[64 + lane]), b = wave_sum(lv[128 + lane] * lv[192 + lane]);
        if (lane == 0) ((float*)(ws + WS_MISC))[0] = __expf(a) - __expf(b) + 0.2f;
    }
}

__device__ __forceinline__ unsigned pack4_i8(float a, float b, float c, float d, float inv) {
    return ((unsigned)(int)rintf(a * inv) & 255u) | (((unsigned)(int)rintf(b * inv) & 255u) << 8) | (((unsigned)(int)rintf(c * inv) & 255u) << 16) | ((unsigned)(int)rintf(d * inv) << 24);
}
__device__ __forceinline__ void quant_weights(unsigned char* ws, int lane, int gw, int NGW) {
    float* wsc = (float*)(ws + WS_WSC);
    for (int n = gw; n < 15360; n += NGW) {
        const bf16_t* src = (n < 6144) ? (const bf16_t*)(ws + WS_WIN0) + (size_t)n * 2048 : (n < 11264) ? (const bf16_t*)(ws + WS_WIN1) + (size_t)(n - 6144) * 2048
                          : (n < 13312) ? (const bf16_t*)(ws + WS_WQ0) + (size_t)(n - 11264) * 2048 : (const bf16_t*)(ws + WS_WQ1) + (size_t)(n - 13312) * 2048;
        u32x4 v[4];
#pragma unroll
        for (int j = 0; j < 4; ++j) v[j] = ((const u32x4*)src)[lane + 64 * j];
        float f[32]; float m = 0.f;
#pragma unroll
        for (int j = 0; j < 4; ++j) unpack8(v[j], f + 8 * j);
#pragma unroll
        for (int e = 0; e < 32; ++e) m = fmaxf(m, fabsf(f[e]));
        m = fmaxf(wave_max(m), 1e-30f);
        const float inv = 127.f / m;
        u32x2* dst = (u32x2*)(ws + WS_W8 + (size_t)n * 2048);
#pragma unroll
        for (int j = 0; j < 4; ++j) { u32x2 o; o.x = pack4_i8(f[8 * j], f[8 * j + 1], f[8 * j + 2], f[8 * j + 3], inv); o.y = pack4_i8(f[8 * j + 4], f[8 * j + 5], f[8 * j + 6], f[8 * j + 7], inv);
            dst[lane + 64 * j] = o; }
        if (lane == 0) wsc[n] = m * (1.f / 127.f);
    }
}

template <bool GATES>
__device__ __forceinline__ void phase_rows(const Params& p, LAS unsigned char* lds, const void* hsrc_, const float* ng, const float* modl  , int sc_off, int sh_off,
                                           int tid, int lane, int wave, int bid, int G) {
    unsigned char* ws = p.ws;
    LAS float* wg = (LAS float*)lds;
    if (GATES) {
        for (int i = tid; i < 8 * DM; i += NTHREADS) { const int k = i >> 3, j = i & 7; wg[j * DM + k] = p.in[7][(size_t)k * EVEN_IN_SRC + 3072 + j]; }
        __syncthreads();
    }
    float* lf = (float*)(ws + WS_LF); float* li = (float*)(ws + WS_LI);
    for (int r0 = (bid * 8 + wave) * 8; r0 < NT; r0 += G * 64) {
        const int b = r0 / SEQ;
        f32x4 av[8], bv[8];
        { const float* sc = modl + (size_t)b * 12288 + sc_off; const float* sh = modl + (size_t)b * 12288 + sh_off;
#pragma unroll
          for (int j = 0; j < 8; ++j) { av[j] = ((const f32x4*)ng)[lane + 64 * j] * (((const f32x4*)sc)[lane + 64 * j] + 1.f); bv[j] = ((const f32x4*)sh)[lane + 64 * j]; } }
#pragma unroll 1
        for (int i = 0; i < 8; i += 2) {
            f32x4 v0[8], v1[8]; float s0 = 0.f, s1 = 0.f;
            if (GATES) { const f32x4* x0 = (const f32x4*)((const float*)hsrc_ + (size_t)(r0 + i) * DM) + lane; const f32x4* x1 = x0 + DM / 4;
#pragma unroll
                for (int j = 0; j < 8; ++j) { v0[j] = x0[64 * j]; v1[j] = x1[64 * j]; } }
            else { const u32x2* x0 = (const u32x2*)((const bf16_t*)hsrc_ + (size_t)(r0 + i) * DM) + lane; const u32x2* x1 = x0 + DM / 4;
#pragma unroll
                for (int j = 0; j < 8; ++j) { const u32x2 a = x0[64 * j], c = x1[64 * j];
                    v0[j] = (f32x4){bf_lo(a.x), bf_hi(a.x), bf_lo(a.y), bf_hi(a.y)}; v1[j] = (f32x4){bf_lo(c.x), bf_hi(c.x), bf_lo(c.y), bf_hi(c.y)}; } }
#pragma unroll
            for (int j = 0; j < 8; ++j) { s0 += (v0[j][0] * v0[j][0] + v0[j][1] * v0[j][1]) + (v0[j][2] * v0[j][2] + v0[j][3] * v0[j][3]);
                                          s1 += (v1[j][0] * v1[j][0] + v1[j][1] * v1[j][1]) + (v1[j][2] * v1[j][2] + v1[j][3] * v1[j][3]); }
#pragma unroll
            for (int o = 1; o < 64; o <<= 1) { s0 += __shfl_xor(s0, o); s1 += __shfl_xor(s1, o); }
            const float q0 = rsqrtf(s0 * (1.f / DM) + EPS), q1 = rsqrtf(s1 * (1.f / DM) + EPS);
#pragma unroll
            for (int j = 0; j < 8; ++j) { v0[j] = v0[j] * q0 * av[j] + bv[j]; v1[j] = v1[j] * q1 * av[j] + bv[j]; }
            {
                float m0 = 0.f, m1 = 0.f;
#pragma unroll
                for (int j = 0; j < 8; ++j) { m0 = fmaxf(m0, fmaxf(fmaxf(fabsf(v0[j][0]), fabsf(v0[j][1])), fmaxf(fabsf(v0[j][2]), fabsf(v0[j][3]))));
                                              m1 = fmaxf(m1, fmaxf(fmaxf(fabsf(v1[j][0]), fabsf(v1[j][1])), fmaxf(fabsf(v1[j][2]), fabsf(v1[j][3])))); }
#pragma unroll
                for (int o = 1; o < 64; o <<= 1) { m0 = fmaxf(m0, __shfl_xor(m0, o)); m1 = fmaxf(m1, __shfl_xor(m1, o)); }
                m0 = fmaxf(m0, 1e-20f); m1 = fmaxf(m1, 1e-20f);
                const float i0 = 127.f / m0, i1 = 127.f / m1;
                unsigned* e0 = (unsigned*)(ws + WS_HN8 + (size_t)(r0 + i) * DM) + lane; unsigned* e1 = e0 + DM / 4;
#pragma unroll
                for (int j = 0; j < 8; ++j) {
                    const unsigned a0 = (unsigned)(int)rintf(v0[j][0] * i0) & 255u, a1 = (unsigned)(int)rintf(v0[j][1] * i0) & 255u, a2 = (unsigned)(int)rintf(v0[j][2] * i0) & 255u, a3 = (unsigned)(int)rintf(v0[j][3] * i0);
                    const unsigned c0 = (unsigned)(int)rintf(v1[j][0] * i1) & 255u, c1 = (unsigned)(int)rintf(v1[j][1] * i1) & 255u, c2 = (unsigned)(int)rintf(v1[j][2] * i1) & 255u, c3 = (unsigned)(int)rintf(v1[j][3] * i1);
                    e0[64 * j] = a0 | (a1 << 8) | (a2 << 16) | (a3 << 24); e1[64 * j] = c0 | (c1 << 8) | (c2 << 16) | (c3 << 24); }
                if (lane == 0) { float* xs = (float*)(ws + WS_XS); xs[r0 + i] = m0 * (1.f / 127.f); xs[r0 + i + 1] = m1 * (1.f / 127.f); }
            }
            if (GATES) {
#pragma unroll
                for (int rr = 0; rr < 2; ++rr) {
                    float pd[8];
#pragma unroll
                    for (int jg = 0; jg < 8; ++jg) { float a = 0.f;
#pragma unroll
                        for (int j = 0; j < 8; ++j) { const f32x4 w = *(const LAS f32x4*)(wg + jg * DM + 4 * lane + 256 * j); const f32x4 x = rr ? v1[j] : v0[j];
                            a += (x[0] * w[0] + x[1] * w[1]) + (x[2] * w[2] + x[3] * w[3]); }
                        pd[jg] = a; __builtin_amdgcn_sched_barrier(0); }
                    const bool b5 = (lane >> 5) & 1, b4 = (lane >> 4) & 1, b3 = (lane >> 3) & 1;
                    float r4[4], r2[2];
#pragma unroll
                    for (int q = 0; q < 4; ++q) r4[q] = (b5 ? pd[4 + q] : pd[q]) + __shfl_xor(b5 ? pd[q] : pd[4 + q], 32);
#pragma unroll
                    for (int q = 0; q < 2; ++q) r2[q] = (b4 ? r4[2 + q] : r4[q]) + __shfl_xor(b4 ? r4[q] : r4[2 + q], 16);
                    float g1 = (b3 ? r2[1] : r2[0]) + __shfl_xor(b3 ? r2[0] : r2[1], 8);
                    g1 += __shfl_xor(g1, 4); g1 += __shfl_xor(g1, 2); g1 += __shfl_xor(g1, 1);
                    const int jg = lane >> 3, h = jg & 3; const int m = r0 + i + rr, s = m % SEQ;
                    if ((lane & 7) == 0) {
                        const float pre = g1 + p.in[11][jg];
                        if (jg < 4) li[((size_t)b * 4 + h) * SEQ + s] = pre;
                        else lf[((size_t)b * 4 + h) * SEQ + s] = (pre >= 0.f) ? -log1pf(__expf(-pre)) : pre - log1pf(__expf(pre));
                    }
                }
            }
        }
    }
}
#define XB_TMO      128
#define XB_XCNT(j)  (256  + 64 * (j))
#define XB_XSUB(j)  (1280 + 64 * (j))
#define XB_XGEN(j)  (2304 + 64 * (j))
#define XB_TOP      3328
#define XB_TOPGEN   3392
#define XCD_BAR_WORDS 3456
#define XB_SPIN_CAP (1u << 18)

__device__ __forceinline__ unsigned xb_ld(unsigned* p)              { return __hip_atomic_load(p, __ATOMIC_RELAXED, __HIP_MEMORY_SCOPE_AGENT); }
__device__ __forceinline__ unsigned xb_add(unsigned* p, unsigned v) { return __hip_atomic_fetch_add(p, v, __ATOMIC_RELAXED, __HIP_MEMORY_SCOPE_AGENT); }
__device__ __forceinline__ unsigned xb_xcc_id() { return (unsigned)__builtin_amdgcn_s_getreg((3 << 11) | 20) & 0xFu; }
#define XB_SPIN(cond, bar) do { unsigned _sp = 0; while (cond) { __builtin_amdgcn_s_sleep(1); \
    if ((++_sp & 255u) == 0u) { if (xb_ld(&(bar)[XB_TMO])) break; if (_sp > XB_SPIN_CAP) { atomicAdd(&(bar)[XB_TMO], 1u); break; } } } } while (0)

struct XcdBarrier {
    unsigned* bar; unsigned x;
    volatile LAS unsigned* st;
};

__device__ __forceinline__ XcdBarrier xcd_barrier_post(unsigned* bar, volatile LAS unsigned* st) {
    XcdBarrier b; b.bar = bar; b.x = xb_xcc_id(); b.st = st;
    if (threadIdx.x == 0) (void)xb_add(&bar[XB_XCNT(b.x)], 1u);
    return b;
}
__device__ __forceinline__ void xcd_barrier_complete(unsigned* bar, unsigned x, unsigned& nloc, unsigned& nx) {
    const unsigned G = gridDim.x * gridDim.y * gridDim.z;
    unsigned sum, cnt, mine, sp = 0u;
    for (;;) {
        sum = 0u; cnt = 0u; mine = 0u;
#pragma unroll
        for (unsigned j = 0; j < 16; ++j) { const unsigned c = xb_ld(&bar[XB_XCNT(j)]); sum += c; cnt += (c > 0u) ? 1u : 0u; mine = (j == x) ? c : mine; }
        if (sum == G) break;
        __builtin_amdgcn_s_sleep(1);
        if ((++sp & 255u) == 0u) { if (xb_ld(&bar[XB_TMO])) break; if (sp > XB_SPIN_CAP) { atomicAdd(&bar[XB_TMO], 1u); break; } }
    }
    nloc = mine > 0u ? mine : 1u; nx = cnt > 0u ? cnt : 1u;
}

__device__ __forceinline__ void xcd_barrier(const XcdBarrier& b) {
    asm volatile("s_waitcnt vmcnt(0)" ::: "memory");
    __syncthreads();
    if (threadIdx.x == 0) {
        unsigned* bar = b.bar;
        __builtin_amdgcn_s_waitcnt(0);
        unsigned nloc = b.st[0], nx = b.st[1];
        if (nloc == 0u) { xcd_barrier_complete(bar, b.x, nloc, nx); b.st[0] = nloc; b.st[1] = nx; }
        const unsigned old = xb_add(&bar[XB_XSUB(b.x)], 1u);
        const unsigned gen = old / nloc;
        if (old + 1u == (gen + 1u) * nloc) {
            __builtin_amdgcn_fence(__ATOMIC_RELEASE, "agent");
            asm volatile("s_waitcnt vmcnt(0)" ::: "memory");
            const unsigned og = xb_add(&bar[XB_TOP], 1u);
            const unsigned tg = og / nx;
            if (og + 1u == (tg + 1u) * nx) xb_add(&bar[XB_TOPGEN], 1u);
            else XB_SPIN(xb_ld(&bar[XB_TOPGEN]) == tg, bar);
            __builtin_amdgcn_fence(__ATOMIC_ACQUIRE, "agent");
            xb_add(&bar[XB_XGEN(b.x)], 1u);
            asm volatile("s_waitcnt vmcnt(0)" ::: "memory");
        } else {
            XB_SPIN(xb_ld(&bar[XB_XGEN(b.x)]) == gen, bar);
            __builtin_amdgcn_fence(__ATOMIC_ACQUIRE, "agent");
            asm volatile("s_waitcnt vmcnt(0)" ::: "memory");
        }
    }
    __syncthreads();
}
__device__ __forceinline__ void transpose_64x128(const bf16_t* src, size_t ld_src, bf16_t* dst, size_t ld_dst, LAS unsigned char* T  , int tid) {
#pragma unroll
    for (int i = 0; i < 2; ++i) { const int id = tid + NTHREADS * i, row = id >> 4, ch = id & 15;
        const u32x4 w = *(const u32x4*)(src + (size_t)row * ld_src + ch * 8);
        LAS bf16_t* tp = (LAS bf16_t*)(T + (8 * ch) * 144 + ((((row >> 3) ^ (ch & 7)) << 4) + (row & 7) * 2));
        tp[0 * 72] = (bf16_t)(w.x & 0xffffu); tp[1 * 72] = (bf16_t)(w.x >> 16); tp[2 * 72] = (bf16_t)(w.y & 0xffffu); tp[3 * 72] = (bf16_t)(w.y >> 16);
        tp[4 * 72] = (bf16_t)(w.z & 0xffffu); tp[5 * 72] = (bf16_t)(w.z >> 16); tp[6 * 72] = (bf16_t)(w.w & 0xffffu); tp[7 * 72] = (bf16_t)(w.w >> 16); }
    __syncthreads();
#pragma unroll
    for (int i = 0; i < 2; ++i) { const int id = tid + NTHREADS * i, v = id >> 3, c = id & 7;
        *(u32x4*)(dst + (size_t)v * ld_dst + c * 8) = *(const LAS u32x4*)(T + v * 144 + ((c ^ ((v >> 3) & 7)) << 4)); }
    __syncthreads();
}

__device__ __forceinline__ void diff_post_item(const Params& p, LAS unsigned char* lds, int item, int tid) {
    const int blk = item & 15, h = (item >> 4) & 7, b = item >> 7;
    bf16_t* proj = (bf16_t*)(p.ws + WS_PROJ);
    const float* tab = (const float*)(p.ws + WS_ROPE);
    const size_t row0 = (size_t)b * SEQ + blk * 256;
#pragma unroll
    for (int i = 0; i < 2; ++i) {
        const int id = tid + NTHREADS * i, tok = id >> 2, comp = id & 1, qk = (id >> 1) & 1;
        bf16_t* ptr = proj + (row0 + tok) * EVEN_IN + (qk ? 4096 : 3072) + h * 128 + comp * 64;
        const u32x4 w1 = *(const u32x4*)ptr, w2 = *(const u32x4*)(ptr + 8);
        float x1[8], x2[8], o1[8], o2[8]; unpack8(w1, x1); unpack8(w2, x2);
        const float* tb = tab + (row0 + tok) * 48;
#pragma unroll
        for (int e = 0; e < 8; ++e) { const float cs = tb[2 * e], sn = tb[2 * e + 1]; o1[e] = x1[e] * cs - x2[e] * sn; o2[e] = x2[e] * cs + x1[e] * sn; }
        *(u32x4*)ptr = pack8(o1); *(u32x4*)(ptr + 8) = pack8(o2);
    }
    (void)lds;
}

__device__ __forceinline__ void mlstm_cloc_unit(const Params& p, LAS unsigned char* lds, int unit, int tid, int lane, int wave) {
    const int c = unit & 31, h = (unit >> 5) & 3, b = unit >> 7, bh = b * 4 + h;
    unsigned char* ws = p.ws;
    const bf16_t* proj = (const bf16_t*)(ws + WS_PROJ);
    LAS unsigned char* Kt = lds;
    LAS unsigned char* Vt = lds + 34816;
    LAS float* sc = (LAS float*)(lds + 104448);
    const int s0 = c * 128;
    const float* lf = (const float*)(ws + WS_LF) + (size_t)bh * SEQ + s0;
    const float* li = (const float*)(ws + WS_LI) + (size_t)bh * SEQ + s0;
    if (wave == 0) {
        const float e0 = lf[2 * lane], e1 = lf[2 * lane + 1];
        float incl = e0 + e1;
#pragma unroll
        for (int o = 1; o < 64; o <<= 1) { const float t = __shfl_up(incl, o); if (lane >= o) incl += t; }
        const float g = __shfl(incl, 63);
        const float b0 = incl - e1, b1 = incl;
        const float a0 = g - b0 + li[2 * lane], a1 = g - b1 + li[2 * lane + 1];
        const float ml = wave_max(fmaxf(a0, a1));
        sc[2 * lane] = __expf(a0 - ml); sc[2 * lane + 1] = __expf(a1 - ml);
        if (lane == 0) { float* chs = (float*)(ws + WS_CHS) + (size_t)(bh * 32 + c) * 2; chs[0] = g; chs[1] = ml; }
    }
    __syncthreads();
    const float* cw = p.in[9]; const float* cb = p.in[10];
    bf16_t* Qm = (bf16_t*)(ws + WS_QM) + ((size_t)bh * SEQ + s0) * 128;
    bf16_t* Km = (bf16_t*)(ws + WS_KM) + ((size_t)bh * SEQ + s0) * 128;
#pragma unroll 2
    for (int i = 0; i < 8; ++i) {
        const int id = tid + NTHREADS * (i & 3), isk = i >> 2, s = id >> 4, dc = id & 15;
        const int col = isk * 512 + h * 128 + dc * 8;
        float y[8];
        { const f32x4 b0 = *(const f32x4*)(cb + col), b1 = *(const f32x4*)(cb + col + 4);
          y[0] = b0[0]; y[1] = b0[1]; y[2] = b0[2]; y[3] = b0[3]; y[4] = b1[0]; y[5] = b1[1]; y[6] = b1[2]; y[7] = b1[3]; }
#pragma unroll
        for (int w = 0; w < 4; ++w) {
            const int ts = s0 + s - 3 + w;
            if (ts >= 0) {
                const u32x4 raw = *(const u32x4*)(proj + ((size_t)b * SEQ + ts) * EVEN_IN + col);
                float x[8]; unpack8(raw, x);
                const f32x4 w0 = *(const f32x4*)(cw + w * 1024 + col), w1 = *(const f32x4*)(cw + w * 1024 + col + 4);
                y[0] += x[0] * w0[0]; y[1] += x[1] * w0[1]; y[2] += x[2] * w0[2]; y[3] += x[3] * w0[3];
                y[4] += x[4] * w1[0]; y[5] += x[5] * w1[1]; y[6] += x[6] * w1[2]; y[7] += x[7] * w1[3];
            }
        }
#pragma unroll
        for (int e = 0; e < 8; ++e) y[e] = y[e] * sigmoidf_(y[e]);
        if (!isk) {
#pragma unroll
            for (int e = 0; e < 8; ++e) y[e] *= 0.08838834764831845f;
            *(u32x4*)(Qm + (size_t)s * 128 + dc * 8) = pack8(y);
        } else {
            *(u32x4*)(Km + (size_t)s * 128 + dc * 8) = pack8(y);
            const float wsv = sc[s];
            LAS bf16_t* kp = (LAS bf16_t*)(Kt + (dc * 8) * 272 + ((((s >> 3) ^ (dc & 7)) << 4) + (s & 7) * 2));
#pragma unroll
            for (int e = 0; e < 8; ++e) kp[e * 136] = f2bf(y[e] * wsv);
        }
    }
    {
        const bf16_t* Vtm = (const bf16_t*)(ws + WS_VTM) + ((size_t)bh * 256) * SEQ + s0;
#pragma unroll 4
        for (int i = 0; i < 8; ++i) { const int id = tid + NTHREADS * i, v = id >> 4, ch = id & 15;
            *(LAS u32x4*)(Vt + v * 272 + ((ch ^ ((v >> 3) & 15)) << 4)) = *(const u32x4*)(Vtm + (size_t)v * SEQ + ch * 8); }
    }
    __syncthreads();
    if (tid < 128) { float a = 0.f;
#pragma unroll
        for (int ch = 0; ch < 16; ++ch) { float f[8]; unpack8(*(const LAS u32x4*)(Kt + tid * 272 + ch * 16), f); a += ((f[0] + f[1]) + (f[2] + f[3])) + ((f[4] + f[5]) + (f[6] + f[7])); }
        ((float*)(ws + WS_NLOC))[(size_t)(bh * 32 + c) * 128 + tid] = a; }
    const int r16 = lane & 15, g = lane >> 4;
    f32x4 acc[8][2];
#pragma unroll
    for (int db = 0; db < 8; ++db) { acc[db][0] = (f32x4){0.f, 0.f, 0.f, 0.f}; acc[db][1] = (f32x4){0.f, 0.f, 0.f, 0.f}; }
#pragma unroll
    for (int ks = 0; ks < 4; ++ks) {
        bf16x8 vf[2];
#pragma unroll
        for (int j = 0; j < 2; ++j) { const int v = 16 * (2 * wave + j) + r16; vf[j] = *(const LAS bf16x8*)(Vt + v * 272 + (((4 * ks + g) ^ ((v >> 3) & 15)) << 4)); }
#pragma unroll
        for (int db = 0; db < 8; ++db) { const int d = 16 * db + r16; const bf16x8 kf = *(const LAS bf16x8*)(Kt + d * 272 + (((4 * ks + g) ^ ((d >> 3) & 7)) << 4));
            acc[db][0] = mfma16(kf, vf[0], acc[db][0]); acc[db][1] = mfma16(kf, vf[1], acc[db][1]); }
    }
    bf16_t* Cl = (bf16_t*)(ws + WS_CLOC) + (size_t)(bh * 32 + c) * 256 * 128;
#pragma unroll
    for (int db = 0; db < 8; ++db)
#pragma unroll
        for (int j = 0; j < 2; ++j) { const int v = 16 * (2 * wave + j) + r16;
            u32x2 w; w.x = pk_bf16(acc[db][j][0], acc[db][j][1]); w.y = pk_bf16(acc[db][j][2], acc[db][j][3]);
            *(u32x2*)(Cl + (size_t)v * 128 + 16 * db + 4 * g) = w; }
    __syncthreads();
}

constexpr int ATT_KROW = 256, ATT_VROW = 128, ATT_KBYTES = 64 * ATT_KROW, ATT_BUF = ATT_KBYTES + 128 * ATT_VROW, ATT_EXTRA = 2 * ATT_BUF;
template <int MODE>
__device__ __forceinline__ void attn_unit(LAS unsigned char* lds, const bf16_t* Qb, const bf16_t* Kb, int ld, const bf16_t* Vt, int j,
                                          const float* kmean  , bf16_t* outp, const float* gvec  , float lam,
                                          int tid, int lane, int wave) {
    constexpr int NC = (MODE == 0) ? 2 : 1;
    constexpr float CS = ((MODE == 0) ? 0.125f : 0.08838834764831845f) * 1.4426950408889634f;
    const int r16 = lane & 15, g = lane >> 4;
    const int q0 = j * 128, qpos = q0 + 16 * wave + r16;
    const int own = j >> 1, half = j & 1;
    const int nown = (MODE == 0) ? 0 : 2 + 2 * half;
    const int ntiles = (MODE == 0) ? 2 * (j + 1) : nown + 4 * own;
    bf16x8 qf[4];
#pragma unroll
    for (int ks = 0; ks < 4; ++ks) qf[ks] = *(const bf16x8*)(Qb + (size_t)qpos * ld + 32 * ks + 8 * g);
    unsigned sel = 0;
    if (MODE == 1) {
        LAS float* km = (LAS float*)(lds + ATT_EXTRA);
        for (int i = tid; i < 16 * 128; i += NTHREADS) km[i] = kmean[i];
        __syncthreads();
        float qv[32];
#pragma unroll
        for (int ks = 0; ks < 4; ++ks) { float f[8]; unpack8(__builtin_bit_cast(u32x4, qf[ks]), f);
#pragma unroll
            for (int e = 0; e < 8; ++e) qv[8 * ks + e] = f[e]; }
        float gate[15]; float t1 = -INFINITY, t2 = -INFINITY, t3 = -INFINITY;
#pragma unroll
        for (int n = 0; n < 15; ++n) {
            gate[n] = -INFINITY;
            if (n < own) {
                float a = 0.f;
#pragma unroll
                for (int ks = 0; ks < 4; ++ks) { const f32x4 k0 = *(const LAS f32x4*)(km + n * 128 + 32 * ks + 8 * g), k1 = *(const LAS f32x4*)(km + n * 128 + 32 * ks + 8 * g + 4);
                    a += (qv[8 * ks + 0] * k0[0] + qv[8 * ks + 1] * k0[1]) + (qv[8 * ks + 2] * k0[2] + qv[8 * ks + 3] * k0[3])
                       + (qv[8 * ks + 4] * k1[0] + qv[8 * ks + 5] * k1[1]) + (qv[8 * ks + 6] * k1[2] + qv[8 * ks + 7] * k1[3]); }
                a += __shfl_xor(a, 16); a += __shfl_xor(a, 32);
                gate[n] = a;
                float v = a; const float n1 = fmaxf(t1, v); v = fminf(t1, v); t1 = n1; const float n2 = fmaxf(t2, v); v = fminf(t2, v); t2 = n2; t3 = fmaxf(t3, v);
            }
        }
        const float theta = (own >= 3) ? t3 : -INFINITY;
#pragma unroll
        for (int n = 0; n < 15; ++n) if (n < own && gate[n] >= theta) sel |= 1u << n;
    }
    f32x4 O[NC][8];
#pragma unroll
    for (int c = 0; c < NC; ++c)
#pragma unroll
        for (int vb = 0; vb < 8; ++vb) O[c][vb] = (f32x4){0.f, 0.f, 0.f, 0.f};
    float mrun[NC], lsum[NC];
#pragma unroll
    for (int c = 0; c < NC; ++c) { mrun[c] = -INFINITY; lsum[c] = 0.f; }

    auto key0_of = [&](int t) -> int { if (MODE == 0) return 64 * t; if (t < nown) return own * 256 + 64 * t; const int tt = t - nown; return (tt >> 2) * 256 + 64 * (tt & 3); };
    u32x4 kreg[2], vreg[2];
    auto load_tile = [&](int t) { const int k0 = key0_of(t);
#pragma unroll
        for (int i = 0; i < 2; ++i) { const int id = tid + NTHREADS * i;
            kreg[i] = *(const u32x4*)(Kb + (size_t)(k0 + (id >> 4)) * ld + (id & 15) * 8);
            vreg[i] = *(const u32x4*)(Vt + (size_t)(id >> 3) * SEQ + k0 + (id & 7) * 8); } };
    auto store_tile = [&](int buf) { LAS unsigned char* base = lds + buf * ATT_BUF;
#pragma unroll
        for (int i = 0; i < 2; ++i) { const int id = tid + NTHREADS * i;
            { const int r = id >> 4; *(LAS u32x4*)(base + r * ATT_KROW + (((id & 15) ^ ((r & 3) + 4 * ((r >> 3) & 3))) << 4)) = kreg[i]; }
            { const int v = id >> 3; *(LAS u32x4*)(base + ATT_KBYTES + v * ATT_VROW + (((id & 7) ^ ((v >> 1) & 7)) << 4)) = vreg[i]; } } };
    load_tile(0); store_tile(0);
    __syncthreads();
    if (ntiles > 1) load_tile(1);
#if defined(ATT_ABL) && ATT_ABL == 4
    if (ntiles > 1) store_tile(1);
    __syncthreads();
#endif
    const int qlo = q0 + 16 * wave;
    const int krow_base = (8 * (r16 >> 2) + (r16 & 3)) * ATT_KROW;
    int koff[4], voff[2];
#pragma unroll
    for (int kk = 0; kk < 4; ++kk) koff[kk] = krow_base + (((4 * kk + g) ^ r16) << 4);
#pragma unroll
    for (int kg = 0; kg < 2; ++kg) voff[kg] = r16 * ATT_VROW + (((4 * kg + g) ^ (r16 >> 1)) << 4);
    for (int t = 0; t < ntiles; ++t) {
        const int k0 = key0_of(t);
        const LAS unsigned char* kb_ = lds + (t & 1) * ATT_BUF;
        const LAS unsigned char* vb_ = kb_ + ATT_KBYTES;
        bool causal, active = true; bool lane_on = true;
        if (MODE == 0) { causal = (k0 + 63 > qlo); active = (k0 <= qlo + 15); }
        else if (t < nown) { causal = true; active = (k0 <= qlo + 15); }
        else { causal = false; const int n = (t - nown) >> 2; lane_on = (sel >> n) & 1u; active = __any(lane_on); }
#if defined(ATT_ABL) && ATT_ABL == 3
        active = false;
#endif
        if (active) {
#pragma unroll
            for (int c = 0; c < NC; ++c) {
                f32x4 s[2][2];
#pragma unroll
                for (int kg = 0; kg < 2; ++kg)
#pragma unroll
                    for (int kb = 0; kb < 2; ++kb) {
                        f32x4 a = (f32x4){0.f, 0.f, 0.f, 0.f};
                        const LAS unsigned char* kr = kb_ + (32 * kg + 4 * kb) * ATT_KROW;
#pragma unroll
                        for (int ks = 0; ks < (MODE == 0 ? 2 : 4); ++ks) { const int kk = (MODE == 0) ? 2 * c + ks : ks;
                            a = mfma16(*(const LAS bf16x8*)(kr + koff[kk]), qf[kk], a); }
                        s[kg][kb] = a;
                    }
                if (causal) {
#pragma unroll
                    for (int kg = 0; kg < 2; ++kg)
#pragma unroll
                        for (int kb = 0; kb < 2; ++kb)
#pragma unroll
                            for (int e = 0; e < 4; ++e) if (k0 + 32 * kg + 8 * g + 4 * kb + e > qpos) s[kg][kb][e] = -INFINITY;
                }
                if (MODE == 1 && !lane_on) {
#pragma unroll
                    for (int kg = 0; kg < 2; ++kg)
#pragma unroll
                        for (int kb = 0; kb < 2; ++kb) s[kg][kb] = (f32x4){-INFINITY, -INFINITY, -INFINITY, -INFINITY};
                }
                float tm = -INFINITY;
#pragma unroll
                for (int kg = 0; kg < 2; ++kg)
#pragma unroll
                    for (int kb = 0; kb < 2; ++kb) tm = fmaxf(tm, fmaxf(fmaxf(s[kg][kb][0], s[kg][kb][1]), fmaxf(s[kg][kb][2], s[kg][kb][3])));
                if (__any((tm - mrun[c]) * CS > 6.0f)) {
                    tm = fmaxf(tm, __shfl_xor(tm, 16)); tm = fmaxf(tm, __shfl_xor(tm, 32));
                    const float mn = fmaxf(mrun[c], tm);
                    const float alpha = __builtin_amdgcn_exp2f((mrun[c] - mn) * CS);
                    mrun[c] = mn; lsum[c] *= alpha;
#pragma unroll
                    for (int vb = 0; vb < 8; ++vb) O[c][vb] *= alpha;
                }
                const float mc = mrun[c] * CS;
                f32x4 psv = (f32x4){0.f, 0.f, 0.f, 0.f};
                bf16x8 pk[2];
#pragma unroll
                for (int kg = 0; kg < 2; ++kg) {
                    float pe[8];
#pragma unroll
                    for (int kb = 0; kb < 2; ++kb) { const f32x4 t4 = s[kg][kb] * CS - mc; f32x4 p4;
#pragma unroll
#if defined(ATT_ABL) && ATT_ABL == 2
                        for (int e = 0; e < 4; ++e) { p4[e] = t4[e]; pe[4 * kb + e] = p4[e]; }
#else
                        for (int e = 0; e < 4; ++e) { p4[e] = __builtin_amdgcn_exp2f(t4[e]); pe[4 * kb + e] = p4[e]; }
#endif
                        psv += p4; }
                    pk[kg] = __builtin_bit_cast(bf16x8, pack8(pe));
                }
                lsum[c] += (psv[0] + psv[1]) + (psv[2] + psv[3]);
#if defined(ATT_ABL) && ATT_ABL == 1
                asm volatile("" :: "v"(pk[0]), "v"(pk[1]));
#else
#pragma unroll
                for (int vb = 0; vb < 8; ++vb) {
#pragma unroll
                    for (int kg = 0; kg < 2; ++kg)
                        O[c][vb] = mfma16(*(const LAS bf16x8*)(vb_ + 16 * vb * ATT_VROW + voff[kg]), pk[kg], O[c][vb]); }
#endif
#ifndef ATT_NO_SCHED_BAR
                __builtin_amdgcn_sched_barrier(0);
#endif
            }
        }
#if !(defined(ATT_ABL) && ATT_ABL == 4)
        if (t + 1 < ntiles) store_tile((t + 1) & 1);
        if (t + 2 < ntiles) load_tile(t + 2);
        __syncthreads();
#endif
    }
#if defined(ATT_ABL) && ATT_ABL == 4
    __syncthreads();
#endif
    float linv[NC];
#pragma unroll
    for (int c = 0; c < NC; ++c) { float l = lsum[c]; l += __shfl_xor(l, 16); l += __shfl_xor(l, 32); linv[c] = 1.f / l;
#if defined(ATT_ABL) && ATT_ABL == 3
        linv[c] = 1.f;
#endif
    }
    if (MODE == 0) {
        const float i0 = linv[0], i1 = lam * linv[1];
        float ss = 0.f; f32x4 y[8];
#pragma unroll
        for (int vb = 0; vb < 8; ++vb) { y[vb] = O[0][vb] * i0 - O[NC - 1][vb] * i1; ss += (y[vb][0] * y[vb][0] + y[vb][1] * y[vb][1]) + (y[vb][2] * y[vb][2] + y[vb][3] * y[vb][3]); }
        ss += __shfl_xor(ss, 16); ss += __shfl_xor(ss, 32);
        const float r = rsqrtf(ss * (1.f / 128.f) + EPS) * 0.8f;
#pragma unroll
        for (int vb = 0; vb < 8; ++vb) { const f32x4 gv = *(const f32x4*)(gvec + 16 * vb + 4 * g); const f32x4 o = y[vb] * r * gv;
            u32x2 w; w.x = pk_bf16(o[0], o[1]); w.y = pk_bf16(o[2], o[3]);
            *(u32x2*)(outp + (size_t)qpos * DM + 16 * vb + 4 * g) = w; }
    } else {
#pragma unroll
        for (int vb = 0; vb < 8; ++vb) { const f32x4 o = O[0][vb] * linv[0];
            u32x2 w; w.x = pk_bf16(o[0], o[1]); w.y = pk_bf16(o[2], o[3]);
            *(u32x2*)(outp + (size_t)qpos * DM + 16 * vb + 4 * g) = w; }
    }
}

__device__ __forceinline__ void mlstm_scan(const Params& p, int idx) {
    unsigned char* ws = p.ws;
    const int bh = idx >> 12, ch = idx & 4095;
    const float* chs = (const float*)(ws + WS_CHS) + (size_t)bh * 64;
    const bf16_t* Cl = (const bf16_t*)(ws + WS_CLOC) + (size_t)bh * 32 * 32768 + (size_t)ch * 8;
    bf16_t* Cp = (bf16_t*)(ws + WS_CPREV) + (size_t)bh * 32 * 32768 + (size_t)ch * 8;
    const bool do_n = ch < 16;
    const float* nl = (const float*)(ws + WS_NLOC) + (size_t)bh * 32 * 128 + ch * 8;
    float* np = (float*)(ws + WS_NPREV) + (size_t)bh * 32 * 128 + ch * 8;
    float st[8], nst[8];
#pragma unroll
    for (int e = 0; e < 8; ++e) { st[e] = 0.f; nst[e] = 0.f; }
    float m = 0.f;
#pragma unroll 8
    for (int c = 0; c < 32; ++c) {
        const u32x4 cl = *(const u32x4*)(Cl + (size_t)c * 32768);
        *(u32x4*)(Cp + (size_t)c * 32768) = pack8(st);
        if (do_n) { *(f32x4*)(np + c * 128) = (f32x4){nst[0], nst[1], nst[2], nst[3]}; *(f32x4*)(np + c * 128 + 4) = (f32x4){nst[4], nst[5], nst[6], nst[7]}; }
        if (ch == 0) ((float*)(ws + WS_MPREV))[bh * 32 + c] = m;
        const float gc = chs[2 * c], ml = chs[2 * c + 1];
        const float mn = fmaxf(gc + m, ml), a = __expf(gc + m - mn), b = __expf(ml - mn);
        float f[8]; unpack8(cl, f);
#pragma unroll
        for (int e = 0; e < 8; ++e) st[e] = a * st[e] + b * f[e];
        if (do_n) { const f32x4 n0 = *(const f32x4*)(nl + c * 128), n1 = *(const f32x4*)(nl + c * 128 + 4);
#pragma unroll
            for (int e = 0; e < 4; ++e) { nst[e] = a * nst[e] + b * n0[e]; nst[4 + e] = a * nst[4 + e] + b * n1[e]; } }
        m = mn;
    }
}

__device__ __forceinline__ int swz256(int row, int ch) { return row * 256 + ((ch ^ (row & 15)) << 4); }
__device__ __forceinline__ void mlstm_out_unit(const Params& p, LAS unsigned char* lds, int unit, int tid, int lane, int wave) {
    const int c = unit & 31, h = (unit >> 5) & 3, b = unit >> 7, bh = b * 4 + h;
    unsigned char* ws = p.ws;
    LAS unsigned char* Cp = lds;
    LAS unsigned char* Vt = lds + 65536;
    LAS float* sc = (LAS float*)(lds + 131072);
    const int s0 = c * 128;
    if (wave == 0) {
        float mp = ((const float*)(ws + WS_MPREV))[bh * 32 + c];
        if (lane == 0) sc[544] = mp;
        const float* lf = (const float*)(ws + WS_LF) + (size_t)bh * SEQ + s0;
        const float* li = (const float*)(ws + WS_LI) + (size_t)bh * SEQ + s0;
        const float e0 = lf[2 * lane], e1 = lf[2 * lane + 1];
        float incl = e0 + e1;
#pragma unroll
        for (int o = 1; o < 64; o <<= 1) { const float t = __shfl_up(incl, o); if (lane >= o) incl += t; }
        const float b0 = incl - e1, b1 = incl;
        const float u0 = li[2 * lane] - b0, u1 = li[2 * lane + 1] - b1;
        float cm = fmaxf(u0, u1);
#pragma unroll
        for (int o = 1; o < 64; o <<= 1) { const float t = __shfl_up(cm, o); if (lane >= o) cm = fmaxf(cm, t); }
        float pm = __shfl_up(cm, 1); if (lane == 0) pm = -INFINITY;
        sc[160 + 2 * lane] = b0; sc[160 + 2 * lane + 1] = b1;
        sc[288 + 2 * lane] = u0; sc[288 + 2 * lane + 1] = u1;
        sc[416 + 2 * lane] = fmaxf(mp, fmaxf(pm, u0)); sc[416 + 2 * lane + 1] = fmaxf(mp, cm);
    }
    __syncthreads();
    {
        if (c > 0) {
            const bf16_t* Cpg = (const bf16_t*)(ws + WS_CPREV) + (size_t)(bh * 32 + c) * 32768;
#pragma unroll
            for (int i = 0; i < 8; ++i) { const int id = tid + NTHREADS * i; *(LAS u32x4*)(Cp + swz256(id >> 4, id & 15)) = *(const u32x4*)(Cpg + (size_t)id * 8); }
            if (tid < 128) sc[32 + tid] = ((const float*)(ws + WS_NPREV))[(size_t)(bh * 32 + c) * 128 + tid];
        }
        const bf16_t* Vtm = (const bf16_t*)(ws + WS_VTM) + ((size_t)bh * 256) * SEQ + s0;
#pragma unroll
        for (int i = 0; i < 8; ++i) { const int id = tid + NTHREADS * i, v = id >> 4, ch = id & 15;
            *(LAS u32x4*)(Vt + swz256(v, ch)) = *(const u32x4*)(Vtm + (size_t)v * SEQ + ch * 8); }
    }
    __syncthreads();
    const int r16 = lane & 15, g = lane >> 4;
    const int tl = 16 * wave + r16;
    const float mprev = sc[544], Mt = sc[416 + tl], bc = sc[160 + tl];
    const float winter = __expf(mprev - Mt);
    const bf16_t* Qm = (const bf16_t*)(ws + WS_QM) + ((size_t)bh * SEQ + s0) * 128;
    const bf16_t* Km = (const bf16_t*)(ws + WS_KM) + ((size_t)bh * SEQ + s0) * 128;
    bf16x8 qf[4];
#pragma unroll
    for (int ks = 0; ks < 4; ++ks) qf[ks] = *(const bf16x8*)(Qm + (size_t)tl * 128 + 32 * ks + 8 * g);
    f32x4 acc[16];
#pragma unroll
    for (int vb = 0; vb < 16; ++vb) acc[vb] = (f32x4){0.f, 0.f, 0.f, 0.f};
    float den = 0.f;
    if (c > 0) {
#pragma unroll
        for (int vb = 0; vb < 16; ++vb) {
#pragma unroll
            for (int ks = 0; ks < 4; ++ks) acc[vb] = mfma16(*(const LAS bf16x8*)(Cp + swz256(16 * vb + r16, 4 * ks + g)), qf[ks], acc[vb]);
            acc[vb] *= winter;
        }
        float qn = 0.f;
#pragma unroll
        for (int ks = 0; ks < 4; ++ks) { float f[8]; unpack8(__builtin_bit_cast(u32x4, qf[ks]), f);
#pragma unroll
            for (int e = 0; e < 8; ++e) qn += f[e] * sc[32 + 32 * ks + 8 * g + e]; }
        qn += __shfl_xor(qn, 16); qn += __shfl_xor(qn, 32);
        den = winter * qn * 0.25f;
    }
    const int nsb = (wave >> 1) + 1;
    for (int sb = 0; sb < nsb; ++sb) {
        f32x4 sv[2];
#pragma unroll
        for (int kb = 0; kb < 2; ++kb) {
            f32x4 a = (f32x4){0.f, 0.f, 0.f, 0.f};
            const bf16_t* kr = Km + (size_t)(32 * sb + 8 * (r16 >> 2) + 4 * kb + (r16 & 3)) * 128 + 8 * g;
#pragma unroll
            for (int ks = 0; ks < 4; ++ks) a = mfma16(*(const bf16x8*)(kr + 32 * ks), qf[ks], a);
            sv[kb] = a;
        }
        float pe[8];
#pragma unroll
        for (int kb = 0; kb < 2; ++kb)
#pragma unroll
            for (int e = 0; e < 4; ++e) { const int s = 32 * sb + 8 * g + 4 * kb + e;
                const float w = (s <= tl) ? __expf(sc[288 + s] - Mt) : 0.f; const float x = sv[kb][e] * w; pe[4 * kb + e] = x; den += x; }
        const bf16x8 pf = __builtin_bit_cast(bf16x8, pack8(pe));
#pragma unroll
        for (int vb = 0; vb < 16; ++vb) acc[vb] = mfma16(*(const LAS bf16x8*)(Vt + swz256(16 * vb + r16, 4 * sb + g)), pf, acc[vb]);
    }
    den += __shfl_xor(den, 16); den += __shfl_xor(den, 32);
    const float dinv = 1.f / fmaxf(fabsf(den), __expf(-(bc + Mt)));
    float ss = 0.f;
#pragma unroll
    for (int vb = 0; vb < 16; ++vb) { acc[vb] *= dinv; ss += (acc[vb][0] * acc[vb][0] + acc[vb][1] * acc[vb][1]) + (acc[vb][2] * acc[vb][2] + acc[vb][3] * acc[vb][3]); }
    ss += __shfl_xor(ss, 16); ss += __shfl_xor(ss, 32);
    const float r = rsqrtf(ss * (1.f / 256.f) + EPS);
    const size_t trow = (size_t)b * SEQ + s0 + tl;
    const bf16_t* ao = (const bf16_t*)(ws + WS_PROJ) + trow * EVEN_IN + 2048 + h * 256;
    bf16_t* outp = (bf16_t*)(ws + WS_CAT) + trow * DM + h * 256;
    const float* hg = p.in[12] + h * 256;
#pragma unroll
    for (int vb = 0; vb < 16; ++vb) { const int v = 16 * vb + 4 * g;
        const u32x2 aw = *(const u32x2*)(ao + v); const f32x4 gv = *(const f32x4*)(hg + v);
        const float o0 = acc[vb][0] * r * gv[0] * sigmoidf_(bf_lo(aw.x)), o1 = acc[vb][1] * r * gv[1] * sigmoidf_(bf_hi(aw.x));
        const float o2 = acc[vb][2] * r * gv[2] * sigmoidf_(bf_lo(aw.y)), o3 = acc[vb][3] * r * gv[3] * sigmoidf_(bf_hi(aw.y));
        u32x2 w; w.x = pk_bf16(o0, o1); w.y = pk_bf16(o2, o3); *(u32x2*)(outp + v) = w; }
    __syncthreads();
}
__device__ __forceinline__ void moba_post_item(const Params& p, LAS unsigned char* lds, int item, int tid) {
    const int blk = item & 15, h = (item >> 4) & 7, b = item >> 7;
    bf16_t* proj = (bf16_t*)(p.ws + WS_PROJ);
    const float* tab = (const float*)(p.ws + WS_ROPE);
    const size_t row0 = (size_t)b * SEQ + blk * 256;
    {
        const int dc = tid & 15, tg = tid >> 4;
        float a[8];
#pragma unroll
        for (int e = 0; e < 8; ++e) a[e] = 0.f;
        for (int tt = 0; tt < 8; ++tt) {
            const size_t row = row0 + tg * 8 + tt;
            const bf16_t* kp = proj + row * ODD_IN + 1024 + h * 128;
            float x[8]; unpack8(*(const u32x4*)(kp + dc * 8), x);
            if (dc < 4) {
                float y[8]; unpack8(*(const u32x4*)(kp + (dc ^ 2) * 8), y);
                const float* tb = tab + row * 48 + 16 + 16 * (dc & 1);
#pragma unroll
                for (int e = 0; e < 8; ++e) { const float cs = tb[2 * e], sn = tb[2 * e + 1];
                    x[e] = (dc < 2) ? (x[e] * cs - y[e] * sn) : (x[e] * cs + y[e] * sn); }
            }
#pragma unroll
            for (int e = 0; e < 8; ++e) a[e] += x[e];
        }
        LAS float* part = (LAS float*)lds;
#pragma unroll
        for (int e = 0; e < 8; ++e) part[tg * 128 + dc * 8 + e] = a[e];
        __syncthreads();
        if (tid < 128) { float s = 0.f;
#pragma unroll 8
            for (int i = 0; i < 32; ++i) s += part[i * 128 + tid];
            ((float*)(p.ws + WS_KMEAN))[((size_t)(b * 8 + h) * 16 + blk) * 128 + tid] = s * (1.f / 256.f); }
        __syncthreads();
    }
    {
        const int tok = tid >> 1, qk = tid & 1;
        bf16_t* ptr = proj + (row0 + tok) * ODD_IN + qk * 1024 + h * 128;
        float x1[16], x2[16], o1[16], o2[16];
        unpack8(*(const u32x4*)ptr, x1); unpack8(*(const u32x4*)(ptr + 8), x1 + 8); unpack8(*(const u32x4*)(ptr + 16), x2); unpack8(*(const u32x4*)(ptr + 24), x2 + 8);
        const float* tb = tab + (row0 + tok) * 48 + 16;
#pragma unroll
        for (int e = 0; e < 16; ++e) { const float cs = tb[2 * e], sn = tb[2 * e + 1]; o1[e] = x1[e] * cs - x2[e] * sn; o2[e] = x2[e] * cs + x1[e] * sn; }
        *(u32x4*)ptr = pack8(o1); *(u32x4*)(ptr + 8) = pack8(o1 + 8); *(u32x4*)(ptr + 16) = pack8(o2); *(u32x4*)(ptr + 24) = pack8(o2 + 8);
    }
}

__device__ __forceinline__ void sgu_unit(const Params& p, LAS unsigned char* lds, int unit, int tid, int lane, int wave) {
    const int gq = unit & 7, c = (unit >> 3) & 31, b = unit >> 8;
    const bf16_t* proj = (const bf16_t*)(p.ws + WS_PROJ);
    LAS unsigned char* vnT = lds;
    const size_t row0 = (size_t)b * SEQ + c * 128;
    {
        const int pt = 16 * wave + (lane >> 2), sub = lane & 3;
        const bf16_t* src = proj + (row0 + pt) * ODD_IN + 4096 + gq * 128 + sub * 32;
        float x[32];
#pragma unroll
        for (int i = 0; i < 4; ++i) unpack8(*(const u32x4*)(src + 8 * i), x + 8 * i);
        float s1 = 0.f;
#pragma unroll
        for (int e = 0; e < 32; ++e) { x[e] = gelu_tanh(x[e]); s1 += x[e]; }
        s1 += __shfl_xor(s1, 1); s1 += __shfl_xor(s1, 2);
        const float mu = s1 * (1.f / 128.f);
        float s2 = 0.f;
#pragma unroll
        for (int e = 0; e < 32; ++e) { x[e] -= mu; s2 += x[e] * x[e]; }
        s2 += __shfl_xor(s2, 1); s2 += __shfl_xor(s2, 2);
        const float r = rsqrtf(s2 * (1.f / 128.f) + EPS);
        const float* lg = p.in[17] + gq * 128 + sub * 32; const float* lb = p.in[18] + gq * 128 + sub * 32;
#pragma unroll
        for (int e = 0; e < 32; ++e) { const int d = sub * 32 + e;
            *(LAS bf16_t*)(vnT + d * 272 + ((((pt >> 3) ^ ((d >> 3) & 15)) << 4) + (pt & 7) * 2)) = f2bf(x[e] * r * lg[e] + lb[e]); }
    }
    __syncthreads();
    const int r16 = lane & 15, g = lane >> 4;
    const int prow = 16 * wave + r16;
    f32x4 acc[8];
#pragma unroll
    for (int db = 0; db < 8; ++db) acc[db] = (f32x4){0.f, 0.f, 0.f, 0.f};
    const float* W = p.in[19] + ((size_t)gq * 128 + prow) * 128;
    const int nrs = (wave >> 1) + 1;
    for (int rs = 0; rs < nrs; ++rs) {
        const int r0 = 32 * rs + 8 * g;
        const f32x4 w0 = *(const f32x4*)(W + r0), w1 = *(const f32x4*)(W + r0 + 4);
        float wf[8] = {w0[0], w0[1], w0[2], w0[3], w1[0], w1[1], w1[2], w1[3]};
#pragma unroll
        for (int e = 0; e < 8; ++e) if (r0 + e > prow) wf[e] = 0.f;
        const bf16x8 af = __builtin_bit_cast(bf16x8, pack8(wf));
#pragma unroll
        for (int db = 0; db < 8; ++db) { const int d = 16 * db + r16; acc[db] = mfma16(*(const LAS bf16x8*)(vnT + d * 272 + (((4 * rs + g) ^ ((d >> 3) & 15)) << 4)), af, acc[db]); }
    }
    bf16_t* cat = (bf16_t*)(p.ws + WS_CAT);
    {
        const float bs = p.in[20][gq * 128 + prow];
        const bf16_t* up = proj + (row0 + prow) * ODD_IN + 3072 + gq * 128 + 4 * g;
        bf16_t* op = cat + (row0 + prow) * DM + 1024 + gq * 128 + 4 * g;
#pragma unroll
        for (int db = 0; db < 8; ++db) { const u32x2 uw = *(const u32x2*)(up + 16 * db);
            u32x2 w; w.x = pk_bf16(gelu_tanh(bf_lo(uw.x)) * (acc[db][0] + bs), gelu_tanh(bf_hi(uw.x)) * (acc[db][1] + bs));
            w.y = pk_bf16(gelu_tanh(bf_lo(uw.y)) * (acc[db][2] + bs), gelu_tanh(bf_hi(uw.y)) * (acc[db][3] + bs));
            *(u32x2*)(op + 16 * db) = w; }
    }
    __syncthreads();
}

__device__ __forceinline__ void ins16(float (&val)[16], float v) {
#pragma unroll
    for (int i = 0; i < 16; ++i) { const float hi = fmaxf(val[i], v); v = fminf(val[i], v); val[i] = hi; }
}
template <int N>
__device__ __forceinline__ void bitonic_sort_desc(float (&v)[N]) {
#pragma unroll
    for (int k = 2; k <= N; k <<= 1)
#pragma unroll
        for (int j = k >> 1; j > 0; j >>= 1)
#pragma unroll
            for (int i = 0; i < N; ++i) { const int l = i ^ j;
                if (l > i) { const bool desc = ((i & k) == 0); const float a = v[i], b = v[l], hi = fmaxf(a, b), lo = fminf(a, b); v[i] = desc ? hi : lo; v[l] = desc ? lo : hi; } }
}
template <int XM>
__device__ __forceinline__ void merge_top16(float (&t)[16]) {
    float w[16];
#pragma unroll
    for (int i = 0; i < 16; ++i) w[i] = fmaxf(t[i], __shfl_xor(t[15 - i], XM));
#pragma unroll
    for (int j = 8; j > 0; j >>= 1)
#pragma unroll
        for (int i = 0; i < 16; ++i) { const int l = i ^ j; if (l > i) { const float a = w[i], b = w[l]; w[i] = fmaxf(a, b); w[l] = fminf(a, b); } }
#pragma unroll
    for (int i = 0; i < 16; ++i) t[i] = w[i];
}
template <bool LAST>
__device__ __forceinline__ void peer_tile(const Params& p, LAS unsigned char* lds, int layer, int tile, int tid, int lane, int wave) {
    unsigned char* ws = p.ws;
    LAS unsigned* eL = (LAS unsigned*)lds;
    LAS float* wL = (LAS float*)(lds + 32768);
    const int r16 = lane & 15, g = lane >> 4;
    const size_t tok0 = (size_t)tile * 64;
    {
        LAS unsigned* ctr0 = (LAS unsigned*)(lds + 114688);
        if (tid < 96) ctr0[tid] = 0u;
        LAS float* part0 = (LAS float*)(lds + 65536);
#pragma unroll
        for (int i = 0; i < 16; ++i) part0[tid + NTHREADS * i] = 0.f;
    }
    {
        const int tg = wave & 3, hs = wave >> 2;
        const bf16_t* SK = (const bf16_t*)(ws + WS_SK) + (size_t)layer * 8 * 2 * 128 * 128;
#pragma unroll 1
        for (int hh = 0; hh < 4; ++hh) {
            const int h = 4 * hs + hh;
            int r16q = r16; asm volatile("" : "+v"(r16q));
            const bf16_t* qrow = (const bf16_t*)(ws + WS_QP) + (tok0 + 16 * tg + r16q) * DM;
            float L[2][16];
#pragma unroll 1
            for (int c = 0; c < 2; ++c) {
                bf16x8 qf[4];
#pragma unroll
                for (int ks = 0; ks < 4; ++ks) qf[ks] = *(const bf16x8*)(qrow + h * 256 + c * 128 + 32 * ks + 8 * g);
                const bf16_t* skc = SK + (size_t)(h * 2 + c) * 128 * 128;
                float scv[32];
#pragma unroll
                for (int nb = 0; nb < 8; ++nb) {
                    f32x4 a = (f32x4){0.f, 0.f, 0.f, 0.f};
#pragma unroll
                    for (int ks = 0; ks < 4; ++ks) a = mfma16(*(const bf16x8*)(skc + (size_t)(16 * nb + r16) * 128 + 32 * ks + 8 * g), qf[ks], a);
#pragma unroll
                    for (int e = 0; e < 4; ++e) { const int n = 16 * nb + 4 * g + e;
                        scv[4 * nb + e] = __uint_as_float((__float_as_uint(a[e]) & 0xffffff80u) | (unsigned)(127 - n)); }
                }
                float Lc[16], Ld[16];
#pragma unroll
                for (int k = 0; k < 16; ++k) { Lc[k] = scv[k]; Ld[k] = scv[16 + k]; }
                bitonic_sort_desc<16>(Lc); bitonic_sort_desc<16>(Ld);
#pragma unroll
                for (int k = 0; k < 16; ++k) Lc[k] = fmaxf(Lc[k], Ld[15 - k]);
#pragma unroll
                for (int j = 8; j > 0; j >>= 1)
#pragma unroll
                    for (int i = 0; i < 16; ++i) { const int l = i ^ j; if (l > i) { const float a = Lc[i], b = Lc[l]; Lc[i] = fmaxf(a, b); Lc[l] = fminf(a, b); } }
                merge_top16<16>(Lc); merge_top16<32>(Lc);
#pragma unroll
                for (int k = 0; k < 16; ++k) { if (c == 0) L[0][k] = Lc[k]; else L[1][k] = Lc[k]; }
            }
            float top[16];
#pragma unroll
            for (int q = 0; q < 16; ++q) top[q] = -INFINITY;
            {
                int cix = 0;
#pragma unroll
                for (int i = 0; i < 16; ++i)
#pragma unroll
                    for (int jj = 0; jj < 16; ++jj)
                        if ((i + 1) * (jj + 1) <= 16) {
                            const float key = __uint_as_float((__float_as_uint(L[0][i] + L[1][jj]) & 0xffffff00u) | (unsigned)(i * 16 + jj));
                            top[cix >> 2] = ((cix & 3) == g) ? key : top[cix >> 2];
                            ++cix;
                        }
            }
            bitonic_sort_desc<16>(top); merge_top16<16>(top); merge_top16<32>(top);
            const float mx = top[0]; float e16[16]; float se = 0.f;
#pragma unroll
            for (int k = 0; k < 16; ++k) { e16[k] = __expf(top[k] - mx); se += e16[k]; }
            const float inv = 1.f / se;
            LAS unsigned char* ixb = (LAS unsigned char*)(lds + 98304 + wave * 2048) + lane;
#pragma unroll
            for (int q = 0; q < 16; ++q) { ixb[q * 64] = (unsigned char)(127u - (__float_as_uint(L[0][q]) & 127u)); ixb[(16 + q) * 64] = (unsigned char)(127u - (__float_as_uint(L[1][q]) & 127u)); }
#pragma unroll
            for (int k = 0; k < 16; ++k) {
                const unsigned id = __float_as_uint(top[k]) & 0xffu; const unsigned ii = id >> 4, jj = id & 15u;
                const unsigned ex = (unsigned)ixb[ii * 64] * 128u + (unsigned)ixb[(16 + jj) * 64];
                if (g == 0) { eL[(16 * tg + r16) * 128 + h * 16 + k] = ex; wL[(16 * tg + r16) * 128 + h * 16 + k] = e16[k] * inv; }
            }
        }
    }
    __syncthreads();
#ifdef PEER_STAMP
    if (layer == 0) { PEER_STAMP; }
#endif
    { unsigned z2 = 0; asm volatile("" : "+s"(z2)); lane = (int)__builtin_amdgcn_mbcnt_hi(~0u, __builtin_amdgcn_mbcnt_lo(~0u, z2)); }
    const int g8 = lane >> 3, j8 = lane & 7;
    const bool b0 = lane & 1, b1 = (lane >> 1) & 1, b2 = (lane >> 2) & 1;
    LAS float* part = (LAS float*)(lds + 65536);
    const unsigned char* U8 = ws + WS_U + (size_t)layer * 16384 * 1024;
    LAS unsigned* ctr = (LAS unsigned*)(lds + 114688);
    LAS unsigned* done = ctr + 32;
#define PEER_GRAB(which_) ({ unsigned v_ = 0u; if (lane == 0) v_ = __hip_atomic_fetch_add(ctr + (which_), 1u, __ATOMIC_RELAXED, __HIP_MEMORY_SCOPE_WORKGROUP); (int)__builtin_amdgcn_readfirstlane(v_); })
#define PEER_ISSUE(dst, base, jo_, tl_, hf_, gq) do { _Pragma("unroll") for (int bb = 0; bb < 8; ++bb) { const unsigned ex_ = eL[(tl_) * 128 + 64 * (hf_) + 8 * bb + (gq)]; \
        dst[bb] = *(const GAS u32x4*)((base) + (unsigned)(ex_ * 128u + (jo_))); } } while (0)
#define PEER_CVT4(w_, k_) __builtin_amdgcn_cvt_scalef32_pk_f32_fp4((unsigned)(w_), 1.0f, k_)
#define PEER_UDOT(src, hf_) do { float pd[8]; \
        _Pragma("unroll") for (int bb = 0; bb < 8; ++bb) { int aL = 0, aH = 0; asm volatile("" : "+v"(src[bb])); \
            _Pragma("unroll") for (int d = 0; d < 4; ++d) { const int w = (int)src[bb][d]; \
                aL = __builtin_amdgcn_sdot4(w & 0x0F0F0F0F, xw[2 * d], aL, false); aH = __builtin_amdgcn_sdot4(w & (int)0xF0F0F0F0u, xw[2 * d + 1], aH, false); } \
            pd[bb] = (float)(aL * 16 + aH) * 0.0625f + cx; __builtin_amdgcn_sched_barrier(0); } \
        float r4[4], r2[2]; \
        _Pragma("unroll") for (int i = 0; i < 4; ++i) r4[i] = (b2 ? pd[4 + i] : pd[i]) + dpp_xor4(b2 ? pd[i] : pd[4 + i]); \
        _Pragma("unroll") for (int i = 0; i < 2; ++i) r2[i] = (b1 ? r4[2 + i] : r4[i]) + dpp_xor2(b1 ? r4[i] : r4[2 + i]); \
        const float r1 = (b0 ? r2[1] : r2[0]) + dpp_xor1(b0 ? r2[0] : r2[1]); \
        part[tl * 128 + 64 * (hf_) + 8 * j8 + g8] += r1; } while (0)
    {
        const GAS unsigned char* U8g = (const GAS unsigned char*)U8; const unsigned jo = 16u * (unsigned)j8;
        const GAS unsigned char* xlane = (const GAS unsigned char*)(ws + WS_HN8) + tok0 * DM + 32 * j8;
        u32x4 ua[8], ub[8], xc[2];
        int cur = PEER_GRAB(0);
        if (cur < 512) {
            PEER_ISSUE(ua, U8g + (size_t)(cur >> 6) * (16384 * 128), jo, cur & 63, 0, g8);
#pragma unroll
            for (int i = 0; i < 2; ++i) xc[i] = *(const GAS u32x4*)(xlane + (unsigned)((cur & 63) * DM + (cur >> 6) * 256 + 16 * i));
        }
#pragma unroll 1
        while (cur < 512) {
            const int cb = cur >> 6, tl = cur & 63;
            const int nxt = PEER_GRAB(0);
            const GAS unsigned char* Ucb = U8g + (size_t)cb * (16384 * 128);
            PEER_ISSUE(ub, Ucb, jo, tl, 1, g8);
            int xw[8];
#pragma unroll
            for (int i = 0; i < 2; ++i) { xw[4 * i] = (int)xc[i].x; xw[4 * i + 1] = (int)xc[i].y; xw[4 * i + 2] = (int)xc[i].z; xw[4 * i + 3] = (int)xc[i].w; }
            int sL = 0, sH = 0;
#pragma unroll
            for (int d = 0; d < 4; ++d) { sL = __builtin_amdgcn_sdot4(xw[2 * d], 0x01010101, sL, false); sH = __builtin_amdgcn_sdot4(xw[2 * d + 1], 0x01010101, sH, false); }
            const float cx = 0.5f * (float)sH - 7.5f * (float)sL;
            if (nxt < 512) {
#pragma unroll
                for (int i = 0; i < 2; ++i) xc[i] = *(const GAS u32x4*)(xlane + (unsigned)((nxt & 63) * DM + (nxt >> 6) * 256 + 16 * i)); }
            while ((int)__builtin_amdgcn_readfirstlane(((volatile LAS unsigned*)done)[tl]) != cb) __builtin_amdgcn_s_sleep(1);
            __builtin_amdgcn_sched_barrier(0);
            PEER_UDOT(ua, 0);
            if (nxt < 512) PEER_ISSUE(ua, U8g + (size_t)(nxt >> 6) * (16384 * 128), jo, nxt & 63, 0, g8);
            __builtin_amdgcn_sched_barrier(0);
            PEER_UDOT(ub, 1);
            if (lane == 0) ((volatile LAS unsigned*)done)[tl] = (unsigned)(cb + 1);
            cur = nxt;
        }
    }
    __syncthreads();
#undef PEER_UDOT
#ifdef PEER_STAMP
    if (layer == 0 && TSEL_A >= 0 && blockIdx.x == PSB && threadIdx.x == PST) ((unsigned long long*)(p.ws + (512 * 1024) + 1024))[22] = __builtin_amdgcn_s_memrealtime();
#endif
    unsigned char* wsw = ws; asm volatile("" : "+s"(wsw));
    const GAS float* SCU = (const GAS float*)(wsw + WS_SCL) + layer * 16384;
    const GAS float* SCV = (const GAS float*)(wsw + WS_SCL) + 32768 + layer * 16384;
    LAS unsigned char* wqb = (LAS unsigned char*)(lds + 115200);
    LAS float* wsc = (LAS float*)(lds + 123392);
#pragma unroll 1
    for (int tt = 0; tt < 8; ++tt) { const int tl = 8 * wave + tt;
        const float xs = ((const GAS float*)(wsw + WS_XS))[tok0 + tl];
        float wv[2];
#pragma unroll
        for (int i = 0; i < 2; ++i) { const int pk_ = tl * 128 + lane + 64 * i; const unsigned ex = eL[pk_];
            wv[i] = wL[pk_] * gelu_tanh(part[pk_] * (SCU[ex] * xs)) * SCV[ex]; }
        const float m = fmaxf(wave_max(fmaxf(fabsf(wv[0]), fabsf(wv[1]))), 1e-30f);
        const float inv = 127.f / m;
#pragma unroll
        for (int i = 0; i < 2; ++i) wqb[((tl * 2 + i) * 2 + (lane >> 5)) * 32 + (lane & 7) * 4 + ((lane >> 3) & 3)] = (unsigned char)(int)rintf(wv[i] * inv);
        if (lane == 0) wsc[tl] = m * (1.f / 127.f);
    }
    unsigned char* wsv = ws; asm volatile("" : "+s"(wsv));
    const unsigned char* V8 = wsv + WS_V + (size_t)layer * 16384 * 1024;
    bf16_t* OUTT = (bf16_t*)(wsv + WS_PROJ);
    int lane_v = lane; asm volatile("" : "+v"(lane_v));
    const int g8v = lane_v >> 3, j8v = lane_v & 7; const bool c3 = (lane_v >> 3) & 1, c4 = (lane_v >> 4) & 1, c5 = (lane_v >> 5) & 1;
#define PEER_VACC(src, hf_) do { _Pragma("unroll") for (int qd = 0; qd < 2; ++qd) { const int WQ = (int)wqw[((tl * 2 + (hf_)) * 2 + qd) * 8 + g8v]; \
            sw = __builtin_amdgcn_sdot4(WQ, 0x01010101, sw, false); \
            asm volatile("" : "+v"(src[4 * qd]), "+v"(src[4 * qd + 1]), "+v"(src[4 * qd + 2]), "+v"(src[4 * qd + 3])); \
            _Pragma("unroll") for (int d = 0; d < 4; ++d) { const unsigned r0 = src[4 * qd][d], r1 = src[4 * qd + 1][d], r2 = src[4 * qd + 2][d], r3 = src[4 * qd + 3][d]; \
                const unsigned x01 = __builtin_amdgcn_perm(r1, r0, 0x05010400u), y01 = __builtin_amdgcn_perm(r1, r0, 0x07030602u); \
                const unsigned x23 = __builtin_amdgcn_perm(r3, r2, 0x05010400u), y23 = __builtin_amdgcn_perm(r3, r2, 0x07030602u); \
                unsigned t[4]; t[0] = __builtin_amdgcn_perm(x23, x01, 0x05040100u); t[1] = __builtin_amdgcn_perm(x23, x01, 0x07060302u); \
                t[2] = __builtin_amdgcn_perm(y23, y01, 0x05040100u); t[3] = __builtin_amdgcn_perm(y23, y01, 0x07060302u); \
                _Pragma("unroll") for (int k = 0; k < 4; ++k) { \
                    acc[8 * d + k] = __builtin_amdgcn_sdot4((int)(t[k] & 0x0F0F0F0Fu), WQ, acc[8 * d + k], false); \
                    acc[8 * d + 4 + k] = __builtin_amdgcn_sdot4((int)(t[k] & 0xF0F0F0F0u), WQ, acc[8 * d + 4 + k], false); } } \
            __builtin_amdgcn_sched_barrier(0); } } while (0)
    __syncthreads();
    {
        const GAS unsigned char* V8g = (const GAS unsigned char*)V8; const unsigned jov = 16u * (unsigned)j8v;
        const LAS unsigned* wqw = (const LAS unsigned*)(lds + 115200);
        const LAS float* wscl = (const LAS float*)(lds + 123392);
        u32x4 va[8], vb[8];
        int cur = PEER_GRAB(1);
        if (cur < 512) PEER_ISSUE(va, V8g + (size_t)(cur >> 6) * (16384 * 128), jov, cur & 63, 0, g8v);
#pragma unroll 1
        while (cur < 512) {
            const int cb = cur >> 6, tl = cur & 63; const size_t tok = tok0 + tl;
            const int nxt = PEER_GRAB(1);
            PEER_ISSUE(vb, V8g + (size_t)cb * (16384 * 128), jov, tl, 1, g8v);
            int acc[32]; int sw = 0;
#pragma unroll
            for (int c = 0; c < 32; ++c) acc[c] = 0;
            __builtin_amdgcn_sched_barrier(0);
            PEER_VACC(va, 0);
            if (nxt < 512) PEER_ISSUE(va, V8g + (size_t)(nxt >> 6) * (16384 * 128), jov, nxt & 63, 0, g8v);
            __builtin_amdgcn_sched_barrier(0);
            PEER_VACC(vb, 1);
            const float wsf = wscl[tl], swf = (float)sw;
            const float cl = -7.5f * swf * wsf, ch = 0.5f * swf * wsf, wh = wsf * 0.0625f;
            float ac[32];
#pragma unroll
            for (int d = 0; d < 4; ++d)
#pragma unroll
                for (int k = 0; k < 4; ++k) { ac[8 * d + k] = (float)acc[8 * d + k] * wsf + cl; ac[8 * d + 4 + k] = (float)acc[8 * d + 4 + k] * wh + ch; }
            float q16[16], q8[8], q4[4];
#pragma unroll
            for (int i = 0; i < 16; ++i) q16[i] = swap32_add(ac[i], ac[16 + i]);
#pragma unroll
            for (int i = 0; i < 8; ++i) q8[i] = swap16_add(q16[i], q16[8 + i]);
#pragma unroll
            for (int i = 0; i < 4; ++i) q4[i] = (c3 ? q8[4 + i] : q8[i]) + dpp_xor8(c3 ? q8[i] : q8[4 + i]);
            u32x2 ow; ow.x = pk_bf16(q4[0], q4[1]); ow.y = pk_bf16(q4[2], q4[3]);
            *(GAS u32x2*)(OUTT + tok * DM + cb * 256 + 32 * j8v + 4 * g8v) = ow;
            cur = nxt;
        }
    }
#undef PEER_VACC
#undef PEER_CVT4
#undef PEER_ISSUE
#undef PEER_GRAB
#ifdef PEER_STAMP
    if (layer == 0 && TSEL_A >= 0 && blockIdx.x == PSB && threadIdx.x == PST) ((unsigned long long*)(p.ws + (512 * 1024) + 1024))[23] = __builtin_amdgcn_s_memrealtime();
#endif
    asm volatile("s_waitcnt vmcnt(0)" ::: "memory");
    __syncthreads();
    unsigned char* wse = ws; asm volatile("" : "+s"(wse));
    const GAS float* mod = (const GAS float*)(wse + WS_MOD) + (size_t)layer * 4 * 12288;
    const GAS bf16_t* OUTE = (const GAS bf16_t*)(wse + WS_PROJ);
    int lane_e = lane; asm volatile("" : "+v"(lane_e));
    const int bt = (int)(tok0 / SEQ);
    float gv2[32], av[32], sv2[32];
    {
        const GAS float* g2 = mod + (size_t)bt * 12288 + 10240 + 16 * lane_e;
        const GAS float* modn = (const GAS float*)(wse + WS_MOD) + (size_t)(LAST ? layer : layer + 1) * 4 * 12288 + (size_t)bt * 12288 + 16 * lane_e;
        const GAS float* ng = (const GAS float*)(LAST ? p.in[6] : p.in[5] + (size_t)(layer + 1) * 2 * DM) + 16 * lane_e;
#pragma unroll
        for (int j = 0; j < 2; ++j)
#pragma unroll
            for (int d = 0; d < 4; ++d) { const f32x4 a = *(const GAS f32x4*)(g2 + 1024 * j + 4 * d), g = *(const GAS f32x4*)(ng + 1024 * j + 4 * d);
                f32x4 sc = (f32x4){0.f, 0.f, 0.f, 0.f}, sh = (f32x4){0.f, 0.f, 0.f, 0.f};
                if (!LAST) { sc = *(const GAS f32x4*)(modn + 2048 + 1024 * j + 4 * d); sh = *(const GAS f32x4*)(modn + 1024 * j + 4 * d); }
#pragma unroll
                for (int e = 0; e < 4; ++e) { gv2[16 * j + 4 * d + e] = a[e]; av[16 * j + 4 * d + e] = g[e] * (1.f + sc[e]); sv2[16 * j + 4 * d + e] = sh[e]; } }
    }
#pragma unroll 1
    for (int tt = 0; tt < 8; ++tt) {
        const int tl = 8 * wave + tt; const size_t tok = tok0 + tl;
        GAS float* hrow = (GAS float*)(p.out + tok * DM + 16 * lane_e);
        GAS bf16_t* hb = (GAS bf16_t*)(wse + WS_H) + tok * DM + 16 * lane_e;
        const GAS bf16_t* orow = OUTE + tok * DM + 16 * lane_e;
        float hv[32]; float ss = 0.f;
#pragma unroll
        for (int j = 0; j < 2; ++j) {
            float of[16]; unpack8(*(const GAS u32x4*)(orow + 1024 * j), of); unpack8(*(const GAS u32x4*)(orow + 1024 * j + 8), of + 8);
            float hf[16]; unpack8(*(const GAS u32x4*)(hb + 1024 * j), hf); unpack8(*(const GAS u32x4*)(hb + 1024 * j + 8), hf + 8);
#pragma unroll
            for (int e = 0; e < 16; ++e) { const float hh = hf[e] + gv2[16 * j + e] * of[e]; hv[16 * j + e] = hh; ss += hh * hh; }
        }
        const float r = rsqrtf(wave_sum(ss) * (1.f / DM) + EPS);
        if (LAST) {
#pragma unroll
            for (int j = 0; j < 2; ++j)
#pragma unroll
                for (int d = 0; d < 4; ++d) { f32x4 o;
#pragma unroll
                    for (int e = 0; e < 4; ++e) o[e] = hv[16 * j + 4 * d + e] * r * av[16 * j + 4 * d + e];
                    *(GAS f32x4*)(hrow + 1024 * j + 4 * d) = o; }
        } else {
#pragma unroll
            for (int j = 0; j < 2; ++j) { *(GAS u32x4*)(hb + 1024 * j) = pack8(hv + 16 * j); *(GAS u32x4*)(hb + 1024 * j + 8) = pack8(hv + 16 * j + 8); }
            float mx = 0.f;
#pragma unroll
            for (int e = 0; e < 32; ++e) { hv[e] = hv[e] * r * av[e] + sv2[e]; mx = fmaxf(mx, fabsf(hv[e])); }
            mx = fmaxf(wave_max(mx), 1e-20f);
            const float inv = 127.f / mx;
            GAS unsigned char* h8 = (GAS unsigned char*)(wse + WS_HN8) + tok * DM + 16 * lane_e;
#pragma unroll
            for (int j = 0; j < 2; ++j) { u32x4 o;
                o.x = pack4_i8(hv[16 * j], hv[16 * j + 1], hv[16 * j + 2], hv[16 * j + 3], inv); o.y = pack4_i8(hv[16 * j + 4], hv[16 * j + 5], hv[16 * j + 6], hv[16 * j + 7], inv);
                o.z = pack4_i8(hv[16 * j + 8], hv[16 * j + 9], hv[16 * j + 10], hv[16 * j + 11], inv); o.w = pack4_i8(hv[16 * j + 12], hv[16 * j + 13], hv[16 * j + 14], hv[16 * j + 15], inv);
                *(GAS u32x4*)(h8 + 1024 * j) = o; }
            if (lane_e == 0) ((GAS float*)(wse + WS_XS))[tok] = mx * (1.f / 127.f);
        }
    }
#ifdef PEER_STAMP
    if (layer == 0 && TSEL_A >= 0 && blockIdx.x == PSB && threadIdx.x == PST) ((unsigned long long*)(p.ws + (512 * 1024) + 1024))[24] = __builtin_amdgcn_s_memrealtime();
    if (layer == 0 && TSEL_A >= 0 && threadIdx.x == PST) __hip_atomic_fetch_max((unsigned long long*)(p.ws + (512 * 1024) + 1024) + 25, (unsigned long long)__builtin_amdgcn_s_memrealtime(), __ATOMIC_RELAXED, __HIP_MEMORY_SCOPE_AGENT);
#endif
    __syncthreads();
}
template <class Epi>
__device__ __forceinline__ void run_gemm(LAS unsigned char* lds, const bf16_t* A, const bf16_t* Bt, int N, const Epi& E, int tid, int bid, int G) {
    pg8::Gemm gm{A, Bt, NT, N, DM, nullptr, nullptr}; pg8::StaticOrder S; S.init(NT, N, G, bid);
    pg8::gemm_phase<Epi, pg8::StaticOrder, true, true>(lds, gm, S, E, tid);
}
template <class Epi>
__device__ __forceinline__ void run_gemm_i8(LAS unsigned char* lds, const unsigned char* A8, const unsigned char* Bt8, int N, const float* sa, const float* sw, const Epi& E, int tid, int bid, int G) {
    pg8::Gemm gm{(const bf16_t*)A8, (const bf16_t*)Bt8, NT, N, DM / 2, sa, sw}; pg8::StaticOrder S; S.init(NT, N, G, bid);
    pg8::gemm_phase<Epi, pg8::StaticOrder, true, true, true>(lds, gm, S, E, tid);
}


typedef __attribute__((address_space(4))) const unsigned char* karg_t;
__device__ __forceinline__ Params load_params() {
    int z; asm volatile("s_mov_b32 %0, 0" : "=s"(z));
    karg_t ka = (karg_t)__builtin_amdgcn_kernarg_segment_ptr() + z;
    Params q;
#pragma unroll
    for (int k = 0; k < 25; ++k) q.in[k] = *(const float* const __attribute__((address_space(4)))*)(ka + 8 * k);
    q.out = *(float* const __attribute__((address_space(4)))*)(ka + 200);
    q.ws = *(unsigned char* const __attribute__((address_space(4)))*)(ka + 208);
    q.pad = 0;
    return q;
}

constexpr size_t WS_BAR = WS_MISC + 65536;
constexpr int BAR_LDS_OFF = LDS_BYTES - 64;
#define GRID_BAR() do { const Params pb = load_params(); XcdBarrier xb; xb.bar = (unsigned*)(pb.ws + WS_BAR); xb.x = xb_xcc_id(); xb.st = (volatile LAS unsigned*)(lds + BAR_LDS_OFF); xcd_barrier(xb); } while (0)
#define STAMP(k) do { if (TSEL_A >= 0 && blockIdx.x == 0 && wave_s == 0 && __builtin_amdgcn_mbcnt_lo(~0u, 0u) == 0 && __builtin_amdgcn_mbcnt_hi(~0u, 0u) == 0) { const Params pt = load_params(); ((unsigned long long*)(pt.ws + WS_MISC + 1024))[(k)] = __builtin_amdgcn_s_memrealtime(); } } while (0)
#ifndef DUMP_STAGE
#define DUMP_STAGE 0
#endif
__device__ __forceinline__ void dump_bf16(float* out, const bf16_t* src, size_t ld) {
    for (size_t i = (size_t)blockIdx.x * NTHREADS + threadIdx.x; i < (size_t)NT * DM; i += (size_t)gridDim.x * NTHREADS) {
        const size_t t = i / DM, c = i % DM; float v = bf2f(src[t * ld + c]); if (!(v == v) || fabsf(v) > 1e30f) v = 1.0e4f; out[i] = v; }
}
__device__ __forceinline__ void dump_f32(float* out, const float* src, size_t n) {
    for (size_t i = (size_t)blockIdx.x * NTHREADS + threadIdx.x; i < (size_t)NT * DM; i += (size_t)gridDim.x * NTHREADS) out[i] = src[i % n];
}
#define DUMPF_AT(n, srcexpr, cnt) if (DUMP_STAGE == (n)) { const Params pd = load_params(); unsigned char* ws = pd.ws; dump_f32(pd.out, (const float*)(srcexpr), (cnt)); return; }
#define DUMP_AT(n, srcexpr, ld) if (DUMP_STAGE == (n)) { const Params pd = load_params(); unsigned char* ws = pd.ws; dump_bf16(pd.out, (const bf16_t*)(srcexpr), (ld)); return; }

__global__ void __launch_bounds__(NTHREADS, 2) fwd_megakernel(Params p_unused) {
    extern __shared__ __attribute__((aligned(16))) unsigned char lds_raw[];
    LAS unsigned char* lds = (LAS unsigned char*)lds_raw;
    cg::grid_group grid = cg::this_grid();
    const int wave_s = __builtin_amdgcn_readfirstlane(threadIdx.x >> 6);
    STAMP(0);
    {
        if (threadIdx.x < 16) ((volatile LAS unsigned*)(lds + BAR_LDS_OFF))[threadIdx.x] = 0u;
        if (blockIdx.x == 0) { const Params pz = load_params(); unsigned* bw = (unsigned*)(pz.ws + WS_BAR);
            for (int i = threadIdx.x; i < XCD_BAR_WORDS + 128; i += NTHREADS) __hip_atomic_store(bw + i, 0u, __ATOMIC_RELAXED, __HIP_MEMORY_SCOPE_AGENT);
            if (TSEL_A >= 0 && threadIdx.x == 0) ((unsigned long long*)(pz.ws + WS_MISC + 1024))[25] = 0ull; }
        __syncthreads();
    }
#define PHASE_BEGIN const Params p = load_params(); unsigned char* ws = p.ws; (void)ws; \
    int bid = blockIdx.x, G = gridDim.x; unsigned zq = 0; asm volatile("" : "+s"(bid), "+s"(G), "+s"(zq)); \
    int tid = (wave_s << 6) | (int)__builtin_amdgcn_mbcnt_hi(~0u, __builtin_amdgcn_mbcnt_lo(~0u, zq)); asm volatile("" : "+v"(tid)); const int lane = tid & 63, wave = wave_s; (void)lane; (void)wave; \


    { PHASE_BEGIN phase0a(p, lds, tid, lane, wave, bid, G); }
    grid.sync(); { const Params pb = load_params(); (void)xcd_barrier_post((unsigned*)(pb.ws + WS_BAR), (volatile LAS unsigned*)(lds + BAR_LDS_OFF)); } STAMP(1);
    { PHASE_BEGIN quant_weights(ws, lane, bid * 8 + wave, G * 8); phase_rows<true>(p, lds, p.in[0], p.in[5], (const float*)(ws + WS_MOD), 2048, 0, tid, lane, wave, bid, G); }
    GRID_BAR(); STAMP(2);
    DUMP_AT(1, ws + WS_HN, DM)
    DUMPF_AT(10, ws + WS_LF, 131072)
    DUMPF_AT(12, ws + WS_MOD, 98304)
    DUMP_AT(2, ws + WS_WIN0, DM)
    { PHASE_BEGIN EpiProj<0> E{(bf16_t*)(ws + WS_PROJ), EVEN_IN, (bf16_t*)(ws + WS_VTM), (bf16_t*)(ws + WS_VTD)}; run_gemm_i8(lds, ws + WS_HN8, ws + WS_W8, EVEN_IN, (const float*)(ws + WS_XS), (const float*)(ws + WS_WSC), E, tid, bid, G); }
    GRID_BAR(); STAMP(3);
    DUMP_AT(3, ws + WS_PROJ, EVEN_IN)
    DUMP_AT(4, ws + WS_PROJ + 2 * 3072, EVEN_IN)
    { PHASE_BEGIN
      for (int it = bid; it < 1024; it += G) {
        if (it < 512) mlstm_cloc_unit(p, lds, it, tid, lane, wave); else diff_post_item(p, lds, it - 512, tid);
      } }
    GRID_BAR(); STAMP(4);
    DUMP_AT(5, ws + WS_PROJ + 2 * 3072, EVEN_IN)
    DUMP_AT(6, ws + WS_CLOC, DM)
    DUMPF_AT(11, ws + WS_CHS, 1024)
    DUMPF_AT(13, ws + WS_NLOC, 65536)
    DUMP_AT(7, ws + WS_VTD, DM)
    DUMP_AT(8, ws + WS_QM, DM)
    {
        PHASE_BEGIN
        {
            for (int idx = bid * NTHREADS + tid; idx < 65536; idx += G * NTHREADS) mlstm_scan(p, idx);
            asm volatile("s_waitcnt vmcnt(0)" ::: "memory");
            __syncthreads();
            if (tid == 0) { __builtin_amdgcn_fence(__ATOMIC_RELEASE, "agent"); asm volatile("s_waitcnt vmcnt(0)" ::: "memory");
                __hip_atomic_fetch_add((unsigned*)(ws + WS_BAR) + XCD_BAR_WORDS + 64, 1u, __ATOMIC_RELAXED, __HIP_MEMORY_SCOPE_AGENT); }
        }
    }
#pragma unroll 1
    for (int st = 0; st < 3; ++st) {
        { PHASE_BEGIN if (((bid >> 3) & 3) == st) convert_tables(p, lane, bid * 8 + wave, G * 8); }
        if (st < 2) {
            PHASE_BEGIN
            const float lam = ((const float*)(ws + WS_MISC))[0];
            for (int pr = bid + st * G; pr < 512; pr += (st == 0 ? 512 : G)) {
                const int bh = pr >> 4, jj = pr & 15, b = bh >> 3, h = bh & 7;
                const bf16_t* PROJ = (const bf16_t*)(ws + WS_PROJ);
                const bf16_t* Qb = PROJ + (size_t)b * SEQ * EVEN_IN + 3072 + h * 128;
                const bf16_t* Kb = PROJ + (size_t)b * SEQ * EVEN_IN + 4096 + h * 128;
                const bf16_t* Vt = (const bf16_t*)(ws + WS_VTD) + ((size_t)bh * 128) * SEQ;
                bf16_t* outp = (bf16_t*)(ws + WS_CAT) + (size_t)b * SEQ * DM + 1024 + h * 128;
#pragma unroll 1
                for (int rep = 0; rep < 2; ++rep)
                    attn_unit<0>(lds, Qb, Kb, EVEN_IN, Vt, rep ? jj : 31 - jj, nullptr, outp, p.in[14] + h * 128, lam, tid, lane, wave);
            }
        }
    }
    STAMP(21);
    {
        PHASE_BEGIN
        if (tid == 0) {
            unsigned* cnt = (unsigned*)(ws + WS_BAR) + XCD_BAR_WORDS + 64; unsigned sp = 0;
            while (__hip_atomic_load(cnt, __ATOMIC_RELAXED, __HIP_MEMORY_SCOPE_AGENT) < (unsigned)G && ++sp < (1u << 22)) __builtin_amdgcn_s_sleep(2);
            __builtin_amdgcn_fence(__ATOMIC_ACQUIRE, "agent"); asm volatile("s_waitcnt vmcnt(0)" ::: "memory");
        }
        __syncthreads();
        for (int pr = bid; pr < 256; pr += G) {
            const int bh = pr >> 4, cc = pr & 15;
#pragma unroll 1
            for (int rep = 0; rep < 2; ++rep) mlstm_out_unit(p, lds, bh * 32 + (rep ? cc : 31 - cc), tid, lane, wave);
        }
    }
    { PHASE_BEGIN if (((bid >> 3) & 3) == 3) convert_tables(p, lane, bid * 8 + wave, G * 8); }
    GRID_BAR(); STAMP(5);
    DUMP_AT(9, ws + WS_CAT, DM)
    { PHASE_BEGIN EpiResid<true> E{p.in[0], (bf16_t*)(ws + WS_H), (const float*)(ws + WS_MOD) + 4096}; run_gemm(lds, (const bf16_t*)(ws + WS_CAT), (const bf16_t*)(ws + WS_WOUT0), DM, E, tid, bid, G); }
    GRID_BAR(); STAMP(6);
#if STOP_AFTER >= 2
    { PHASE_BEGIN phase_rows<false>(p, lds, ws + WS_H, p.in[5] + DM, (const float*)(ws + WS_MOD), 8192, 6144, tid, lane, wave, bid, G); }
    GRID_BAR(); STAMP(7);
    { PHASE_BEGIN EpiStoreBf16 E{(bf16_t*)(ws + WS_QP), DM}; run_gemm_i8(lds, ws + WS_HN8, ws + WS_W8 + (size_t)(6144 + 5120) * 2048, DM, (const float*)(ws + WS_XS), (const float*)(ws + WS_WSC) + 6144 + 5120, E, tid, bid, G); }
    GRID_BAR(); STAMP(8);
    { PHASE_BEGIN for (int tile = bid; tile < 256; tile += G) peer_tile<false>(p, lds, 0, tile, tid, lane, wave); }
    GRID_BAR(); STAMP(9);
#endif
#if STOP_AFTER >= 3
    { PHASE_BEGIN EpiProj<1> E{(bf16_t*)(ws + WS_PROJ), ODD_IN, (bf16_t*)(ws + WS_VTM), (bf16_t*)(ws + WS_VTD)}; run_gemm_i8(lds, ws + WS_HN8, ws + WS_W8 + (size_t)6144 * 2048, ODD_IN, (const float*)(ws + WS_XS), (const float*)(ws + WS_WSC) + 6144, E, tid, bid, G); }
    GRID_BAR(); STAMP(10);
    { PHASE_BEGIN
      for (int it = bid; it < 1536; it += G) {
        if (it < 512) moba_post_item(p, lds, it, tid); else sgu_unit(p, lds, it - 512, tid, lane, wave);
      } }
    GRID_BAR(); STAMP(11);
    { PHASE_BEGIN
      for (int pr = bid; pr < 512; pr += G) {
        const int bh = pr >> 4, jj = pr & 15, b = bh >> 3, h = bh & 7;
        const bf16_t* PROJ = (const bf16_t*)(ws + WS_PROJ);
        const bf16_t* Qb = PROJ + (size_t)b * SEQ * ODD_IN + h * 128;
        const bf16_t* Kb = PROJ + (size_t)b * SEQ * ODD_IN + 1024 + h * 128;
        const bf16_t* Vt = (const bf16_t*)(ws + WS_VTD) + ((size_t)bh * 128) * SEQ;
        const float* km = (const float*)(ws + WS_KMEAN) + (size_t)bh * 16 * 128;
        bf16_t* outp = (bf16_t*)(ws + WS_CAT) + (size_t)b * SEQ * DM + h * 128;
#pragma unroll 1
        for (int rep = 0; rep < 2; ++rep)
            attn_unit<1>(lds, Qb, Kb, ODD_IN, Vt, rep ? jj : 31 - jj, km, outp, nullptr, 0.f, tid, lane, wave);
      } }
    GRID_BAR(); STAMP(12);
    { PHASE_BEGIN EpiResid<false> E{(const bf16_t*)(ws + WS_H), (bf16_t*)(ws + WS_H), (const float*)(ws + WS_MOD) + 4 * 12288 + 4096}; run_gemm(lds, (const bf16_t*)(ws + WS_CAT), (const bf16_t*)(ws + WS_WOUT1), DM, E, tid, bid, G); }
    GRID_BAR(); STAMP(13);
#endif
#if STOP_AFTER >= 4
    { PHASE_BEGIN phase_rows<false>(p, lds, ws + WS_H, p.in[5] + 3 * DM, (const float*)(ws + WS_MOD) + 4 * 12288, 8192, 6144, tid, lane, wave, bid, G); }
    GRID_BAR(); STAMP(14);
    { PHASE_BEGIN EpiStoreBf16 E{(bf16_t*)(ws + WS_QP), DM}; run_gemm_i8(lds, ws + WS_HN8, ws + WS_W8 + (size_t)(6144 + 5120 + 2048) * 2048, DM, (const float*)(ws + WS_XS), (const float*)(ws + WS_WSC) + 6144 + 5120 + 2048, E, tid, bid, G); }
    GRID_BAR(); STAMP(15);
    { PHASE_BEGIN for (int tile = bid; tile < 256; tile += G) peer_tile<true>(p, lds, 1, tile, tid, lane, wave); }
    STAMP(31);
    if (TSEL_A >= 0 && blockIdx.x == 0 && wave_s == 0 && __builtin_amdgcn_mbcnt_lo(~0u, 0u) == 0 && __builtin_amdgcn_mbcnt_hi(~0u, 0u) == 0) { const Params pt = load_params(); const unsigned long long* ts = (const unsigned long long*)(pt.ws + WS_MISC + 1024);
        pt.out[0] += (float)(ts[TSEL_B] - ts[TSEL_A]) * (0.01f / TSCALE); }
#else
    {
        PHASE_BEGIN
        const int gw = bid * 8 + wave, NGW = G * 8;
        for (int m = gw; m < NT; m += NGW) {
            float* hr = p.out + (size_t)m * DM;
            f32x4 v[8]; float s = 0.f;
#pragma unroll
            for (int j = 0; j < 8; ++j) { v[j] = ((const f32x4*)hr)[lane + 64 * j]; s += (v[j][0] * v[j][0] + v[j][1] * v[j][1]) + (v[j][2] * v[j][2] + v[j][3] * v[j][3]); }
            const float r = rsqrtf(wave_sum(s) * (1.f / DM) + EPS);
#pragma unroll
            for (int j = 0; j < 8; ++j) ((f32x4*)hr)[lane + 64 * j] = v[j] * r * ((const f32x4*)p.in[6])[lane + 64 * j];
        }
    }
#endif
}

extern "C" void kernel_launch(void* const* d_in, const int* in_sizes, int n_in, void* d_out, int out_size, void* d_ws, size_t ws_size,
                              hipStream_t stream) {
    static int grid_blocks = 0;
    if (!grid_blocks) {
        int dev = 0, cus = 0, per_cu = 0;
        (void)hipGetDevice(&dev);
        (void)hipDeviceGetAttribute(&cus, hipDeviceAttributeMultiprocessorCount, dev);
        (void)hipFuncSetAttribute((const void*)fwd_megakernel, hipFuncAttributeMaxDynamicSharedMemorySize, LDS_BYTES);
        (void)hipOccupancyMaxActiveBlocksPerMultiprocessor(&per_cu, (const void*)fwd_megakernel, NTHREADS, LDS_BYTES);
        if (per_cu < 1) { fprintf(stderr, "kernel_launch: occupancy query says %d blocks per CU\n", per_cu); per_cu = 1; }
        grid_blocks = cus;
        if (n_in != 25 || ws_size < WS_END) fprintf(stderr, "kernel_launch: unexpected n_in %d or ws_size %zu (< %zu)\n", n_in, ws_size, (size_t)WS_END);
    }
    Params p{};
    for (int i = 0; i < 25 && i < n_in; ++i) p.in[i] = (const float*)d_in[i];
    p.out = (float*)d_out; p.ws = (unsigned char*)d_ws;
    void* args[] = {&p};
    hipError_t e = hipLaunchCooperativeKernel((const void*)fwd_megakernel, dim3(grid_blocks), dim3(NTHREADS), args, LDS_BYTES, stream);
    if (e != hipSuccess) fprintf(stderr, "cooperative launch failed: %s (grid %d)\n", hipGetErrorString(e), grid_blocks);
}
```

```cpp
#include <hip/hip_runtime.h>
#include <hip/hip_cooperative_groups.h>
#include <cstdio>
#include <cstdint>
namespace cg = cooperative_groups;
#ifndef STOP_AFTER
#define STOP_AFTER 99
#define DUMP_STAGE 0
#endif
#define PSB 0
#define PST 0
#define ATT_ABL 0
#define TSCALE 4.f
#ifndef TSEL_A
#define TSEL_A -1
#define TSEL_B -1
#endif
#define PEER_STAMP do { if (TSEL_A >= 0 && blockIdx.x == PSB && threadIdx.x == PST) ((unsigned long long*)(p.ws + (512 * 1024) + 1024))[20] = __builtin_amdgcn_s_memrealtime(); } while (0)
namespace pg8 {
#define PG8_LAS __attribute__((address_space(3)))
typedef unsigned short bf16_t;
typedef short bf16x8 __attribute__((ext_vector_type(8)));
typedef float f32x4 __attribute__((ext_vector_type(4)));
typedef unsigned u32x4 __attribute__((ext_vector_type(4)));
typedef int i32x4 __attribute__((ext_vector_type(4)));
constexpr int BM = 256, BK = 64, HALF = 128, HTB = HALF * BK * 2  , STAGE_BYTES = 8 * HTB, NXCD = 8, WGM = 8;

__host__ __device__ __forceinline__ int lds_byte(int r, int c) { const int st = (r >> 4) * 2 + (c >> 5), rr = r & 15, cc = c & 31, ob = rr * 64 + cc * 2; return st * 1024 + (ob ^ (((ob >> 9) & 1) << 5)); }
__host__ __device__ __forceinline__ void stage_rc(int b, int& R, int& C) { const int st = b / 1024, sb = b % 1024, swz = sb ^ (((sb >> 9) & 1) << 5); R = (st >> 1) * 16 + swz / 64; C = (st & 1) * 32 + (swz % 64) / 2; }
__host__ __device__ __forceinline__ int perm32(int rho) { const int n = rho >> 4, i = rho & 15; return 8 * (i >> 2) + 4 * n + (i & 3); }

struct Unit { int pm, pn; };
struct Gemm { const bf16_t* A; const bf16_t* Bt; int M, N, K; const float* sa; const float* sw; };

struct StaticOrder {
    int nM, nN, nwg, G, c;
    __host__ __device__ void init(int M, int N, int G_, int c_) { nM = M / BM; nN = N / BM; nwg = nM * nN; G = G_; c = c_; }
    __host__ __device__ bool next(int i, Unit& u) const {
        const long L = (long)i * G + c; if (L >= nwg) return false;
        int wgid = (int)L; { const int q = nwg / NXCD, r = nwg % NXCD, xcd = wgid % NXCD, off = wgid / NXCD; wgid = (xcd < r ? xcd * (q + 1) : r * (q + 1) + (xcd - r) * q) + off; }
        const int nig = WGM * nN, gid = wgid / nig, fm = gid * WGM, gsz = (nM - fm) < WGM ? (nM - fm) : WGM;
        u.pm = fm + ((wgid % nig) % gsz); u.pn = (wgid % nig) / gsz; return true;
    }
    __device__ __forceinline__ void a_ready(const Unit&) const {}
    __device__ __forceinline__ void done(const Unit&) const {}
};
template <class Epi, class Sched, bool ALIGN_EPI = false, bool SP2 = false, bool I8 = false>
__device__ __forceinline__ void gemm_phase(PG8_LAS unsigned char* lds, const Gemm g, const Sched& S, const Epi& E, const int tid) {
    const int wid = __builtin_amdgcn_readfirstlane(tid >> 6), lane = tid & 63, wr = wid >> 2, wc = wid & 3, fr = lane & 15, fq = lane >> 4;
    const int K = g.K, nt = K / BK;
    unsigned voffA[2], voffB[2];
#pragma unroll
    for (int i = 0; i < 2; ++i) { int R, C; stage_rc(tid * 16 + i * 8192, R, C); const int Rb = Epi::PERM ? ((R & ~31) + perm32(R & 31)) : R;
        voffA[i] = (unsigned)(R * K + C) * 2u; voffB[i] = (unsigned)(Rb * K + C) * 2u; }
    const size_t kstep = (size_t)(BK * 2);
    const size_t hstep = (size_t)HALF * K * 2;
    const size_t tstep = 2 * hstep;
    const unsigned ldsw = (unsigned)wid * 1024u;
    const int aoff = lds_byte(wr * 64 + fr, fq * 8), boff = lds_byte(wc * 32 + fr, fq * 8);
#define PG8_SA(b, h) (((b) * 2 + (h)) * HTB)
#define PG8_SB(b, h) ((4 + (b) * 2 + (h)) * HTB)
#define PG8_STAGE(bufoff, gbase, voff) do { _Pragma("unroll") for (int _i = 0; _i < 2; ++_i) \
        __builtin_amdgcn_global_load_lds((const unsigned*)((const char*)(gbase) + (voff)[_i]), (PG8_LAS unsigned*)(lds + (bufoff) + ldsw + _i * 8192), 16, 0, 0); } while (0)
#define PG8_LDA(dst, b, h) do { _Pragma("unroll") for (int m = 0; m < 4; ++m) _Pragma("unroll") for (int k = 0; k < 2; ++k) dst[m][k] = *(const PG8_LAS bf16x8*)(lds + PG8_SA(b, h) + aoff + m * 2048 + k * 1024); } while (0)
#define PG8_LDB(dst, b, h) do { _Pragma("unroll") for (int n = 0; n < 2; ++n) _Pragma("unroll") for (int k = 0; k < 2; ++k) dst[n][k] = *(const PG8_LAS bf16x8*)(lds + PG8_SB(b, h) + boff + n * 2048 + k * 1024); } while (0)
#define PG8_MMA(ai, bj, At, Bt) do { __builtin_amdgcn_s_setprio(1); _Pragma("unroll") for (int m = 0; m < 4; ++m) _Pragma("unroll") for (int n = 0; n < 2; ++n) _Pragma("unroll") for (int k = 0; k < 2; ++k) \
        { if constexpr (I8) acc[ai][bj][m][n] = __builtin_bit_cast(f32x4, __builtin_amdgcn_mfma_i32_16x16x64_i8(__builtin_bit_cast(i32x4, Bt[n][k]), __builtin_bit_cast(i32x4, At[m][k]), __builtin_bit_cast(i32x4, acc[ai][bj][m][n]), 0, 0, 0)); \
          else acc[ai][bj][m][n] = __builtin_amdgcn_mfma_f32_16x16x32_bf16(Bt[n][k], At[m][k], acc[ai][bj][m][n], 0, 0, 0); } __builtin_amdgcn_s_setprio(0); } while (0)
#define PG8_WAIT_V(n) asm volatile("s_waitcnt vmcnt(" #n ")" ::: "memory")
#define PG8_WAIT_L(n) asm volatile("s_waitcnt lgkmcnt(" #n ")" ::: "memory")
#define PG8_BAR __builtin_amdgcn_s_barrier()
#define PG8_SCHED __builtin_amdgcn_sched_barrier(0)
    Unit cur, nxt; int ui = 0;
    if (!S.next(0, cur)) return;
    f32x4 acc[2][2][4][2];
#pragma unroll
    for (int a = 0; a < 2; ++a)
#pragma unroll
        for (int b = 0; b < 2; ++b)
#pragma unroll
            for (int m = 0; m < 4; ++m)
#pragma unroll
                for (int n = 0; n < 2; ++n) acc[a][b][m][n] = (f32x4){0.f, 0.f, 0.f, 0.f};
    bf16x8 At[4][2], B0[2][2], B1[2][2];
    const char* cA = (const char*)g.A + (size_t)cur.pm * tstep; const char* cB = (const char*)g.Bt + (size_t)cur.pn * tstep;
    S.a_ready(cur);
    if constexpr (SP2) {
        PG8_STAGE(PG8_SB(0, 0), cB, voffB); PG8_STAGE(PG8_SB(0, 1), cB + hstep, voffB); PG8_STAGE(PG8_SA(0, 0), cA, voffA); PG8_STAGE(PG8_SA(0, 1), cA + hstep, voffA);
        if (wr == 1) PG8_BAR;
        PG8_WAIT_V(2); PG8_BAR;
        PG8_STAGE(PG8_SB(1, 0), cB + kstep, voffB); PG8_STAGE(PG8_SA(1, 0), cA + kstep, voffA); PG8_STAGE(PG8_SB(1, 1), cB + hstep + kstep, voffB);
        PG8_WAIT_V(6); PG8_BAR;
    } else {
        PG8_STAGE(PG8_SB(0, 0), cB, voffB); PG8_STAGE(PG8_SA(0, 0), cA, voffA); PG8_STAGE(PG8_SB(0, 1), cB + hstep, voffB); PG8_STAGE(PG8_SA(0, 1), cA + hstep, voffA);
        if (wr == 1) PG8_BAR;
        PG8_WAIT_V(4); PG8_BAR;
        PG8_STAGE(PG8_SB(1, 0), cB + kstep, voffB); PG8_STAGE(PG8_SA(1, 0), cA + kstep, voffA); PG8_STAGE(PG8_SB(1, 1), cB + hstep + kstep, voffB);
        PG8_WAIT_V(6); PG8_BAR;
    }
    for (;;) {
        const bool has_next = S.next(ui + 1, nxt);
        const char* nA = has_next ? (const char*)g.A + (size_t)nxt.pm * tstep : cA; const char* nB = has_next ? (const char*)g.Bt + (size_t)nxt.pn * tstep : cB;
        for (int t = 0; t < nt; t += 2) {
            const bool last = (t == nt - 2);
            const char* a1 = cA + (size_t)(t + 1) * kstep;
            const char* a2 = last ? nA : cA + (size_t)(t + 2) * kstep; const char* b2 = last ? nB : cB + (size_t)(t + 2) * kstep;
            const char* a3 = a2 + kstep; const char* b3 = b2 + kstep;
            if (last && has_next) S.a_ready(nxt);
            if constexpr (SP2) {
            PG8_LDB(B0, 0, 0); PG8_LDB(B1, 0, 1); PG8_SCHED; PG8_LDA(At, 0, 0); PG8_STAGE(PG8_SA(1, 1), a1 + hstep, voffA);
            PG8_WAIT_V(8); PG8_WAIT_L(0); PG8_BAR; PG8_MMA(0, 0, At, B0); PG8_MMA(0, 1, At, B1); PG8_BAR; PG8_SCHED;
            PG8_LDA(At, 0, 1); PG8_STAGE(PG8_SB(0, 0), b2, voffB); PG8_STAGE(PG8_SB(0, 1), b2 + hstep, voffB); PG8_STAGE(PG8_SA(0, 0), a2, voffA);
            PG8_WAIT_V(8); PG8_WAIT_L(0); PG8_BAR; PG8_MMA(1, 0, At, B0); PG8_MMA(1, 1, At, B1); PG8_BAR; PG8_SCHED;
            PG8_LDB(B0, 1, 0); PG8_LDB(B1, 1, 1); PG8_SCHED; PG8_LDA(At, 1, 0); PG8_STAGE(PG8_SA(0, 1), a2 + hstep, voffA);
            PG8_WAIT_V(8); PG8_WAIT_L(0); PG8_BAR; PG8_MMA(0, 0, At, B0); PG8_MMA(0, 1, At, B1); PG8_BAR; PG8_SCHED;
            PG8_LDA(At, 1, 1); PG8_STAGE(PG8_SB(1, 0), b3, voffB); PG8_STAGE(PG8_SB(1, 1), b3 + hstep, voffB); PG8_STAGE(PG8_SA(1, 0), a3, voffA);
            PG8_WAIT_V(8); PG8_WAIT_L(0); PG8_BAR; PG8_MMA(1, 0, At, B0); PG8_MMA(1, 1, At, B1); PG8_BAR; PG8_SCHED;
            } else {
            PG8_LDB(B0, 0, 0); PG8_SCHED; PG8_LDA(At, 0, 0); PG8_STAGE(PG8_SA(1, 1), a1 + hstep, voffA);
            PG8_WAIT_L(8); PG8_BAR; PG8_WAIT_L(0); PG8_MMA(0, 0, At, B0); PG8_BAR; PG8_SCHED;
            PG8_LDB(B1, 0, 1); PG8_STAGE(PG8_SB(0, 0), b2, voffB);
            PG8_BAR; PG8_WAIT_L(0); PG8_MMA(0, 1, At, B1); PG8_BAR;
            PG8_LDA(At, 0, 1); PG8_STAGE(PG8_SA(0, 0), a2, voffA);
            PG8_BAR; PG8_WAIT_L(0); PG8_MMA(1, 0, At, B0); PG8_BAR; PG8_SCHED;
            PG8_STAGE(PG8_SB(0, 1), b2 + hstep, voffB);
            PG8_WAIT_V(6); PG8_BAR; PG8_MMA(1, 1, At, B1); PG8_BAR;
            PG8_LDB(B0, 1, 0); PG8_SCHED; PG8_LDA(At, 1, 0); PG8_STAGE(PG8_SA(0, 1), a2 + hstep, voffA);
            PG8_WAIT_L(8); PG8_BAR; PG8_WAIT_L(0); PG8_MMA(0, 0, At, B0); PG8_BAR; PG8_SCHED;
            PG8_LDB(B1, 1, 1); PG8_STAGE(PG8_SB(1, 0), b3, voffB);
            PG8_BAR; PG8_WAIT_L(0); PG8_MMA(0, 1, At, B1); PG8_BAR;
            PG8_LDA(At, 1, 1); PG8_STAGE(PG8_SA(1, 0), a3, voffA);
            PG8_BAR; PG8_WAIT_L(0); PG8_MMA(1, 0, At, B0); PG8_BAR; PG8_SCHED;
            PG8_STAGE(PG8_SB(1, 1), b3 + hstep, voffB);
            PG8_WAIT_V(6); PG8_BAR; PG8_MMA(1, 1, At, B1); PG8_BAR;
            }
        }
        if constexpr (ALIGN_EPI) { if (wr == 0) PG8_BAR; }
        if constexpr (I8) {
            const float* sap = g.sa + cur.pm * 256 + wr * 64 + fr; const float* swp = g.sw + cur.pn * 256 + wc * 32 + 8 * fq;
            f32x4 cw[2][2];
#pragma unroll
            for (int b = 0; b < 2; ++b)
#pragma unroll
                for (int n = 0; n < 2; ++n) cw[b][n] = *(const f32x4*)(swp + b * 128 + 4 * n);
#pragma unroll
            for (int a = 0; a < 2; ++a)
#pragma unroll
                for (int m = 0; m < 4; ++m) { const float ra = sap[a * 128 + m * 16];
#pragma unroll
                    for (int b = 0; b < 2; ++b)
#pragma unroll
                        for (int n = 0; n < 2; ++n) acc[a][b][m][n] = __builtin_convertvector(__builtin_bit_cast(i32x4, acc[a][b][m][n]), f32x4) * ra * cw[b][n]; }
        }
        if constexpr (!Epi::AFTER_DRAIN) { E(acc, cur, wr, wc, fr, fq); S.done(cur); }
        if (!has_next) break;
#pragma unroll
        for (int a = 0; a < 2; ++a)
#pragma unroll
            for (int b = 0; b < 2; ++b)
#pragma unroll
                for (int m = 0; m < 4; ++m)
#pragma unroll
                    for (int n = 0; n < 2; ++n) acc[a][b][m][n] = (f32x4){0.f, 0.f, 0.f, 0.f};
        cur = nxt; cA = nA; cB = nB; ++ui;
        if constexpr (ALIGN_EPI) { if (wr == 1) PG8_BAR; }
    }
    PG8_WAIT_V(0);
    if constexpr (!ALIGN_EPI) { if (wr == 0) PG8_BAR; }
    PG8_BAR;
    if constexpr (Epi::AFTER_DRAIN) { E.fused(acc, cur, wr, wc, fr, fq, lds, wid, lane); S.done(cur); }
#undef PG8_SA
#undef PG8_SB
#undef PG8_STAGE
#undef PG8_LDA
#undef PG8_LDB
#undef PG8_MMA
#undef PG8_WAIT_V
#undef PG8_WAIT_L
#undef PG8_BAR
#undef PG8_SCHED
}
}
#define LAS __attribute__((address_space(3)))
#define GAS __attribute__((address_space(1)))
typedef unsigned short bf16_t;
typedef short bf16x8 __attribute__((ext_vector_type(8)));
typedef float f32x4 __attribute__((ext_vector_type(4)));
typedef unsigned u32x4 __attribute__((ext_vector_type(4)));
typedef unsigned u32x2 __attribute__((ext_vector_type(2)));

constexpr int NB = 4, SEQ = 4096, DM = 2048, NT = NB * SEQ;
constexpr int NTHREADS = 512;
constexpr int LDS_BYTES = 147456;
constexpr float EPS = 1e-6f;
constexpr int EVEN_IN_SRC = 6152, EVEN_IN = 6144, ODD_IN = 5120;

constexpr size_t MiB = 1048576;
constexpr size_t WS_MOD = 0;
constexpr size_t WS_MISC = 512 * 1024;
constexpr size_t WS_LF = 1 * MiB;
constexpr size_t WS_LI = WS_LF + 256 * 1024;
constexpr size_t WS_CHS = 2 * MiB;
constexpr size_t WS_NLOC = 2 * MiB + 512 * 1024;
constexpr size_t WS_KMEAN = 3 * MiB;
constexpr size_t WS_SCL = 3 * MiB + 512 * 1024;
constexpr size_t WS_SK = 4 * MiB;
constexpr size_t WS_ROPE = 5 * MiB;
constexpr size_t WS_WIN0 = 8 * MiB;
constexpr size_t WS_WOUT0 = 32 * MiB;
constexpr size_t WS_WIN1 = 40 * MiB;
constexpr size_t WS_WOUT1 = 60 * MiB;
constexpr size_t WS_WQ0 = 68 * MiB;
constexpr size_t WS_WQ1 = 76 * MiB;
constexpr size_t WS_U = 84 * MiB;
constexpr size_t WS_V = 212 * MiB;
constexpr size_t WS_HN8 = 148 * MiB;
constexpr size_t WS_XS = 180 * MiB;
constexpr size_t WS_W8 = 116 * MiB;
constexpr size_t WS_WSC = 181 * MiB;
constexpr size_t WS_HN = 340 * MiB;
constexpr size_t WS_PROJ = 404 * MiB;
constexpr size_t WS_CAT = 596 * MiB;
constexpr size_t WS_QP = 660 * MiB;
constexpr size_t WS_QM = 724 * MiB;
constexpr size_t WS_KM = 740 * MiB;
constexpr size_t WS_VTM = 756 * MiB;
constexpr size_t WS_CLOC = 788 * MiB;
constexpr size_t WS_VTD = 820 * MiB;
constexpr size_t WS_CPREV = 852 * MiB;
constexpr size_t WS_NPREV = 2 * MiB + 768 * 1024;
constexpr size_t WS_MPREV = 2 * MiB + 16384;
constexpr size_t WS_H = 884 * MiB;
constexpr size_t WS_END = 948 * MiB;

struct Params { const float* in[25]; float* out; unsigned char* ws; long long pad; };

__device__ __forceinline__ float bf_lo(unsigned w) { return __uint_as_float(w << 16); }
__device__ __forceinline__ float bf_hi(unsigned w) { return __uint_as_float(w & 0xffff0000u); }
__device__ __forceinline__ float bf2f(bf16_t h) { return __uint_as_float((unsigned)h << 16); }
typedef float f32x2_t __attribute__((ext_vector_type(2))); typedef __bf16 bf16x2_t __attribute__((ext_vector_type(2)));
__device__ __forceinline__ unsigned pk_bf16(float lo, float hi) { const f32x2_t v = {lo, hi}; const bf16x2_t b = __builtin_convertvector(v, bf16x2_t); return __builtin_bit_cast(unsigned, b); }
__device__ __forceinline__ bf16_t f2bf(float f) { return (bf16_t)(pk_bf16(f, 0.f) & 0xffffu); }
__device__ __forceinline__ float wave_sum(float v) {
#pragma unroll
    for (int o = 1; o < 64; o <<= 1) v += __shfl_xor(v, o);
    return v;
}
__device__ __forceinline__ float wave_max(float v) {
#pragma unroll
    for (int o = 1; o < 64; o <<= 1) v = fmaxf(v, __shfl_xor(v, o));
    return v;
}
__device__ __forceinline__ float swap32_add(float x, float y) { const auto r = __builtin_amdgcn_permlane32_swap(__float_as_uint(x), __float_as_uint(y), false, false); return __uint_as_float(r[0]) + __uint_as_float(r[1]); }
__device__ __forceinline__ float swap16_add(float x, float y) { const auto r = __builtin_amdgcn_permlane16_swap(__float_as_uint(x), __float_as_uint(y), false, false); return __uint_as_float(r[0]) + __uint_as_float(r[1]); }
__device__ __forceinline__ float dpp_xor8(float v) { return __uint_as_float(__builtin_amdgcn_update_dpp(0u, __float_as_uint(v), 0x128, 0xF, 0xF, false)); }
__device__ __forceinline__ float dpp_xor1(float v) { return __uint_as_float(__builtin_amdgcn_update_dpp(0u, __float_as_uint(v), 0xB1, 0xF, 0xF, false)); }
__device__ __forceinline__ float dpp_xor2(float v) { return __uint_as_float(__builtin_amdgcn_update_dpp(0u, __float_as_uint(v), 0x4E, 0xF, 0xF, false)); }
__device__ __forceinline__ float dpp_xor4(float v) { const unsigned t = __builtin_amdgcn_update_dpp(0u, __float_as_uint(v), 0x141, 0xF, 0xF, false);
    return __uint_as_float(__builtin_amdgcn_update_dpp(0u, t, 0x1B, 0xF, 0xF, false)); }
__device__ __forceinline__ float sigmoidf_(float a) { return 1.f / (1.f + __expf(-a)); }
__device__ __forceinline__ float gelu_tanh(float x) { const float z = 0.7978845608f * (x + 0.044715f * x * x * x); return x / (1.f + __expf(-2.f * z)); }
__device__ __forceinline__ f32x4 mfma16(bf16x8 a, bf16x8 b, f32x4 c) { return __builtin_amdgcn_mfma_f32_16x16x32_bf16(a, b, c, 0, 0, 0); }
__device__ __forceinline__ void unpack8(u32x4 w, float* f) {
    f[0] = bf_lo(w.x); f[1] = bf_hi(w.x); f[2] = bf_lo(w.y); f[3] = bf_hi(w.y); f[4] = bf_lo(w.z); f[5] = bf_hi(w.z); f[6] = bf_lo(w.w); f[7] = bf_hi(w.w);
}
__device__ __forceinline__ u32x4 pack8(const float* f) { u32x4 w; w.x = pk_bf16(f[0], f[1]); w.y = pk_bf16(f[2], f[3]); w.z = pk_bf16(f[4], f[5]); w.w = pk_bf16(f[6], f[7]); return w; }

struct EpiStoreBf16 {
    static constexpr bool PERM = true, AFTER_DRAIN = false;
    bf16_t* O; int ldc;
    __device__ __forceinline__ void operator()(const f32x4 (&acc)[2][2][4][2], const pg8::Unit& u, int wr, int wc, int fr, int fq) const {
        const int row0 = u.pm * 256 + wr * 64 + fr, col0 = u.pn * 256 + wc * 32 + 8 * fq;
#pragma unroll
        for (int ai = 0; ai < 2; ++ai)
#pragma unroll
            for (int m = 0; m < 4; ++m) { bf16_t* rowp = O + (size_t)(row0 + ai * 128 + m * 16) * ldc + col0;
#pragma unroll
                for (int bj = 0; bj < 2; ++bj) { const f32x4 v0 = acc[ai][bj][m][0], v1 = acc[ai][bj][m][1];
                    u32x4 w; w.x = pk_bf16(v0[0], v0[1]); w.y = pk_bf16(v0[2], v0[3]); w.z = pk_bf16(v1[0], v1[1]); w.w = pk_bf16(v1[2], v1[3]);
                    *(u32x4*)(rowp + bj * 128) = w; } }
    }
};
template <int LAYER>
struct EpiProj {
    static constexpr bool PERM = true, AFTER_DRAIN = false;
    bf16_t* O; int ldc; bf16_t* vta; bf16_t* vtb;
    __device__ __forceinline__ void operator()(const f32x4 (&acc)[2][2][4][2], const pg8::Unit& u, int wr, int wc, int fr, int fq) const {
        const int row0 = u.pm * 256 + wr * 64 + fr, col0 = u.pn * 256 + wc * 32 + 8 * fq;
        const bool isva = (LAYER == 0) && (u.pn >= 4 && u.pn < 8);
        const bool isvb = (LAYER == 0) ? (u.pn >= 20) : (u.pn >= 8 && u.pn < 12);
        if (!isva && !isvb) {
#pragma unroll
            for (int ai = 0; ai < 2; ++ai)
#pragma unroll
                for (int m = 0; m < 4; ++m) { bf16_t* rowp = O + (size_t)(row0 + ai * 128 + m * 16) * ldc + col0;
#pragma unroll
                    for (int bj = 0; bj < 2; ++bj) { const f32x4 v0 = acc[ai][bj][m][0], v1 = acc[ai][bj][m][1];
                        u32x4 w; w.x = pk_bf16(v0[0], v0[1]); w.y = pk_bf16(v0[2], v0[3]); w.z = pk_bf16(v1[0], v1[1]); w.w = pk_bf16(v1[2], v1[3]);
                        *(u32x4*)(rowp + bj * 128) = w; } }
        } else {
            const int b = (u.pm * 256) / SEQ, s0 = (u.pm * 256) % SEQ + wr * 64 + fr;
            const int cbase = isva ? 1024 : (LAYER == 0 ? 5120 : 2048);
            const int hv = isva ? 256 : 128, nh = isva ? 4 : 8;
            bf16_t* vt = isva ? vta : vtb;
#pragma unroll
            for (int bj = 0; bj < 2; ++bj) {
                const int cc = col0 + bj * 128 - cbase; const int h = cc / hv, v0i = cc % hv;
                bf16_t* vp = vt + ((size_t)(b * nh + h) * hv + v0i) * SEQ + s0;
#pragma unroll
                for (int ai = 0; ai < 2; ++ai)
#pragma unroll
                    for (int m = 0; m < 4; ++m) { const int so = ai * 128 + m * 16;
#pragma unroll
                        for (int n = 0; n < 2; ++n)
#pragma unroll
                            for (int e = 0; e < 4; ++e) vp[(size_t)(4 * n + e) * SEQ + so] = f2bf(acc[ai][bj][m][n][e]); }
            }
        }
    }
};
template <bool IN_F32>
struct EpiResid {
    static constexpr bool PERM = true, AFTER_DRAIN = false;
    const void* hin; bf16_t* hout; const float* gate;
    __device__ __forceinline__ void operator()(const f32x4 (&acc)[2][2][4][2], const pg8::Unit& u, int wr, int wc, int fr, int fq) const {
        const int row0 = u.pm * 256 + wr * 64 + fr, col0 = u.pn * 256 + wc * 32 + 8 * fq;
        const float* gp = gate + (size_t)((u.pm * 256) / SEQ) * 12288 + col0;
        f32x4 gv[2][2];
#pragma unroll
        for (int bj = 0; bj < 2; ++bj) { gv[bj][0] = *(const f32x4*)(gp + bj * 128); gv[bj][1] = *(const f32x4*)(gp + bj * 128 + 4); }
#pragma unroll
        for (int ai = 0; ai < 2; ++ai)
#pragma unroll
            for (int m = 0; m < 4; ++m) { const size_t off = (size_t)(row0 + ai * 128 + m * 16) * DM + col0;
#pragma unroll
                for (int bj = 0; bj < 2; ++bj) {
                    float h8[8];
                    if (IN_F32) { const f32x4 a = *(const f32x4*)((const float*)hin + off + bj * 128), c = *(const f32x4*)((const float*)hin + off + bj * 128 + 4);
                        h8[0] = a[0]; h8[1] = a[1]; h8[2] = a[2]; h8[3] = a[3]; h8[4] = c[0]; h8[5] = c[1]; h8[6] = c[2]; h8[7] = c[3]; }
                    else unpack8(*(const u32x4*)((const bf16_t*)hin + off + bj * 128), h8);
                    const f32x4 v0 = acc[ai][bj][m][0] * gv[bj][0], v1 = acc[ai][bj][m][1] * gv[bj][1];
                    u32x4 w; w.x = pk_bf16(h8[0] + v0[0], h8[1] + v0[1]); w.y = pk_bf16(h8[2] + v0[2], h8[3] + v0[3]); w.z = pk_bf16(h8[4] + v1[0], h8[5] + v1[1]); w.w = pk_bf16(h8[6] + v1[2], h8[7] + v1[3]);
                    *(u32x4*)(hout + off + bj * 128) = w; } }
    }
};

__device__ __forceinline__ void rms_mod_row(const float* src, const float* ng, const float* sc, const float* sh, bf16_t* dst, int lane, f32x4 (&v)[8]) {
    const f32x4* xr = (const f32x4*)src + lane; float s = 0.f;
#pragma unroll
    for (int j = 0; j < 8; ++j) { v[j] = xr[64 * j]; s += (v[j][0] * v[j][0] + v[j][1] * v[j][1]) + (v[j][2] * v[j][2] + v[j][3] * v[j][3]); }
    const float r = rsqrtf(wave_sum(s) * (1.f / DM) + EPS);
    u32x2* o8 = (u32x2*)dst + lane;
#pragma unroll
    for (int j = 0; j < 8; ++j) {
        const f32x4 g = ((const f32x4*)ng)[lane + 64 * j], a = ((const f32x4*)sc)[lane + 64 * j], b = ((const f32x4*)sh)[lane + 64 * j];
        v[j] = v[j] * r * g * (a + 1.f) + b;
        u32x2 w; w.x = pk_bf16(v[j][0], v[j][1]); w.y = pk_bf16(v[j][2], v[j][3]); o8[64 * j] = w;
    }
}

__device__ __forceinline__ void p0_transpose_item(const float* W, int ldw, int c0, int k0, bf16_t* WT, int n0, LAS float* scr, int lane) {
#pragma unroll 8
    for (int i = 0; i < 32; ++i) { const int kk = 2 * i + (lane >> 5); scr[kk * 33 + (lane & 31)] = W[(size_t)(k0 + kk) * ldw + c0 + (lane & 31)]; }
    asm volatile("s_waitcnt lgkmcnt(0)" ::: "memory");
    const int c = lane & 7;
#pragma unroll
    for (int j = 0; j < 4; ++j) { const int n = (lane >> 3) + 8 * j; const LAS float* s = scr + (8 * c) * 33 + n;
        u32x4 o; o.x = pk_bf16(s[0 * 33], s[1 * 33]); o.y = pk_bf16(s[2 * 33], s[3 * 33]); o.z = pk_bf16(s[4 * 33], s[5 * 33]); o.w = pk_bf16(s[6 * 33], s[7 * 33]);
        *(u32x4*)(WT + (size_t)(n0 + n) * 2048 + k0 + 8 * c) = o; }
    asm volatile("s_waitcnt lgkmcnt(0)" ::: "memory");
}

__device__ __forceinline__ unsigned p0_enc8(const f32x4 lo4, const f32x4 hi4, float c, bool) {
    unsigned w = 0u;
#pragma unroll
    for (int b = 0; b < 4; ++b) { const unsigned nl = (unsigned)__builtin_amdgcn_fmed3f(__builtin_fmaf(lo4[b], c, 8.f), 0.f, 15.5f), nh = (unsigned)__builtin_amdgcn_fmed3f(__builtin_fmaf(hi4[b], c, 8.f), 0.f, 15.5f);
        w |= (nl | ((nh ^ 8u) << 4)) << (8 * b); }
    return w;
}
__device__ __forceinline__ void convert_tables(const Params& p, int lane, int gw, int NGW) {
    unsigned char* ws = p.ws;
    float* scl = (float*)(ws + WS_SCL);
#define CT_LOAD(dst0, dst1, r_) do { const int ra_ = (r_), rb_ = ((r_) + NGW < 65536) ? (r_) + NGW : (r_); \
        const f32x4* sa_ = (const f32x4*)((ra_ < 32768 ? p.in[23] : p.in[24]) + (size_t)(ra_ & 32767) * 2048); const f32x4* sb_ = (const f32x4*)((rb_ < 32768 ? p.in[23] : p.in[24]) + (size_t)(rb_ & 32767) * 2048); \
        _Pragma("unroll") for (int j = 0; j < 8; ++j) { dst0[j] = sa_[2 * lane + (j & 1) + 128 * (j >> 1)]; dst1[j] = sb_[2 * lane + (j & 1) + 128 * (j >> 1)]; } } while (0)
    f32x4 v0[8], v1[8];
    if (gw < 65536) CT_LOAD(v0, v1, gw);
#pragma unroll 1
    for (int r = gw; r < 65536; r += 2 * NGW) {
        const int r1 = r + NGW; const bool has1 = r1 < 65536; const int rb = has1 ? r1 : r;
        unsigned char* d0 = ws + (r < 32768 ? WS_U : WS_V) + (size_t)((r >> 14) & 1) * 16384 * 1024 + (size_t)(r & 16383) * 128;
        unsigned char* d1 = ws + (rb < 32768 ? WS_U : WS_V) + (size_t)((rb >> 14) & 1) * 16384 * 1024 + (size_t)(rb & 16383) * 128;
        f32x4 n0[8], n1[8];
        const bool more = r + 2 * NGW < 65536;
        if (more) CT_LOAD(n0, n1, r + 2 * NGW);
        float a0 = 0.f, a1 = 0.f;
#pragma unroll
        for (int j = 0; j < 8; ++j) { a0 += (v0[j][0] * v0[j][0] + v0[j][1] * v0[j][1]) + (v0[j][2] * v0[j][2] + v0[j][3] * v0[j][3]);
                                      a1 += (v1[j][0] * v1[j][0] + v1[j][1] * v1[j][1]) + (v1[j][2] * v1[j][2] + v1[j][3] * v1[j][3]); }
        a0 = wave_sum(a0); a1 = wave_sum(a1);
        const bool u0 = true, u1 = true;
        const float sc0 = (a0 > 0.f) ? (u0 ? 0.3352f : 0.5f) * sqrtf(a0 * (1.f / 2048.f)) : 1.f, sc1 = (a1 > 0.f) ? (u1 ? 0.3352f : 0.5f) * sqrtf(a1 * (1.f / 2048.f)) : 1.f;
        const float c0 = 1.f / sc0, c1 = 1.f / sc1;
#pragma unroll
        for (int jj = 0; jj < 4; ++jj) { const size_t off = (size_t)(2 * jj + (lane >> 5)) * (16384 * 128) + (lane & 31) * 4;
            *(unsigned*)(d0 + off) = p0_enc8(v0[2 * jj], v0[2 * jj + 1], c0, u0);
            if (has1) *(unsigned*)(d1 + off) = p0_enc8(v1[2 * jj], v1[2 * jj + 1], c1, u1); }
        if (lane == 0) { scl[r] = sc0; if (has1) scl[r1] = sc1; }
        if (more) {
#pragma unroll
            for (int j = 0; j < 8; ++j) { v0[j] = n0[j]; v1[j] = n1[j]; } }
    }
#undef CT_LOAD
}
__device__ __forceinline__ void phase0a(const Params& p, LAS unsigned char* lds, int tid, int lane, int wave, int bid, int G) {
    unsigned char* ws = p.ws;
    const int gw = bid * 8 + wave, NGW = G * 8;
    const int gt = bid * NTHREADS + tid, NGT = G * NTHREADS;
    {
        LAS float* scr = (LAS float*)(lds + wave * 8704);
        constexpr int NB0 = 192, NB1 = 64, NB2 = 160, NB3 = 64, NB4 = 64, NB5 = 64, NBT = NB0 + NB1 + NB2 + NB3 + NB4 + NB5;
        for (int it = gw; it < 32 * NBT; it += NGW) {
            const int kb = it / NBT; int nb = it % NBT; const int k0 = kb * 64;
            if (nb < NB0) { const int n0 = nb * 32; p0_transpose_item(p.in[7], EVEN_IN_SRC, n0 + (n0 >= 3072 ? 8 : 0), k0, (bf16_t*)(ws + WS_WIN0), n0, scr, lane); continue; } nb -= NB0;
            if (nb < NB1) { p0_transpose_item(p.in[8], 2048, nb * 32, k0, (bf16_t*)(ws + WS_WOUT0), nb * 32, scr, lane); continue; } nb -= NB1;
            if (nb < NB2) { p0_transpose_item(p.in[15], ODD_IN, nb * 32, k0, (bf16_t*)(ws + WS_WIN1), nb * 32, scr, lane); continue; } nb -= NB2;
            if (nb < NB3) { p0_transpose_item(p.in[16], 2048, nb * 32, k0, (bf16_t*)(ws + WS_WOUT1), nb * 32, scr, lane); continue; } nb -= NB3;
            if (nb < NB4) { p0_transpose_item(p.in[21], 2048, nb * 32, k0, (bf16_t*)(ws + WS_WQ0), nb * 32, scr, lane); continue; } nb -= NB4;
            p0_transpose_item(p.in[21] + (size_t)2048 * 2048, 2048, nb * 32, k0, (bf16_t*)(ws + WS_WQ1), nb * 32, scr, lane);
        }
    }
    {
        const size_t k8 = (size_t)2 * 8 * 2 * 128 * 128 / 8;
        const f32x4* sk = (const f32x4*)p.in[22]; u32x4* dk = (u32x4*)(ws + WS_SK);
        for (size_t i = gt; i < k8; i += NGT) { const f32x4 a = sk[2 * i], b = sk[2 * i + 1];
            u32x4 w; w.x = pk_bf16(a[0], a[1]); w.y = pk_bf16(a[2], a[3]); w.z = pk_bf16(b[0], b[1]); w.w = pk_bf16(b[2], b[3]); dk[i] = w; }
    }
    {
        const int* pos = (const int*)p.in[2]; float* tab = (float*)(ws + WS_ROPE);
        for (int i = gt; i < NT * 24; i += NGT) {
            const int t = i / 24, j = i % 24;
            const float e = (j < 8) ? (float)j * (1.f / 8.f) : (float)(j - 8) * (1.f / 16.f);
            const float inv = exp2f(-e * 18.931568569324174f);
            const float ang = (float)pos[t] * inv;
            float sn, cs; sincosf(ang, &sn, &cs);
            tab[2 * i] = cs; tab[2 * i + 1] = sn;
        }
    }
    {
        const float* cin = p.in[1]; float* mod = (float*)(ws + WS_MOD);
        LAS float* part = (LAS float*)(lds + 73728);
        for (int it = bid; it < 192; it += G) {
            const int ng = it % 96, l = it / 96;
            const int n0 = ng * 128 + 2 * lane;
            f32x2_t acc[4];
#pragma unroll
            for (int b = 0; b < 4; ++b) acc[b] = (f32x2_t){0.f, 0.f};
#pragma unroll 1
            for (int kc = 0; kc < 4; ++kc) {
                const int k0 = wave * 256 + kc * 64;
                float ca[4];
#pragma unroll
                for (int b = 0; b < 4; ++b) { const float cv = cin[b * DM + k0 + lane]; ca[b] = cv * sigmoidf_(cv); }
                const float* wp = p.in[3] + ((size_t)l * DM + k0) * 12288 + n0;
#pragma unroll 16
                for (int kk = 0; kk < 64; ++kk) {
                    const f32x2_t w = *(const f32x2_t*)(wp + (size_t)kk * 12288);
#pragma unroll
                    for (int b = 0; b < 4; ++b) acc[b] += w * __shfl(ca[b], kk);
                }
            }
#pragma unroll
            for (int b = 0; b < 4; ++b) *(LAS f32x2_t*)(part + (wave * 4 + b) * 128 + 2 * lane) = acc[b];
            __syncthreads();
            { const int o = tid, b = o >> 7, col = o & 127;
                float sm = p.in[4][l * 12288 + ng * 128 + col];
#pragma unroll
                for (int w = 0; w < 8; ++w) sm += part[(w * 4 + b) * 128 + col];
                mod[((size_t)l * 4 + b) * 12288 + ng * 128 + col] = sm; }
            __syncthreads();
        }
    }
    if (bid == 0 && wave == 0) {
        const float* lv = p.in[13];
        const float a = wave_sum(lv[lane] * lv[64 + lane]), b = wave_sum(lv[128 + lane] * lv[192 + lane]);
        if (lane == 0) ((float*)(ws + WS_MISC))[0] = __expf(a) - __expf(b) + 0.2f;
    }
}

__device__ __forceinline__ unsigned pack4_i8(float a, float b, float c, float d, float inv) {
    return ((unsigned)(int)rintf(a * inv) & 255u) | (((unsigned)(int)rintf(b * inv) & 255u) << 8) | (((unsigned)(int)rintf(c * inv) & 255u) << 16) | ((unsigned)(int)rintf(d * inv) << 24);
}
__device__ __forceinline__ void quant_weights(unsigned char* ws, int lane, int gw, int NGW) {
    float* wsc = (float*)(ws + WS_WSC);
    for (int n = gw; n < 15360; n += NGW) {
        const bf16_t* src = (n < 6144) ? (const bf16_t*)(ws + WS_WIN0) + (size_t)n * 2048 : (n < 11264) ? (const bf16_t*)(ws + WS_WIN1) + (size_t)(n - 6144) * 2048
                          : (n < 13312) ? (const bf16_t*)(ws + WS_WQ0) + (size_t)(n - 11264) * 2048 : (const bf16_t*)(ws + WS_WQ1) + (size_t)(n - 13312) * 2048;
        u32x4 v[4];
#pragma unroll
        for (int j = 0; j < 4; ++j) v[j] = ((const u32x4*)src)[lane + 64 * j];
        float f[32]; float m = 0.f;
#pragma unroll
        for (int j = 0; j < 4; ++j) unpack8(v[j], f + 8 * j);
#pragma unroll
        for (int e = 0; e < 32; ++e) m = fmaxf(m, fabsf(f[e]));
        m = fmaxf(wave_max(m), 1e-30f);
        const float inv = 127.f / m;
        u32x2* dst = (u32x2*)(ws + WS_W8 + (size_t)n * 2048);
#pragma unroll
        for (int j = 0; j < 4; ++j) { u32x2 o; o.x = pack4_i8(f[8 * j], f[8 * j + 1], f[8 * j + 2], f[8 * j + 3], inv); o.y = pack4_i8(f[8 * j + 4], f[8 * j + 5], f[8 * j + 6], f[8 * j + 7], inv);
            dst[lane + 64 * j] = o; }
        if (lane == 0) wsc[n] = m * (1.f / 127.f);
    }
}

template <bool GATES>
__device__ __forceinline__ void phase_rows(const Params& p, LAS unsigned char* lds, const void* hsrc_, const float* ng, const float* modl  , int sc_off, int sh_off,
                                           int tid, int lane, int wave, int bid, int G) {
    unsigned char* ws = p.ws;
    LAS float* wg = (LAS float*)lds;
    if (GATES) {
        for (int i = tid; i < 8 * DM; i += NTHREADS) { const int k = i >> 3, j = i & 7; wg[j * DM + k] = p.in[7][(size_t)k * EVEN_IN_SRC + 3072 + j]; }
        __syncthreads();
    }
    float* lf = (float*)(ws + WS_LF); float* li = (float*)(ws + WS_LI);
    for (int r0 = (bid * 8 + wave) * 8; r0 < NT; r0 += G * 64) {
        const int b = r0 / SEQ;
        f32x4 av[8], bv[8];
        { const float* sc = modl + (size_t)b * 12288 + sc_off; const float* sh = modl + (size_t)b * 12288 + sh_off;
#pragma unroll
          for (int j = 0; j < 8; ++j) { av[j] = ((const f32x4*)ng)[lane + 64 * j] * (((const f32x4*)sc)[lane + 64 * j] + 1.f); bv[j] = ((const f32x4*)sh)[lane + 64 * j]; } }
#pragma unroll 1
        for (int i = 0; i < 8; i += 2) {
            f32x4 v0[8], v1[8]; float s0 = 0.f, s1 = 0.f;
            if (GATES) { const f32x4* x0 = (const f32x4*)((const float*)hsrc_ + (size_t)(r0 + i) * DM) + lane; const f32x4* x1 = x0 + DM / 4;
#pragma unroll
                for (int j = 0; j < 8; ++j) { v0[j] = x0[64 * j]; v1[j] = x1[64 * j]; } }
            else { const u32x2* x0 = (const u32x2*)((const bf16_t*)hsrc_ + (size_t)(r0 + i) * DM) + lane; const u32x2* x1 = x0 + DM / 4;
#pragma unroll
                for (int j = 0; j < 8; ++j) { const u32x2 a = x0[64 * j], c = x1[64 * j];
                    v0[j] = (f32x4){bf_lo(a.x), bf_hi(a.x), bf_lo(a.y), bf_hi(a.y)}; v1[j] = (f32x4){bf_lo(c.x), bf_hi(c.x), bf_lo(c.y), bf_hi(c.y)}; } }
#pragma unroll
            for (int j = 0; j < 8; ++j) { s0 += (v0[j][0] * v0[j][0] + v0[j][1] * v0[j][1]) + (v0[j][2] * v0[j][2] + v0[j][3] * v0[j][3]);
                                          s1 += (v1[j][0] * v1[j][0] + v1[j][1] * v1[j][1]) + (v1[j][2] * v1[j][2] + v1[j][3] * v1[j][3]); }
#pragma unroll
            for (int o = 1; o < 64; o <<= 1) { s0 += __shfl_xor(s0, o); s1 += __shfl_xor(s1, o); }
            const float q0 = rsqrtf(s0 * (1.f / DM) + EPS), q1 = rsqrtf(s1 * (1.f / DM) + EPS);
#pragma unroll
            for (int j = 0; j < 8; ++j) { v0[j] = v0[j] * q0 * av[j] + bv[j]; v1[j] = v1[j] * q1 * av[j] + bv[j]; }
            {
                float m0 = 0.f, m1 = 0.f;
#pragma unroll
                for (int j = 0; j < 8; ++j) { m0 = fmaxf(m0, fmaxf(fmaxf(fabsf(v0[j][0]), fabsf(v0[j][1])), fmaxf(fabsf(v0[j][2]), fabsf(v0[j][3]))));
                                              m1 = fmaxf(m1, fmaxf(fmaxf(fabsf(v1[j][0]), fabsf(v1[j][1])), fmaxf(fabsf(v1[j][2]), fabsf(v1[j][3])))); }
#pragma unroll
                for (int o = 1; o < 64; o <<= 1) { m0 = fmaxf(m0, __shfl_xor(m0, o)); m1 = fmaxf(m1, __shfl_xor(m1, o)); }
                m0 = fmaxf(m0, 1e-20f); m1 = fmaxf(m1, 1e-20f);
                const float i0 = 127.f / m0, i1 = 127.f / m1;
                unsigned* e0 = (unsigned*)(ws + WS_HN8 + (size_t)(r0 + i) * DM) + lane; unsigned* e1 = e0 + DM / 4;
#pragma unroll
                for (int j = 0; j < 8; ++j) {
                    const unsigned a0 = (unsigned)(int)rintf(v0[j][0] * i0) & 255u, a1 = (unsigned)(int)rintf(v0[j][1] * i0) & 255u, a2 = (unsigned)(int)rintf(v0[j][2] * i0) & 255u, a3 = (unsigned)(int)rintf(v0[j][3] * i0);
                    const unsigned c0 = (unsigned)(int)rintf(v1[j][0] * i1) & 255u, c1 = (unsigned)(int)rintf(v1[j][1] * i1) & 255u, c2 = (unsigned)(int)rintf(v1[j][2] * i1) & 255u, c3 = (unsigned)(int)rintf(v1[j][3] * i1);
                    e0[64 * j] = a0 | (a1 << 8) | (a2 << 16) | (a3 << 24); e1[64 * j] = c0 | (c1 << 8) | (c2 << 16) | (c3 << 24); }
                if (lane == 0) { float* xs = (float*)(ws + WS_XS); xs[r0 + i] = m0 * (1.f / 127.f); xs[r0 + i + 1] = m1 * (1.f / 127.f); }
            }
            if (GATES) {
#pragma unroll
                for (int rr = 0; rr < 2; ++rr) {
                    float pd[8];
#pragma unroll
                    for (int jg = 0; jg < 8; ++jg) { float a = 0.f;
#pragma unroll
                        for (int j = 0; j < 8; ++j) { const f32x4 w = *(const LAS f32x4*)(wg + jg * DM + 4 * lane + 256 * j); const f32x4 x = rr ? v1[j] : v0[j];
                            a += (x[0] * w[0] + x[1] * w[1]) + (x[2] * w[2] + x[3] * w[3]); }
                        pd[jg] = a; __builtin_amdgcn_sched_barrier(0); }
                    const bool b5 = (lane >> 5) & 1, b4 = (lane >> 4) & 1, b3 = (lane >> 3) & 1;
                    float r4[4], r2[2];
#pragma unroll
                    for (int q = 0; q < 4; ++q) r4[q] = (b5 ? pd[4 + q] : pd[q]) + __shfl_xor(b5 ? pd[q] : pd[4 + q], 32);
#pragma unroll
                    for (int q = 0; q < 2; ++q) r2[q] = (b4 ? r4[2 + q] : r4[q]) + __shfl_xor(b4 ? r4[q] : r4[2 + q], 16);
                    float g1 = (b3 ? r2[1] : r2[0]) + __shfl_xor(b3 ? r2[0] : r2[1], 8);
                    g1 += __shfl_xor(g1, 4); g1 += __shfl_xor(g1, 2); g1 += __shfl_xor(g1, 1);
                    const int jg = lane >> 3, h = jg & 3; const int m = r0 + i + rr, s = m % SEQ;
                    if ((lane & 7) == 0) {
                        const float pre = g1 + p.in[11][jg];
                        if (jg < 4) li[((size_t)b * 4 + h) * SEQ + s] = pre;
                        else lf[((size_t)b * 4 + h) * SEQ + s] = (pre >= 0.f) ? -log1pf(__expf(-pre)) : pre - log1pf(__expf(pre));
                    }
                }
            }
        }
    }
}
#define XB_TMO      128
#define XB_XCNT(j)  (256  + 64 * (j))
#define XB_XSUB(j)  (1280 + 64 * (j))
#define XB_XGEN(j)  (2304 + 64 * (j))
#define XB_TOP      3328
#define XB_TOPGEN   3392
#define XCD_BAR_WORDS 3456
#define XB_SPIN_CAP (1u << 18)

__device__ __forceinline__ unsigned xb_ld(unsigned* p)              { return __hip_atomic_load(p, __ATOMIC_RELAXED, __HIP_MEMORY_SCOPE_AGENT); }
__device__ __forceinline__ unsigned xb_add(unsigned* p, unsigned v) { return __hip_atomic_fetch_add(p, v, __ATOMIC_RELAXED, __HIP_MEMORY_SCOPE_AGENT); }
__device__ __forceinline__ unsigned xb_xcc_id() { return (unsigned)__builtin_amdgcn_s_getreg((3 << 11) | 20) & 0xFu; }
#define XB_SPIN(cond, bar) do { unsigned _sp = 0; while (cond) { __builtin_amdgcn_s_sleep(1); \
    if ((++_sp & 255u) == 0u) { if (xb_ld(&(bar)[XB_TMO])) break; if (_sp > XB_SPIN_CAP) { atomicAdd(&(bar)[XB_TMO], 1u); break; } } } } while (0)

struct XcdBarrier {
    unsigned* bar; unsigned x;
    volatile LAS unsigned* st;
};

__device__ __forceinline__ XcdBarrier xcd_barrier_post(unsigned* bar, volatile LAS unsigned* st) {
    XcdBarrier b; b.bar = bar; b.x = xb_xcc_id(); b.st = st;
    if (threadIdx.x == 0) (void)xb_add(&bar[XB_XCNT(b.x)], 1u);
    return b;
}
__device__ __forceinline__ void xcd_barrier_complete(unsigned* bar, unsigned x, unsigned& nloc, unsigned& nx) {
    const unsigned G = gridDim.x * gridDim.y * gridDim.z;
    unsigned sum, cnt, mine, sp = 0u;
    for (;;) {
        sum = 0u; cnt = 0u; mine = 0u;
#pragma unroll
        for (unsigned j = 0; j < 16; ++j) { const unsigned c = xb_ld(&bar[XB_XCNT(j)]); sum += c; cnt += (c > 0u) ? 1u : 0u; mine = (j == x) ? c : mine; }
        if (sum == G) break;
        __builtin_amdgcn_s_sleep(1);
        if ((++sp & 255u) == 0u) { if (xb_ld(&bar[XB_TMO])) break; if (sp > XB_SPIN_CAP) { atomicAdd(&bar[XB_TMO], 1u); break; } }
    }
    nloc = mine > 0u ? mine : 1u; nx = cnt > 0u ? cnt : 1u;
}

__device__ __forceinline__ void xcd_barrier(const XcdBarrier& b) {
    asm volatile("s_waitcnt vmcnt(0)" ::: "memory");
    __syncthreads();
    if (threadIdx.x == 0) {
        unsigned* bar = b.bar;
        __builtin_amdgcn_s_waitcnt(0);
        unsigned nloc = b.st[0], nx = b.st[1];
        if (nloc == 0u) { xcd_barrier_complete(bar, b.x, nloc, nx); b.st[0] = nloc; b.st[1] = nx; }
        const unsigned old = xb_add(&bar[XB_XSUB(b.x)], 1u);
        const unsigned gen = old / nloc;
        if (old + 1u == (gen + 1u) * nloc) {
            __builtin_amdgcn_fence(__ATOMIC_RELEASE, "agent");
            asm volatile("s_waitcnt vmcnt(0)" ::: "memory");
            const unsigned og = xb_add(&bar[XB_TOP], 1u);
            const unsigned tg = og / nx;
            if (og + 1u == (tg + 1u) * nx) xb_add(&bar[XB_TOPGEN], 1u);
            else XB_SPIN(xb_ld(&bar[XB_TOPGEN]) == tg, bar);
            __builtin_amdgcn_fence(__ATOMIC_ACQUIRE, "agent");
            xb_add(&bar[XB_XGEN(b.x)], 1u);
            asm volatile("s_waitcnt vmcnt(0)" ::: "memory");
        } else {
            XB_SPIN(xb_ld(&bar[XB_XGEN(b.x)]) == gen, bar);
            __builtin_amdgcn_fence(__ATOMIC_ACQUIRE, "agent");
            asm volatile("s_waitcnt vmcnt(0)" ::: "memory");
        }
    }
    __syncthreads();
}
__device__ __forceinline__ void transpose_64x128(const bf16_t* src, size_t ld_src, bf16_t* dst, size_t ld_dst, LAS unsigned char* T  , int tid) {
#pragma unroll
    for (int i = 0; i < 2; ++i) { const int id = tid + NTHREADS * i, row = id >> 4, ch = id & 15;
        const u32x4 w = *(const u32x4*)(src + (size_t)row * ld_src + ch * 8);
        LAS bf16_t* tp = (LAS bf16_t*)(T + (8 * ch) * 144 + ((((row >> 3) ^ (ch & 7)) << 4) + (row & 7) * 2));
        tp[0 * 72] = (bf16_t)(w.x & 0xffffu); tp[1 * 72] = (bf16_t)(w.x >> 16); tp[2 * 72] = (bf16_t)(w.y & 0xffffu); tp[3 * 72] = (bf16_t)(w.y >> 16);
        tp[4 * 72] = (bf16_t)(w.z & 0xffffu); tp[5 * 72] = (bf16_t)(w.z >> 16); tp[6 * 72] = (bf16_t)(w.w & 0xffffu); tp[7 * 72] = (bf16_t)(w.w >> 16); }
    __syncthreads();
#pragma unroll
    for (int i = 0; i < 2; ++i) { const int id = tid + NTHREADS * i, v = id >> 3, c = id & 7;
        *(u32x4*)(dst + (size_t)v * ld_dst + c * 8) = *(const LAS u32x4*)(T + v * 144 + ((c ^ ((v >> 3) & 7)) << 4)); }
    __syncthreads();
}

__device__ __forceinline__ void diff_post_item(const Params& p, LAS unsigned char* lds, int item, int tid) {
    const int blk = item & 15, h = (item >> 4) & 7, b = item >> 7;
    bf16_t* proj = (bf16_t*)(p.ws + WS_PROJ);
    const float* tab = (const float*)(p.ws + WS_ROPE);
    const size_t row0 = (size_t)b * SEQ + blk * 256;
#pragma unroll
    for (int i = 0; i < 2; ++i) {
        const int id = tid + NTHREADS * i, tok = id >> 2, comp = id & 1, qk = (id >> 1) & 1;
        bf16_t* ptr = proj + (row0 + tok) * EVEN_IN + (qk ? 4096 : 3072) + h * 128 + comp * 64;
        const u32x4 w1 = *(const u32x4*)ptr, w2 = *(const u32x4*)(ptr + 8);
        float x1[8], x2[8], o1[8], o2[8]; unpack8(w1, x1); unpack8(w2, x2);
        const float* tb = tab + (row0 + tok) * 48;
#pragma unroll
        for (int e = 0; e < 8; ++e) { const float cs = tb[2 * e], sn = tb[2 * e + 1]; o1[e] = x1[e] * cs - x2[e] * sn; o2[e] = x2[e] * cs + x1[e] * sn; }
        *(u32x4*)ptr = pack8(o1); *(u32x4*)(ptr + 8) = pack8(o2);
    }
    (void)lds;
}

__device__ __forceinline__ void mlstm_cloc_unit(const Params& p, LAS unsigned char* lds, int unit, int tid, int lane, int wave) {
    const int c = unit & 31, h = (unit >> 5) & 3, b = unit >> 7, bh = b * 4 + h;
    unsigned char* ws = p.ws;
    const bf16_t* proj = (const bf16_t*)(ws + WS_PROJ);
    LAS unsigned char* Kt = lds;
    LAS unsigned char* Vt = lds + 34816;
    LAS float* sc = (LAS float*)(lds + 104448);
    const int s0 = c * 128;
    const float* lf = (const float*)(ws + WS_LF) + (size_t)bh * SEQ + s0;
    const float* li = (const float*)(ws + WS_LI) + (size_t)bh * SEQ + s0;
    if (wave == 0) {
        const float e0 = lf[2 * lane], e1 = lf[2 * lane + 1];
        float incl = e0 + e1;
#pragma unroll
        for (int o = 1; o < 64; o <<= 1) { const float t = __shfl_up(incl, o); if (lane >= o) incl += t; }
        const float g = __shfl(incl, 63);
        const float b0 = incl - e1, b1 = incl;
        const float a0 = g - b0 + li[2 * lane], a1 = g - b1 + li[2 * lane + 1];
        const float ml = wave_max(fmaxf(a0, a1));
        sc[2 * lane] = __expf(a0 - ml); sc[2 * lane + 1] = __expf(a1 - ml);
        if (lane == 0) { float* chs = (float*)(ws + WS_CHS) + (size_t)(bh * 32 + c) * 2; chs[0] = g; chs[1] = ml; }
    }
    __syncthreads();
    const float* cw = p.in[9]; const float* cb = p.in[10];
    bf16_t* Qm = (bf16_t*)(ws + WS_QM) + ((size_t)bh * SEQ + s0) * 128;
    bf16_t* Km = (bf16_t*)(ws + WS_KM) + ((size_t)bh * SEQ + s0) * 128;
#pragma unroll 2
    for (int i = 0; i < 8; ++i) {
        const int id = tid + NTHREADS * (i & 3), isk = i >> 2, s = id >> 4, dc = id & 15;
        const int col = isk * 512 + h * 128 + dc * 8;
        float y[8];
        { const f32x4 b0 = *(const f32x4*)(cb + col), b1 = *(const f32x4*)(cb + col + 4);
          y[0] = b0[0]; y[1] = b0[1]; y[2] = b0[2]; y[3] = b0[3]; y[4] = b1[0]; y[5] = b1[1]; y[6] = b1[2]; y[7] = b1[3]; }
#pragma unroll
        for (int w = 0; w < 4; ++w) {
            const int ts = s0 + s - 3 + w;
            if (ts >= 0) {
                const u32x4 raw = *(const u32x4*)(proj + ((size_t)b * SEQ + ts) * EVEN_IN + col);
                float x[8]; unpack8(raw, x);
                const f32x4 w0 = *(const f32x4*)(cw + w * 1024 + col), w1 = *(const f32x4*)(cw + w * 1024 + col + 4);
                y[0] += x[0] * w0[0]; y[1] += x[1] * w0[1]; y[2] += x[2] * w0[2]; y[3] += x[3] * w0[3];
                y[4] += x[4] * w1[0]; y[5] += x[5] * w1[1]; y[6] += x[6] * w1[2]; y[7] += x[7] * w1[3];
            }
        }
#pragma unroll
        for (int e = 0; e < 8; ++e) y[e] = y[e] * sigmoidf_(y[e]);
        if (!isk) {
#pragma unroll
            for (int e = 0; e < 8; ++e) y[e] *= 0.08838834764831845f;
            *(u32x4*)(Qm + (size_t)s * 128 + dc * 8) = pack8(y);
        } else {
            *(u32x4*)(Km + (size_t)s * 128 + dc * 8) = pack8(y);
            const float wsv = sc[s];
            LAS bf16_t* kp = (LAS bf16_t*)(Kt + (dc * 8) * 272 + ((((s >> 3) ^ (dc & 7)) << 4) + (s & 7) * 2));
#pragma unroll
            for (int e = 0; e < 8; ++e) kp[e * 136] = f2bf(y[e] * wsv);
        }
    }
    {
        const bf16_t* Vtm = (const bf16_t*)(ws + WS_VTM) + ((size_t)bh * 256) * SEQ + s0;
#pragma unroll 4
        for (int i = 0; i < 8; ++i) { const int id = tid + NTHREADS * i, v = id >> 4, ch = id & 15;
            *(LAS u32x4*)(Vt + v * 272 + ((ch ^ ((v >> 3) & 15)) << 4)) = *(const u32x4*)(Vtm + (size_t)v * SEQ + ch * 8); }
    }
    __syncthreads();
    if (tid < 128) { float a = 0.f;
#pragma unroll
        for (int ch = 0; ch < 16; ++ch) { float f[8]; unpack8(*(const LAS u32x4*)(Kt + tid * 272 + ch * 16), f); a += ((f[0] + f[1]) + (f[2] + f[3])) + ((f[4] + f[5]) + (f[6] + f[7])); }
        ((float*)(ws + WS_NLOC))[(size_t)(bh * 32 + c) * 128 + tid] = a; }
    const int r16 = lane & 15, g = lane >> 4;
    f32x4 acc[8][2];
#pragma unroll
    for (int db = 0; db < 8; ++db) { acc[db][0] = (f32x4){0.f, 0.f, 0.f, 0.f}; acc[db][1] = (f32x4){0.f, 0.f, 0.f, 0.f}; }
#pragma unroll
    for (int ks = 0; ks < 4; ++ks) {
        bf16x8 vf[2];
#pragma unroll
        for (int j = 0; j < 2; ++j) { const int v = 16 * (2 * wave + j) + r16; vf[j] = *(const LAS bf16x8*)(Vt + v * 272 + (((4 * ks + g) ^ ((v >> 3) & 15)) << 4)); }
#pragma unroll
        for (int db = 0; db < 8; ++db) { const int d = 16 * db + r16; const bf16x8 kf = *(const LAS bf16x8*)(Kt + d * 272 + (((4 * ks + g) ^ ((d >> 3) & 7)) << 4));
            acc[db][0] = mfma16(kf, vf[0], acc[db][0]); acc[db][1] = mfma16(kf, vf[1], acc[db][1]); }
    }
    bf16_t* Cl = (bf16_t*)(ws + WS_CLOC) + (size_t)(bh * 32 + c) * 256 * 128;
#pragma unroll
    for (int db = 0; db < 8; ++db)
#pragma unroll
        for (int j = 0; j < 2; ++j) { const int v = 16 * (2 * wave + j) + r16;
            u32x2 w; w.x = pk_bf16(acc[db][j][0], acc[db][j][1]); w.y = pk_bf16(acc[db][j][2], acc[db][j][3]);
            *(u32x2*)(Cl + (size_t)v * 128 + 16 * db + 4 * g) = w; }
    __syncthreads();
}

constexpr int ATT_KROW = 256, ATT_VROW = 128, ATT_KBYTES = 64 * ATT_KROW, ATT_BUF = ATT_KBYTES + 128 * ATT_VROW, ATT_EXTRA = 2 * ATT_BUF;
template <int MODE>
__device__ __forceinline__ void attn_unit(LAS unsigned char* lds, const bf16_t* Qb, const bf16_t* Kb, int ld, const bf16_t* Vt, int j,
                                          const float* kmean  , bf16_t* outp, const float* gvec  , float lam,
                                          int tid, int lane, int wave) {
    constexpr int NC = (MODE == 0) ? 2 : 1;
    constexpr float CS = ((MODE == 0) ? 0.125f : 0.08838834764831845f) * 1.4426950408889634f;
    const int r16 = lane & 15, g = lane >> 4;
    const int q0 = j * 128, qpos = q0 + 16 * wave + r16;
    const int own = j >> 1, half = j & 1;
    const int nown = (MODE == 0) ? 0 : 2 + 2 * half;
    const int ntiles = (MODE == 0) ? 2 * (j + 1) : nown + 4 * own;
    bf16x8 qf[4];
#pragma unroll
    for (int ks = 0; ks < 4; ++ks) qf[ks] = *(const bf16x8*)(Qb + (size_t)qpos * ld + 32 * ks + 8 * g);
    unsigned sel = 0;
    if (MODE == 1) {
        LAS float* km = (LAS float*)(lds + ATT_EXTRA);
        for (int i = tid; i < 16 * 128; i += NTHREADS) km[i] = kmean[i];
        __syncthreads();
        float qv[32];
#pragma unroll
        for (int ks = 0; ks < 4; ++ks) { float f[8]; unpack8(__builtin_bit_cast(u32x4, qf[ks]), f);
#pragma unroll
            for (int e = 0; e < 8; ++e) qv[8 * ks + e] = f[e]; }
        float gate[15]; float t1 = -INFINITY, t2 = -INFINITY, t3 = -INFINITY;
#pragma unroll
        for (int n = 0; n < 15; ++n) {
            gate[n] = -INFINITY;
            if (n < own) {
                float a = 0.f;
#pragma unroll
                for (int ks = 0; ks < 4; ++ks) { const f32x4 k0 = *(const LAS f32x4*)(km + n * 128 + 32 * ks + 8 * g), k1 = *(const LAS f32x4*)(km + n * 128 + 32 * ks + 8 * g + 4);
                    a += (qv[8 * ks + 0] * k0[0] + qv[8 * ks + 1] * k0[1]) + (qv[8 * ks + 2] * k0[2] + qv[8 * ks + 3] * k0[3])
                       + (qv[8 * ks + 4] * k1[0] + qv[8 * ks + 5] * k1[1]) + (qv[8 * ks + 6] * k1[2] + qv[8 * ks + 7] * k1[3]); }
                a += __shfl_xor(a, 16); a += __shfl_xor(a, 32);
                gate[n] = a;
                float v = a; const float n1 = fmaxf(t1, v); v = fminf(t1, v); t1 = n1; const float n2 = fmaxf(t2, v); v = fminf(t2, v); t2 = n2; t3 = fmaxf(t3, v);
            }
        }
        const float theta = (own >= 3) ? t3 : -INFINITY;
#pragma unroll
        for (int n = 0; n < 15; ++n) if (n < own && gate[n] >= theta) sel |= 1u << n;
    }
    f32x4 O[NC][8];
#pragma unroll
    for (int c = 0; c < NC; ++c)
#pragma unroll
        for (int vb = 0; vb < 8; ++vb) O[c][vb] = (f32x4){0.f, 0.f, 0.f, 0.f};
    float mrun[NC], lsum[NC];
#pragma unroll
    for (int c = 0; c < NC; ++c) { mrun[c] = -INFINITY; lsum[c] = 0.f; }

    auto key0_of = [&](int t) -> int { if (MODE == 0) return 64 * t; if (t < nown) return own * 256 + 64 * t; const int tt = t - nown; return (tt >> 2) * 256 + 64 * (tt & 3); };
    u32x4 kreg[2], vreg[2];
    auto load_tile = [&](int t) { const int k0 = key0_of(t);
#pragma unroll
        for (int i = 0; i < 2; ++i) { const int id = tid + NTHREADS * i;
            kreg[i] = *(const u32x4*)(Kb + (size_t)(k0 + (id >> 4)) * ld + (id & 15) * 8);
            vreg[i] = *(const u32x4*)(Vt + (size_t)(id >> 3) * SEQ + k0 + (id & 7) * 8); } };
    auto store_tile = [&](int buf) { LAS unsigned char* base = lds + buf * ATT_BUF;
#pragma unroll
        for (int i = 0; i < 2; ++i) { const int id = tid + NTHREADS * i;
            { const int r = id >> 4; *(LAS u32x4*)(base + r * ATT_KROW + (((id & 15) ^ ((r & 3) + 4 * ((r >> 3) & 3))) << 4)) = kreg[i]; }
            { const int v = id >> 3; *(LAS u32x4*)(base + ATT_KBYTES + v * ATT_VROW + (((id & 7) ^ ((v >> 1) & 7)) << 4)) = vreg[i]; } } };
    load_tile(0); store_tile(0);
    __syncthreads();
    if (ntiles > 1) load_tile(1);
#if defined(ATT_ABL) && ATT_ABL == 4
    if (ntiles > 1) store_tile(1);
    __syncthreads();
#endif
    const int qlo = q0 + 16 * wave;
    const int krow_base = (8 * (r16 >> 2) + (r16 & 3)) * ATT_KROW;
    int koff[4], voff[2];
#pragma unroll
    for (int kk = 0; kk < 4; ++kk) koff[kk] = krow_base + (((4 * kk + g) ^ r16) << 4);
#pragma unroll
    for (int kg = 0; kg < 2; ++kg) voff[kg] = r16 * ATT_VROW + (((4 * kg + g) ^ (r16 >> 1)) << 4);
    for (int t = 0; t < ntiles; ++t) {
        const int k0 = key0_of(t);
        const LAS unsigned char* kb_ = lds + (t & 1) * ATT_BUF;
        const LAS unsigned char* vb_ = kb_ + ATT_KBYTES;
        bool causal, active = true; bool lane_on = true;
        if (MODE == 0) { causal = (k0 + 63 > qlo); active = (k0 <= qlo + 15); }
        else if (t < nown) { causal = true; active = (k0 <= qlo + 15); }
        else { causal = false; const int n = (t - nown) >> 2; lane_on = (sel >> n) & 1u; active = __any(lane_on); }
#if defined(ATT_ABL) && ATT_ABL == 3
        active = false;
#endif
        if (active) {
#pragma unroll
            for (int c = 0; c < NC; ++c) {
                f32x4 s[2][2];
#pragma unroll
                for (int kg = 0; kg < 2; ++kg)
#pragma unroll
                    for (int kb = 0; kb < 2; ++kb) {
                        f32x4 a = (f32x4){0.f, 0.f, 0.f, 0.f};
                        const LAS unsigned char* kr = kb_ + (32 * kg + 4 * kb) * ATT_KROW;
#pragma unroll
                        for (int ks = 0; ks < (MODE == 0 ? 2 : 4); ++ks) { const int kk = (MODE == 0) ? 2 * c + ks : ks;
                            a = mfma16(*(const LAS bf16x8*)(kr + koff[kk]), qf[kk], a); }
                        s[kg][kb] = a;
                    }
                if (causal) {
#pragma unroll
                    for (int kg = 0; kg < 2; ++kg)
#pragma unroll
                        for (int kb = 0; kb < 2; ++kb)
#pragma unroll
                            for (int e = 0; e < 4; ++e) if (k0 + 32 * kg + 8 * g + 4 * kb + e > qpos) s[kg][kb][e] = -INFINITY;
                }
                if (MODE == 1 && !lane_on) {
#pragma unroll
                    for (int kg = 0; kg < 2; ++kg)
#pragma unroll
                        for (int kb = 0; kb < 2; ++kb) s[kg][kb] = (f32x4){-INFINITY, -INFINITY, -INFINITY, -INFINITY};
                }
                float tm = -INFINITY;
#pragma unroll
                for (int kg = 0; kg < 2; ++kg)
#pragma unroll
                    for (int kb = 0; kb < 2; ++kb) tm = fmaxf(tm, fmaxf(fmaxf(s[kg][kb][0], s[kg][kb][1]), fmaxf(s[kg][kb][2], s[kg][kb][3])));
                if (__any((tm - mrun[c]) * CS > 6.0f)) {
                    tm = fmaxf(tm, __shfl_xor(tm, 16)); tm = fmaxf(tm, __shfl_xor(tm, 32));
                    const float mn = fmaxf(mrun[c], tm);
                    const float alpha = __builtin_amdgcn_exp2f((mrun[c] - mn) * CS);
                    mrun[c] = mn; lsum[c] *= alpha;
#pragma unroll
                    for (int vb = 0; vb < 8; ++vb) O[c][vb] *= alpha;
                }
                const float mc = mrun[c] * CS;
                f32x4 psv = (f32x4){0.f, 0.f, 0.f, 0.f};
                bf16x8 pk[2];
#pragma unroll
                for (int kg = 0; kg < 2; ++kg) {
                    float pe[8];
#pragma unroll
                    for (int kb = 0; kb < 2; ++kb) { const f32x4 t4 = s[kg][kb] * CS - mc; f32x4 p4;
#pragma unroll
#if defined(ATT_ABL) && ATT_ABL == 2
                        for (int e = 0; e < 4; ++e) { p4[e] = t4[e]; pe[4 * kb + e] = p4[e]; }
#else
                        for (int e = 0; e < 4; ++e) { p4[e] = __builtin_amdgcn_exp2f(t4[e]); pe[4 * kb + e] = p4[e]; }
#endif
                        psv += p4; }
                    pk[kg] = __builtin_bit_cast(bf16x8, pack8(pe));
                }
                lsum[c] += (psv[0] + psv[1]) + (psv[2] + psv[3]);
#if defined(ATT_ABL) && ATT_ABL == 1
                asm volatile("" :: "v"(pk[0]), "v"(pk[1]));
#else
#pragma unroll
                for (int vb = 0; vb < 8; ++vb) {
#pragma unroll
                    for (int kg = 0; kg < 2; ++kg)
                        O[c][vb] = mfma16(*(const LAS bf16x8*)(vb_ + 16 * vb * ATT_VROW + voff[kg]), pk[kg], O[c][vb]); }
#endif
#ifndef ATT_NO_SCHED_BAR
                __builtin_amdgcn_sched_barrier(0);
#endif
            }
        }
#if !(defined(ATT_ABL) && ATT_ABL == 4)
        if (t + 1 < ntiles) store_tile((t + 1) & 1);
        if (t + 2 < ntiles) load_tile(t + 2);
        __syncthreads();
#endif
    }
#if defined(ATT_ABL) && ATT_ABL == 4
    __syncthreads();
#endif
    float linv[NC];
#pragma unroll
    for (int c = 0; c < NC; ++c) { float l = lsum[c]; l += __shfl_xor(l, 16); l += __shfl_xor(l, 32); linv[c] = 1.f / l;
#if defined(ATT_ABL) && ATT_ABL == 3
        linv[c] = 1.f;
#endif
    }
    if (MODE == 0) {
        const float i0 = linv[0], i1 = lam * linv[1];
        float ss = 0.f; f32x4 y[8];
#pragma unroll
        for (int vb = 0; vb < 8; ++vb) { y[vb] = O[0][vb] * i0 - O[NC - 1][vb] * i1; ss += (y[vb][0] * y[vb][0] + y[vb][1] * y[vb][1]) + (y[vb][2] * y[vb][2] + y[vb][3] * y[vb][3]); }
        ss += __shfl_xor(ss, 16); ss += __shfl_xor(ss, 32);
        const float r = rsqrtf(ss * (1.f / 128.f) + EPS) * 0.8f;
#pragma unroll
        for (int vb = 0; vb < 8; ++vb) { const f32x4 gv = *(const f32x4*)(gvec + 16 * vb + 4 * g); const f32x4 o = y[vb] * r * gv;
            u32x2 w; w.x = pk_bf16(o[0], o[1]); w.y = pk_bf16(o[2], o[3]);
            *(u32x2*)(outp + (size_t)qpos * DM + 16 * vb + 4 * g) = w; }
    } else {
#pragma unroll
        for (int vb = 0; vb < 8; ++vb) { const f32x4 o = O[0][vb] * linv[0];
            u32x2 w; w.x = pk_bf16(o[0], o[1]); w.y = pk_bf16(o[2], o[3]);
            *(u32x2*)(outp + (size_t)qpos * DM + 16 * vb + 4 * g) = w; }
    }
}

__device__ __forceinline__ void mlstm_scan(const Params& p, int idx) {
    unsigned char* ws = p.ws;
    const int bh = idx >> 12, ch = idx & 4095;
    const float* chs = (const float*)(ws + WS_CHS) + (size_t)bh * 64;
    const bf16_t* Cl = (const bf16_t*)(ws + WS_CLOC) + (size_t)bh * 32 * 32768 + (size_t)ch * 8;
    bf16_t* Cp = (bf16_t*)(ws + WS_CPREV) + (size_t)bh * 32 * 32768 + (size_t)ch * 8;
    const bool do_n = ch < 16;
    const float* nl = (const float*)(ws + WS_NLOC) + (size_t)bh * 32 * 128 + ch * 8;
    float* np = (float*)(ws + WS_NPREV) + (size_t)bh * 32 * 128 + ch * 8;
    float st[8], nst[8];
#pragma unroll
    for (int e = 0; e < 8; ++e) { st[e] = 0.f; nst[e] = 0.f; }
    float m = 0.f;
#pragma unroll 8
    for (int c = 0; c < 32; ++c) {
        const u32x4 cl = *(const u32x4*)(Cl + (size_t)c * 32768);
        *(u32x4*)(Cp + (size_t)c * 32768) = pack8(st);
        if (do_n) { *(f32x4*)(np + c * 128) = (f32x4){nst[0], nst[1], nst[2], nst[3]}; *(f32x4*)(np + c * 128 + 4) = (f32x4){nst[4], nst[5], nst[6], nst[7]}; }
        if (ch == 0) ((float*)(ws + WS_MPREV))[bh * 32 + c] = m;
        const float gc = chs[2 * c], ml = chs[2 * c + 1];
        const float mn = fmaxf(gc + m, ml), a = __expf(gc + m - mn), b = __expf(ml - mn);
        float f[8]; unpack8(cl, f);
#pragma unroll
        for (int e = 0; e < 8; ++e) st[e] = a * st[e] + b * f[e];
        if (do_n) { const f32x4 n0 = *(const f32x4*)(nl + c * 128), n1 = *(const f32x4*)(nl + c * 128 + 4);
#pragma unroll
            for (int e = 0; e < 4; ++e) { nst[e] = a * nst[e] + b * n0[e]; nst[4 + e] = a * nst[4 + e] + b * n1[e]; } }
        m = mn;
    }
}

__device__ __forceinline__ int swz256(int row, int ch) { return row * 256 + ((ch ^ (row & 15)) << 4); }
__device__ __forceinline__ void mlstm_out_unit(const Params& p, LAS unsigned char* lds, int unit, int tid, int lane, int wave) {
    const int c = unit & 31, h = (unit >> 5) & 3, b = unit >> 7, bh = b * 4 + h;
    unsigned char* ws = p.ws;
    LAS unsigned char* Cp = lds;
    LAS unsigned char* Vt = lds + 65536;
    LAS float* sc = (LAS float*)(lds + 131072);
    const int s0 = c * 128;
    if (wave == 0) {
        float mp = ((const float*)(ws + WS_MPREV))[bh * 32 + c];
        if (lane == 0) sc[544] = mp;
        const float* lf = (const float*)(ws + WS_LF) + (size_t)bh * SEQ + s0;
        const float* li = (const float*)(ws + WS_LI) + (size_t)bh * SEQ + s0;
        const float e0 = lf[2 * lane], e1 = lf[2 * lane + 1];
        float incl = e0 + e1;
#pragma unroll
        for (int o = 1; o < 64; o <<= 1) { const float t = __shfl_up(incl, o); if (lane >= o) incl += t; }
        const float b0 = incl - e1, b1 = incl;
        const float u0 = li[2 * lane] - b0, u1 = li[2 * lane + 1] - b1;
        float cm = fmaxf(u0, u1);
#pragma unroll
        for (int o = 1; o < 64; o <<= 1) { const float t = __shfl_up(cm, o); if (lane >= o) cm = fmaxf(cm, t); }
        float pm = __shfl_up(cm, 1); if (lane == 0) pm = -INFINITY;
        sc[160 + 2 * lane] = b0; sc[160 + 2 * lane + 1] = b1;
        sc[288 + 2 * lane] = u0; sc[288 + 2 * lane + 1] = u1;
        sc[416 + 2 * lane] = fmaxf(mp, fmaxf(pm, u0)); sc[416 + 2 * lane + 1] = fmaxf(mp, cm);
    }
    __syncthreads();
    {
        if (c > 0) {
            const bf16_t* Cpg = (const bf16_t*)(ws + WS_CPREV) + (size_t)(bh * 32 + c) * 32768;
#pragma unroll
            for (int i = 0; i < 8; ++i) { const int id = tid + NTHREADS * i; *(LAS u32x4*)(Cp + swz256(id >> 4, id & 15)) = *(const u32x4*)(Cpg + (size_t)id * 8); }
            if (tid < 128) sc[32 + tid] = ((const float*)(ws + WS_NPREV))[(size_t)(bh * 32 + c) * 128 + tid];
        }
        const bf16_t* Vtm = (const bf16_t*)(ws + WS_VTM) + ((size_t)bh * 256) * SEQ + s0;
#pragma unroll
        for (int i = 0; i < 8; ++i) { const int id = tid + NTHREADS * i, v = id >> 4, ch = id & 15;
            *(LAS u32x4*)(Vt + swz256(v, ch)) = *(const u32x4*)(Vtm + (size_t)v * SEQ + ch * 8); }
    }
    __syncthreads();
    const int r16 = lane & 15, g = lane >> 4;
    const int tl = 16 * wave + r16;
    const float mprev = sc[544], Mt = sc[416 + tl], bc = sc[160 + tl];
    const float winter = __expf(mprev - Mt);
    const bf16_t* Qm = (const bf16_t*)(ws + WS_QM) + ((size_t)bh * SEQ + s0) * 128;
    const bf16_t* Km = (const bf16_t*)(ws + WS_KM) + ((size_t)bh * SEQ + s0) * 128;
    bf16x8 qf[4];
#pragma unroll
    for (int ks = 0; ks < 4; ++ks) qf[ks] = *(const bf16x8*)(Qm + (size_t)tl * 128 + 32 * ks + 8 * g);
    f32x4 acc[16];
#pragma unroll
    for (int vb = 0; vb < 16; ++vb) acc[vb] = (f32x4){0.f, 0.f, 0.f, 0.f};
    float den = 0.f;
    if (c > 0) {
#pragma unroll
        for (int vb = 0; vb < 16; ++vb) {
#pragma unroll
            for (int ks = 0; ks < 4; ++ks) acc[vb] = mfma16(*(const LAS bf16x8*)(Cp + swz256(16 * vb + r16, 4 * ks + g)), qf[ks], acc[vb]);
            acc[vb] *= winter;
        }
        float qn = 0.f;
#pragma unroll
        for (int ks = 0; ks < 4; ++ks) { float f[8]; unpack8(__builtin_bit_cast(u32x4, qf[ks]), f);
#pragma unroll
            for (int e = 0; e < 8; ++e) qn += f[e] * sc[32 + 32 * ks + 8 * g + e]; }
        qn += __shfl_xor(qn, 16); qn += __shfl_xor(qn, 32);
        den = winter * qn * 0.25f;
    }
    const int nsb = (wave >> 1) + 1;
    for (int sb = 0; sb < nsb; ++sb) {
        f32x4 sv[2];
#pragma unroll
        for (int kb = 0; kb < 2; ++kb) {
            f32x4 a = (f32x4){0.f, 0.f, 0.f, 0.f};
            const bf16_t* kr = Km + (size_t)(32 * sb + 8 * (r16 >> 2) + 4 * kb + (r16 & 3)) * 128 + 8 * g;
#pragma unroll
            for (int ks = 0; ks < 4; ++ks) a = mfma16(*(const bf16x8*)(kr + 32 * ks), qf[ks], a);
            sv[kb] = a;
        }
        float pe[8];
#pragma unroll
        for (int kb = 0; kb < 2; ++kb)
#pragma unroll
            for (int e = 0; e < 4; ++e) { const int s = 32 * sb + 8 * g + 4 * kb + e;
                const float w = (s <= tl) ? __expf(sc[288 + s] - Mt) : 0.f; const float x = sv[kb][e] * w; pe[4 * kb + e] = x; den += x; }
        const bf16x8 pf = __builtin_bit_cast(bf16x8, pack8(pe));
#pragma unroll
        for (int vb = 0; vb < 16; ++vb) acc[vb] = mfma16(*(const LAS bf16x8*)(Vt + swz256(16 * vb + r16, 4 * sb + g)), pf, acc[vb]);
    }
    den += __shfl_xor(den, 16); den += __shfl_xor(den, 32);
    const float dinv = 1.f / fmaxf(fabsf(den), __expf(-(bc + Mt)));
    float ss = 0.f;
#pragma unroll
    for (int vb = 0; vb < 16; ++vb) { acc[vb] *= dinv; ss += (acc[vb][0] * acc[vb][0] + acc[vb][1] * acc[vb][1]) + (acc[vb][2] * acc[vb][2] + acc[vb][3] * acc[vb][3]); }
    ss += __shfl_xor(ss, 16); ss += __shfl_xor(ss, 32);
    const float r = rsqrtf(ss * (1.f / 256.f) + EPS);
    const size_t trow = (size_t)b * SEQ + s0 + tl;
    const bf16_t* ao = (const bf16_t*)(ws + WS_PROJ) + trow * EVEN_IN + 2048 + h * 256;
    bf16_t* outp = (bf16_t*)(ws + WS_CAT) + trow * DM + h * 256;
    const float* hg = p.in[12] + h * 256;
#pragma unroll
    for (int vb = 0; vb < 16; ++vb) { const int v = 16 * vb + 4 * g;
        const u32x2 aw = *(const u32x2*)(ao + v); const f32x4 gv = *(const f32x4*)(hg + v);
        const float o0 = acc[vb][0] * r * gv[0] * sigmoidf_(bf_lo(aw.x)), o1 = acc[vb][1] * r * gv[1] * sigmoidf_(bf_hi(aw.x));
        const float o2 = acc[vb][2] * r * gv[2] * sigmoidf_(bf_lo(aw.y)), o3 = acc[vb][3] * r * gv[3] * sigmoidf_(bf_hi(aw.y));
        u32x2 w; w.x = pk_bf16(o0, o1); w.y = pk_bf16(o2, o3); *(u32x2*)(outp + v) = w; }
    __syncthreads();
}
__device__ __forceinline__ void moba_post_item(const Params& p, LAS unsigned char* lds, int item, int tid) {
    const int blk = item & 15, h = (item >> 4) & 7, b = item >> 7;
    bf16_t* proj = (bf16_t*)(p.ws + WS_PROJ);
    const float* tab = (const float*)(p.ws + WS_ROPE);
    const size_t row0 = (size_t)b * SEQ + blk * 256;
    {
        const int dc = tid & 15, tg = tid >> 4;
        float a[8];
#pragma unroll
        for (int e = 0; e < 8; ++e) a[e] = 0.f;
        for (int tt = 0; tt < 8; ++tt) {
            const size_t row = row0 + tg * 8 + tt;
            const bf16_t* kp = proj + row * ODD_IN + 1024 + h * 128;
            float x[8]; unpack8(*(const u32x4*)(kp + dc * 8), x);
            if (dc < 4) {
                float y[8]; unpack8(*(const u32x4*)(kp + (dc ^ 2) * 8), y);
                const float* tb = tab + row * 48 + 16 + 16 * (dc & 1);
#pragma unroll
                for (int e = 0; e < 8; ++e) { const float cs = tb[2 * e], sn = tb[2 * e + 1];
                    x[e] = (dc < 2) ? (x[e] * cs - y[e] * sn) : (x[e] * cs + y[e] * sn); }
            }
#pragma unroll
            for (int e = 0; e < 8; ++e) a[e] += x[e];
        }
        LAS float* part = (LAS float*)lds;
#pragma unroll
        for (int e = 0; e < 8; ++e) part[tg * 128 + dc * 8 + e] = a[e];
        __syncthreads();
        if (tid < 128) { float s = 0.f;
#pragma unroll 8
            for (int i = 0; i < 32; ++i) s += part[i * 128 + tid];
            ((float*)(p.ws + WS_KMEAN))[((size_t)(b * 8 + h) * 16 + blk) * 128 + tid] = s * (1.f / 256.f); }
        __syncthreads();
    }
    {
        const int tok = tid >> 1, qk = tid & 1;
        bf16_t* ptr = proj + (row0 + tok) * ODD_IN + qk * 1024 + h * 128;
        float x1[16], x2[16], o1[16], o2[16];
        unpack8(*(const u32x4*)ptr, x1); unpack8(*(const u32x4*)(ptr + 8), x1 + 8); unpack8(*(const u32x4*)(ptr + 16), x2); unpack8(*(const u32x4*)(ptr + 24), x2 + 8);
        const float* tb = tab + (row0 + tok) * 48 + 16;
#pragma unroll
        for (int e = 0; e < 16; ++e) { const float cs = tb[2 * e], sn = tb[2 * e + 1]; o1[e] = x1[e] * cs - x2[e] * sn; o2[e] = x2[e] * cs + x1[e] * sn; }
        *(u32x4*)ptr = pack8(o1); *(u32x4*)(ptr + 8) = pack8(o1 + 8); *(u32x4*)(ptr + 16) = pack8(o2); *(u32x4*)(ptr + 24) = pack8(o2 + 8);
    }
}

__device__ __forceinline__ void sgu_unit(const Params& p, LAS unsigned char* lds, int unit, int tid, int lane, int wave) {
    const int gq = unit & 7, c = (unit >> 3) & 31, b = unit >> 8;
    const bf16_t* proj = (const bf16_t*)(p.ws + WS_PROJ);
    LAS unsigned char* vnT = lds;
    const size_t row0 = (size_t)b * SEQ + c * 128;
    {
        const int pt = 16 * wave + (lane >> 2), sub = lane & 3;
        const bf16_t* src = proj + (row0 + pt) * ODD_IN + 4096 + gq * 128 + sub * 32;
        float x[32];
#pragma unroll
        for (int i = 0; i < 4; ++i) unpack8(*(const u32x4*)(src + 8 * i), x + 8 * i);
        float s1 = 0.f;
#pragma unroll
        for (int e = 0; e < 32; ++e) { x[e] = gelu_tanh(x[e]); s1 += x[e]; }
        s1 += __shfl_xor(s1, 1); s1 += __shfl_xor(s1, 2);
        const float mu = s1 * (1.f / 128.f);
        float s2 = 0.f;
#pragma unroll
        for (int e = 0; e < 32; ++e) { x[e] -= mu; s2 += x[e] * x[e]; }
        s2 += __shfl_xor(s2, 1); s2 += __shfl_xor(s2, 2);
        const float r = rsqrtf(s2 * (1.f / 128.f) + EPS);
        const float* lg = p.in[17] + gq * 128 + sub * 32; const float* lb = p.in[18] + gq * 128 + sub * 32;
#pragma unroll
        for (int e = 0; e < 32; ++e) { const int d = sub * 32 + e;
            *(LAS bf16_t*)(vnT + d * 272 + ((((pt >> 3) ^ ((d >> 3) & 15)) << 4) + (pt & 7) * 2)) = f2bf(x[e] * r * lg[e] + lb[e]); }
    }
    __syncthreads();
    const int r16 = lane & 15, g = lane >> 4;
    const int prow = 16 * wave + r16;
    f32x4 acc[8];
#pragma unroll
    for (int db = 0; db < 8; ++db) acc[db] = (f32x4){0.f, 0.f, 0.f, 0.f};
    const float* W = p.in[19] + ((size_t)gq * 128 + prow) * 128;
    const int nrs = (wave >> 1) + 1;
    for (int rs = 0; rs < nrs; ++rs) {
        const int r0 = 32 * rs + 8 * g;
        const f32x4 w0 = *(const f32x4*)(W + r0), w1 = *(const f32x4*)(W + r0 + 4);
        float wf[8] = {w0[0], w0[1], w0[2], w0[3], w1[0], w1[1], w1[2], w1[3]};
#pragma unroll
        for (int e = 0; e < 8; ++e) if (r0 + e > prow) wf[e] = 0.f;
        const bf16x8 af = __builtin_bit_cast(bf16x8, pack8(wf));
#pragma unroll
        for (int db = 0; db < 8; ++db) { const int d = 16 * db + r16; acc[db] = mfma16(*(const LAS bf16x8*)(vnT + d * 272 + (((4 * rs + g) ^ ((d >> 3) & 15)) << 4)), af, acc[db]); }
    }
    bf16_t* cat = (bf16_t*)(p.ws + WS_CAT);
    {
        const float bs = p.in[20][gq * 128 + prow];
        const bf16_t* up = proj + (row0 + prow) * ODD_IN + 3072 + gq * 128 + 4 * g;
        bf16_t* op = cat + (row0 + prow) * DM + 1024 + gq * 128 + 4 * g;
#pragma unroll
        for (int db = 0; db < 8; ++db) { const u32x2 uw = *(const u32x2*)(up + 16 * db);
            u32x2 w; w.x = pk_bf16(gelu_tanh(bf_lo(uw.x)) * (acc[db][0] + bs), gelu_tanh(bf_hi(uw.x)) * (acc[db][1] + bs));
            w.y = pk_bf16(gelu_tanh(bf_lo(uw.y)) * (acc[db][2] + bs), gelu_tanh(bf_hi(uw.y)) * (acc[db][3] + bs));
            *(u32x2*)(op + 16 * db) = w; }
    }
    __syncthreads();
}

__device__ __forceinline__ void ins16(float (&val)[16], float v) {
#pragma unroll
    for (int i = 0; i < 16; ++i) { const float hi = fmaxf(val[i], v); v = fminf(val[i], v); val[i] = hi; }
}
template <int N>
__device__ __forceinline__ void bitonic_sort_desc(float (&v)[N]) {
#pragma unroll
    for (int k = 2; k <= N; k <<= 1)
#pragma unroll
        for (int j = k >> 1; j > 0; j >>= 1)
#pragma unroll
            for (int i = 0; i < N; ++i) { const int l = i ^ j;
                if (l > i) { const bool desc = ((i & k) == 0); const float a = v[i], b = v[l], hi = fmaxf(a, b), lo = fminf(a, b); v[i] = desc ? hi : lo; v[l] = desc ? lo : hi; } }
}
template <int XM>
__device__ __forceinline__ void merge_top16(float (&t)[16]) {
    float w[16];
#pragma unroll
    for (int i = 0; i < 16; ++i) w[i] = fmaxf(t[i], __shfl_xor(t[15 - i], XM));
#pragma unroll
    for (int j = 8; j > 0; j >>= 1)
#pragma unroll
        for (int i = 0; i < 16; ++i) { const int l = i ^ j; if (l > i) { const float a = w[i], b = w[l]; w[i] = fmaxf(a, b); w[l] = fminf(a, b); } }
#pragma unroll
    for (int i = 0; i < 16; ++i) t[i] = w[i];
}
template <bool LAST>
__device__ __forceinline__ void peer_tile(const Params& p, LAS unsigned char* lds, int layer, int tile, int tid, int lane, int wave) {
    unsigned char* ws = p.ws;
    LAS unsigned* eL = (LAS unsigned*)lds;
    LAS float* wL = (LAS float*)(lds + 32768);
    const int r16 = lane & 15, g = lane >> 4;
    const size_t tok0 = (size_t)tile * 64;
    {
        LAS unsigned* ctr0 = (LAS unsigned*)(lds + 114688);
        if (tid < 96) ctr0[tid] = 0u;
        LAS float* part0 = (LAS float*)(lds + 65536);
#pragma unroll
        for (int i = 0; i < 16; ++i) part0[tid + NTHREADS * i] = 0.f;
    }
    {
        const int tg = wave & 3, hs = wave >> 2;
        const bf16_t* SK = (const bf16_t*)(ws + WS_SK) + (size_t)layer * 8 * 2 * 128 * 128;
#pragma unroll 1
        for (int hh = 0; hh < 4; ++hh) {
            const int h = 4 * hs + hh;
            int r16q = r16; asm volatile("" : "+v"(r16q));
            const bf16_t* qrow = (const bf16_t*)(ws + WS_QP) + (tok0 + 16 * tg + r16q) * DM;
            float L[2][16];
#pragma unroll 1
            for (int c = 0; c < 2; ++c) {
                bf16x8 qf[4];
#pragma unroll
                for (int ks = 0; ks < 4; ++ks) qf[ks] = *(const bf16x8*)(qrow + h * 256 + c * 128 + 32 * ks + 8 * g);
                const bf16_t* skc = SK + (size_t)(h * 2 + c) * 128 * 128;
                float scv[32];
#pragma unroll
                for (int nb = 0; nb < 8; ++nb) {
                    f32x4 a = (f32x4){0.f, 0.f, 0.f, 0.f};
#pragma unroll
                    for (int ks = 0; ks < 4; ++ks) a = mfma16(*(const bf16x8*)(skc + (size_t)(16 * nb + r16) * 128 + 32 * ks + 8 * g), qf[ks], a);
#pragma unroll
                    for (int e = 0; e < 4; ++e) { const int n = 16 * nb + 4 * g + e;
                        scv[4 * nb + e] = __uint_as_float((__float_as_uint(a[e]) & 0xffffff80u) | (unsigned)(127 - n)); }
                }
                float Lc[16], Ld[16];
#pragma unroll
                for (int k = 0; k < 16; ++k) { Lc[k] = scv[k]; Ld[k] = scv[16 + k]; }
                bitonic_sort_desc<16>(Lc); bitonic_sort_desc<16>(Ld);
#pragma unroll
                for (int k = 0; k < 16; ++k) Lc[k] = fmaxf(Lc[k], Ld[15 - k]);
#pragma unroll
                for (int j = 8; j > 0; j >>= 1)
#pragma unroll
                    for (int i = 0; i < 16; ++i) { const int l = i ^ j; if (l > i) { const float a = Lc[i], b = Lc[l]; Lc[i] = fmaxf(a, b); Lc[l] = fminf(a, b); } }
                merge_top16<16>(Lc); merge_top16<32>(Lc);
#pragma unroll
                for (int k = 0; k < 16; ++k) { if (c == 0) L[0][k] = Lc[k]; else L[1][k] = Lc[k]; }
            }
            float top[16];
#pragma unroll
            for (int q = 0; q < 16; ++q) top[q] = -INFINITY;
            {
                int cix = 0;
#pragma unroll
                for (int i = 0; i < 16; ++i)
#pragma unroll
                    for (int jj = 0; jj < 16; ++jj)
                        if ((i + 1) * (jj + 1) <= 16) {
                            const float key = __uint_as_float((__float_as_uint(L[0][i] + L[1][jj]) & 0xffffff00u) | (unsigned)(i * 16 + jj));
                            top[cix >> 2] = ((cix & 3) == g) ? key : top[cix >> 2];
                            ++cix;
                        }
            }
            bitonic_sort_desc<16>(top); merge_top16<16>(top); merge_top16<32>(top);
            const float mx = top[0]; float e16[16]; float se = 0.f;
#pragma unroll
            for (int k = 0; k < 16; ++k) { e16[k] = __expf(top[k] - mx); se += e16[k]; }
            const float inv = 1.f / se;
            LAS unsigned char* ixb = (LAS unsigned char*)(lds + 98304 + wave * 2048) + lane;
#pragma unroll
            for (int q = 0; q < 16; ++q) { ixb[q * 64] = (unsigned char)(127u - (__float_as_uint(L[0][q]) & 127u)); ixb[(16 + q) * 64] = (unsigned char)(127u - (__float_as_uint(L[1][q]) & 127u)); }
#pragma unroll
            for (int k = 0; k < 16; ++k) {
                const unsigned id = __float_as_uint(top[k]) & 0xffu; const unsigned ii = id >> 4, jj = id & 15u;
                const unsigned ex = (unsigned)ixb[ii * 64] * 128u + (unsigned)ixb[(16 + jj) * 64];
                if (g == 0) { eL[(16 * tg + r16) * 128 + h * 16 + k] = ex; wL[(16 * tg + r16) * 128 + h * 16 + k] = e16[k] * inv; }
            }
        }
    }
    __syncthreads();
#ifdef PEER_STAMP
    if (layer == 0) { PEER_STAMP; }
#endif
    { unsigned z2 = 0; asm volatile("" : "+s"(z2)); lane = (int)__builtin_amdgcn_mbcnt_hi(~0u, __builtin_amdgcn_mbcnt_lo(~0u, z2)); }
    const int g8 = lane >> 3, j8 = lane & 7;
    const bool b0 = lane & 1, b1 = (lane >> 1) & 1, b2 = (lane >> 2) & 1;
    LAS float* part = (LAS float*)(lds + 65536);
    const unsigned char* U8 = ws + WS_U + (size_t)layer * 16384 * 1024;
    LAS unsigned* ctr = (LAS unsigned*)(lds + 114688);
    LAS unsigned* done = ctr + 32;
#define PEER_GRAB(which_) ({ unsigned v_ = 0u; if (lane == 0) v_ = __hip_atomic_fetch_add(ctr + (which_), 1u, __ATOMIC_RELAXED, __HIP_MEMORY_SCOPE_WORKGROUP); (int)__builtin_amdgcn_readfirstlane(v_); })
#define PEER_ISSUE(dst, base, jo_, tl_, hf_, gq) do { _Pragma("unroll") for (int bb = 0; bb < 8; ++bb) { const unsigned ex_ = eL[(tl_) * 128 + 64 * (hf_) + 8 * bb + (gq)]; \
        dst[bb] = *(const GAS u32x4*)((base) + (unsigned)(ex_ * 128u + (jo_))); } } while (0)
#define PEER_CVT4(w_, k_) __builtin_amdgcn_cvt_scalef32_pk_f32_fp4((unsigned)(w_), 1.0f, k_)
#define PEER_UDOT(src, hf_) do { float pd[8]; \
        _Pragma("unroll") for (int bb = 0; bb < 8; ++bb) { int aL = 0, aH = 0; asm volatile("" : "+v"(src[bb])); \
            _Pragma("unroll") for (int d = 0; d < 4; ++d) { const int w = (int)src[bb][d]; \
                aL = __builtin_amdgcn_sdot4(w & 0x0F0F0F0F, xw[2 * d], aL, false); aH = __builtin_amdgcn_sdot4(w & (int)0xF0F0F0F0u, xw[2 * d + 1], aH, false); } \
            pd[bb] = (float)(aL * 16 + aH) * 0.0625f + cx; __builtin_amdgcn_sched_barrier(0); } \
        float r4[4], r2[2]; \
        _Pragma("unroll") for (int i = 0; i < 4; ++i) r4[i] = (b2 ? pd[4 + i] : pd[i]) + dpp_xor4(b2 ? pd[i] : pd[4 + i]); \
        _Pragma("unroll") for (int i = 0; i < 2; ++i) r2[i] = (b1 ? r4[2 + i] : r4[i]) + dpp_xor2(b1 ? r4[i] : r4[2 + i]); \
        const float r1 = (b0 ? r2[1] : r2[0]) + dpp_xor1(b0 ? r2[0] : r2[1]); \
        part[tl * 128 + 64 * (hf_) + 8 * j8 + g8] += r1; } while (0)
    {
        const GAS unsigned char* U8g = (const GAS unsigned char*)U8; const unsigned jo = 16u * (unsigned)j8;
        const GAS unsigned char* xlane = (const GAS unsigned char*)(ws + WS_HN8) + tok0 * DM + 32 * j8;
        u32x4 ua[8], ub[8], xc[2];
        int cur = PEER_GRAB(0);
        if (cur < 512) {
            PEER_ISSUE(ua, U8g + (size_t)(cur >> 6) * (16384 * 128), jo, cur & 63, 0, g8);
#pragma unroll
            for (int i = 0; i < 2; ++i) xc[i] = *(const GAS u32x4*)(xlane + (unsigned)((cur & 63) * DM + (cur >> 6) * 256 + 16 * i));
        }
#pragma unroll 1
        while (cur < 512) {
            const int cb = cur >> 6, tl = cur & 63;
            const int nxt = PEER_GRAB(0);
            const GAS unsigned char* Ucb = U8g + (size_t)cb * (16384 * 128);
            PEER_ISSUE(ub, Ucb, jo, tl, 1, g8);
            int xw[8];
#pragma unroll
            for (int i = 0; i < 2; ++i) { xw[4 * i] = (int)xc[i].x; xw[4 * i + 1] = (int)xc[i].y; xw[4 * i + 2] = (int)xc[i].z; xw[4 * i + 3] = (int)xc[i].w; }
            int sL = 0, sH = 0;
#pragma unroll
            for (int d = 0; d < 4; ++d) { sL = __builtin_amdgcn_sdot4(xw[2 * d], 0x01010101, sL, false); sH = __builtin_amdgcn_sdot4(xw[2 * d + 1], 0x01010101, sH, false); }
            const float cx = 0.5f * (float)sH - 7.5f * (float)sL;
            if (nxt < 512) {
#pragma unroll
                for (int i = 0; i < 2; ++i) xc[i] = *(const GAS u32x4*)(xlane + (unsigned)((nxt & 63) * DM + (nxt >> 6) * 256 + 16 * i)); }
            while ((int)__builtin_amdgcn_readfirstlane(((volatile LAS unsigned*)done)[tl]) != cb) __builtin_amdgcn_s_sleep(1);
            __builtin_amdgcn_sched_barrier(0);
            PEER_UDOT(ua, 0);
            if (nxt < 512) PEER_ISSUE(ua, U8g + (size_t)(nxt >> 6) * (16384 * 128), jo, nxt & 63, 0, g8);
            __builtin_amdgcn_sched_barrier(0);
            PEER_UDOT(ub, 1);
            if (lane == 0) ((volatile LAS unsigned*)done)[tl] = (unsigned)(cb + 1);
            cur = nxt;
        }
    }
    __syncthreads();
#undef PEER_UDOT
#ifdef PEER_STAMP
    if (layer == 0 && TSEL_A >= 0 && blockIdx.x == PSB && threadIdx.x == PST) ((unsigned long long*)(p.ws + (512 * 1024) + 1024))[22] = __builtin_amdgcn_s_memrealtime();
#endif
    unsigned char* wsw = ws; asm volatile("" : "+s"(wsw));
    const GAS float* SCU = (const GAS float*)(wsw + WS_SCL) + layer * 16384;
    const GAS float* SCV = (const GAS float*)(wsw + WS_SCL) + 32768 + layer * 16384;
    LAS unsigned char* wqb = (LAS unsigned char*)(lds + 115200);
    LAS float* wsc = (LAS float*)(lds + 123392);
#pragma unroll 1
    for (int tt = 0; tt < 8; ++tt) { const int tl = 8 * wave + tt;
        const float xs = ((const GAS float*)(wsw + WS_XS))[tok0 + tl];
        float wv[2];
#pragma unroll
        for (int i = 0; i < 2; ++i) { const int pk_ = tl * 128 + lane + 64 * i; const unsigned ex = eL[pk_];
            wv[i] = wL[pk_] * gelu_tanh(part[pk_] * (SCU[ex] * xs)) * SCV[ex]; }
        const float m = fmaxf(wave_max(fmaxf(fabsf(wv[0]), fabsf(wv[1]))), 1e-30f);
        const float inv = 127.f / m;
#pragma unroll
        for (int i = 0; i < 2; ++i) wqb[((tl * 2 + i) * 2 + (lane >> 5)) * 32 + (lane & 7) * 4 + ((lane >> 3) & 3)] = (unsigned char)(int)rintf(wv[i] * inv);
        if (lane == 0) wsc[tl] = m * (1.f / 127.f);
    }
    unsigned char* wsv = ws; asm volatile("" : "+s"(wsv));
    const unsigned char* V8 = wsv + WS_V + (size_t)layer * 16384 * 1024;
    bf16_t* OUTT = (bf16_t*)(wsv + WS_PROJ);
    int lane_v = lane; asm volatile("" : "+v"(lane_v));
    const int g8v = lane_v >> 3, j8v = lane_v & 7; const bool c3 = (lane_v >> 3) & 1, c4 = (lane_v >> 4) & 1, c5 = (lane_v >> 5) & 1;
#define PEER_VACC(src, hf_) do { _Pragma("unroll") for (int qd = 0; qd < 2; ++qd) { const int WQ = (int)wqw[((tl * 2 + (hf_)) * 2 + qd) * 8 + g8v]; \
            sw = __builtin_amdgcn_sdot4(WQ, 0x01010101, sw, false); \
            asm volatile("" : "+v"(src[4 * qd]), "+v"(src[4 * qd + 1]), "+v"(src[4 * qd + 2]), "+v"(src[4 * qd + 3])); \
            _Pragma("unroll") for (int d = 0; d < 4; ++d) { const unsigned r0 = src[4 * qd][d], r1 = src[4 * qd + 1][d], r2 = src[4 * qd + 2][d], r3 = src[4 * qd + 3][d]; \
                const unsigned x01 = __builtin_amdgcn_perm(r1, r0, 0x05010400u), y01 = __builtin_amdgcn_perm(r1, r0, 0x07030602u); \
                const unsigned x23 = __builtin_amdgcn_perm(r3, r2, 0x05010400u), y23 = __builtin_amdgcn_perm(r3, r2, 0x07030602u); \
                unsigned t[4]; t[0] = __builtin_amdgcn_perm(x23, x01, 0x05040100u); t[1] = __builtin_amdgcn_perm(x23, x01, 0x07060302u); \
                t[2] = __builtin_amdgcn_perm(y23, y01, 0x05040100u); t[3] = __builtin_amdgcn_perm(y23, y01, 0x07060302u); \
                _Pragma("unroll") for (int k = 0; k < 4; ++k) { \
                    acc[8 * d + k] = __builtin_amdgcn_sdot4((int)(t[k] & 0x0F0F0F0Fu), WQ, acc[8 * d + k], false); \
                    acc[8 * d + 4 + k] = __builtin_amdgcn_sdot4((int)(t[k] & 0xF0F0F0F0u), WQ, acc[8 * d + 4 + k], false); } } \
            __builtin_amdgcn_sched_barrier(0); } } while (0)
    __syncthreads();
    {
        const GAS unsigned char* V8g = (const GAS unsigned char*)V8; const unsigned jov = 16u * (unsigned)j8v;
        const LAS unsigned* wqw = (const LAS unsigned*)(lds + 115200);
        const LAS float* wscl = (const LAS float*)(lds + 123392);
        u32x4 va[8], vb[8];
        int cur = PEER_GRAB(1);
        if (cur < 512) PEER_ISSUE(va, V8g + (size_t)(cur >> 6) * (16384 * 128), jov, cur & 63, 0, g8v);
#pragma unroll 1
        while (cur < 512) {
            const int cb = cur >> 6, tl = cur & 63; const size_t tok = tok0 + tl;
            const int nxt = PEER_GRAB(1);
            PEER_ISSUE(vb, V8g + (size_t)cb * (16384 * 128), jov, tl, 1, g8v);
            int acc[32]; int sw = 0;
#pragma unroll
            for (int c = 0; c < 32; ++c) acc[c] = 0;
            __builtin_amdgcn_sched_barrier(0);
            PEER_VACC(va, 0);
            if (nxt < 512) PEER_ISSUE(va, V8g + (size_t)(nxt >> 6) * (16384 * 128), jov, nxt & 63, 0, g8v);
            __builtin_amdgcn_sched_barrier(0);
            PEER_VACC(vb, 1);
            const float wsf = wscl[tl], swf = (float)sw;
            const float cl = -7.5f * swf * wsf, ch = 0.5f * swf * wsf, wh = wsf * 0.0625f;
            float ac[32];
#pragma unroll
            for (int d = 0; d < 4; ++d)
#pragma unroll
                for (int k = 0; k < 4; ++k) { ac[8 * d + k] = (float)acc[8 * d + k] * wsf + cl; ac[8 * d + 4 + k] = (float)acc[8 * d + 4 + k] * wh + ch; }
            float q16[16], q8[8], q4[4];
#pragma unroll
            for (int i = 0; i < 16; ++i) q16[i] = swap32_add(ac[i], ac[16 + i]);
#pragma unroll
            for (int i = 0; i < 8; ++i) q8[i] = swap16_add(q16[i], q16[8 + i]);
#pragma unroll
            for (int i = 0; i < 4; ++i) q4[i] = (c3 ? q8[4 + i] : q8[i]) + dpp_xor8(c3 ? q8[i] : q8[4 + i]);
            u32x2 ow; ow.x = pk_bf16(q4[0], q4[1]); ow.y = pk_bf16(q4[2], q4[3]);
            *(GAS u32x2*)(OUTT + tok * DM + cb * 256 + 32 * j8v + 4 * g8v) = ow;
            cur = nxt;
        }
    }
#undef PEER_VACC
#undef PEER_CVT4
#undef PEER_ISSUE
#undef PEER_GRAB
#ifdef PEER_STAMP
    if (layer == 0 && TSEL_A >= 0 && blockIdx.x == PSB && threadIdx.x == PST) ((unsigned long long*)(p.ws + (512 * 1024) + 1024))[23] = __builtin_amdgcn_s_memrealtime();
#endif
    asm volatile("s_waitcnt vmcnt(0)" ::: "memory");
    __syncthreads();
    unsigned char* wse = ws; asm volatile("" : "+s"(wse));
    const GAS float* mod = (const GAS float*)(wse + WS_MOD) + (size_t)layer * 4 * 12288;
    const GAS bf16_t* OUTE = (const GAS bf16_t*)(wse + WS_PROJ);
    int lane_e = lane; asm volatile("" : "+v"(lane_e));
    const int bt = (int)(tok0 / SEQ);
    float gv2[32], av[32], sv2[32];
    {
        const GAS float* g2 = mod + (size_t)bt * 12288 + 10240 + 16 * lane_e;
        const GAS float* modn = (const GAS float*)(wse + WS_MOD) + (size_t)(LAST ? layer : layer + 1) * 4 * 12288 + (size_t)bt * 12288 + 16 * lane_e;
        const GAS float* ng = (const GAS float*)(LAST ? p.in[6] : p.in[5] + (size_t)(layer + 1) * 2 * DM) + 16 * lane_e;
#pragma unroll
        for (int j = 0; j < 2; ++j)
#pragma unroll
            for (int d = 0; d < 4; ++d) { const f32x4 a = *(const GAS f32x4*)(g2 + 1024 * j + 4 * d), g = *(const GAS f32x4*)(ng + 1024 * j + 4 * d);
                f32x4 sc = (f32x4){0.f, 0.f, 0.f, 0.f}, sh = (f32x4){0.f, 0.f, 0.f, 0.f};
                if (!LAST) { sc = *(const GAS f32x4*)(modn + 2048 + 1024 * j + 4 * d); sh = *(const GAS f32x4*)(modn + 1024 * j + 4 * d); }
#pragma unroll
                for (int e = 0; e < 4; ++e) { gv2[16 * j + 4 * d + e] = a[e]; av[16 * j + 4 * d + e] = g[e] * (1.f + sc[e]); sv2[16 * j + 4 * d + e] = sh[e]; } }
    }
#pragma unroll 1
    for (int tt = 0; tt < 8; ++tt) {
        const int tl = 8 * wave + tt; const size_t tok = tok0 + tl;
        GAS float* hrow = (GAS float*)(p.out + tok * DM + 16 * lane_e);
        GAS bf16_t* hb = (GAS bf16_t*)(wse + WS_H) + tok * DM + 16 * lane_e;
        const GAS bf16_t* orow = OUTE + tok * DM + 16 * lane_e;
        float hv[32]; float ss = 0.f;
#pragma unroll
        for (int j = 0; j < 2; ++j) {
            float of[16]; unpack8(*(const GAS u32x4*)(orow + 1024 * j), of); unpack8(*(const GAS u32x4*)(orow + 1024 * j + 8), of + 8);
            float hf[16]; unpack8(*(const GAS u32x4*)(hb + 1024 * j), hf); unpack8(*(const GAS u32x4*)(hb + 1024 * j + 8), hf + 8);
#pragma unroll
            for (int e = 0; e < 16; ++e) { const float hh = hf[e] + gv2[16 * j + e] * of[e]; hv[16 * j + e] = hh; ss += hh * hh; }
        }
        const float r = rsqrtf(wave_sum(ss) * (1.f / DM) + EPS);
        if (LAST) {
#pragma unroll
            for (int j = 0; j < 2; ++j)
#pragma unroll
                for (int d = 0; d < 4; ++d) { f32x4 o;
#pragma unroll
                    for (int e = 0; e < 4; ++e) o[e] = hv[16 * j + 4 * d + e] * r * av[16 * j + 4 * d + e];
                    *(GAS f32x4*)(hrow + 1024 * j + 4 * d) = o; }
        } else {
#pragma unroll
            for (int j = 0; j < 2; ++j) { *(GAS u32x4*)(hb + 1024 * j) = pack8(hv + 16 * j); *(GAS u32x4*)(hb + 1024 * j + 8) = pack8(hv + 16 * j + 8); }
            float mx = 0.f;
#pragma unroll
            for (int e = 0; e < 32; ++e) { hv[e] = hv[e] * r * av[e] + sv2[e]; mx = fmaxf(mx, fabsf(hv[e])); }
            mx = fmaxf(wave_max(mx), 1e-20f);
            const float inv = 127.f / mx;
            GAS unsigned char* h8 = (GAS unsigned char*)(wse + WS_HN8) + tok * DM + 16 * lane_e;
#pragma unroll
            for (int j = 0; j < 2; ++j) { u32x4 o;
                o.x = pack4_i8(hv[16 * j], hv[16 * j + 1], hv[16 * j + 2], hv[16 * j + 3], inv); o.y = pack4_i8(hv[16 * j + 4], hv[16 * j + 5], hv[16 * j + 6], hv[16 * j + 7], inv);
                o.z = pack4_i8(hv[16 * j + 8], hv[16 * j + 9], hv[16 * j + 10], hv[16 * j + 11], inv); o.w = pack4_i8(hv[16 * j + 12], hv[16 * j + 13], hv[16 * j + 14], hv[16 * j + 15], inv);
                *(GAS u32x4*)(h8 + 1024 * j) = o; }
            if (lane_e == 0) ((GAS float*)(wse + WS_XS))[tok] = mx * (1.f / 127.f);
        }
    }
#ifdef PEER_STAMP
    if (layer == 0 && TSEL_A >= 0 && blockIdx.x == PSB && threadIdx.x == PST) ((unsigned long long*)(p.ws + (512 * 1024) + 1024))[24] = __builtin_amdgcn_s_memrealtime();
    if (layer == 0 && TSEL_A >= 0 && threadIdx.x == PST) __hip_atomic_fetch_max((unsigned long long*)(p.ws + (512 * 1024) + 1024) + 25, (unsigned long long)__builtin_amdgcn_s_memrealtime(), __ATOMIC_RELAXED, __HIP_MEMORY_SCOPE_AGENT);
#endif
    __syncthreads();
}
template <class Epi>
__device__ __forceinline__ void run_gemm(LAS unsigned char* lds, const bf16_t* A, const bf16_t* Bt, int N, const Epi& E, int tid, int bid, int G) {
    pg8::Gemm gm{A, Bt, NT, N, DM, nullptr, nullptr}; pg8::StaticOrder S; S.init(NT, N, G, bid);
    pg8::gemm_phase<Epi, pg8::StaticOrder, true, true>(lds, gm, S, E, tid);
}
template <class Epi>
__device__ __forceinline__ void run_gemm_i8(LAS unsigned char* lds, const unsigned char* A8, const unsigned char* Bt8, int N, const float* sa, const float* sw, const Epi& E, int tid, int bid, int G) {
    pg8::Gemm gm{(const bf16_t*)A8, (const bf16_t*)Bt8, NT, N, DM / 2, sa, sw}; pg8::StaticOrder S; S.init(NT, N, G, bid);
    pg8::gemm_phase<Epi, pg8::StaticOrder, true, true, true>(lds, gm, S, E, tid);
}


typedef __attribute__((address_space(4))) const unsigned char* karg_t;
__device__ __forceinline__ Params load_params() {
    int z; asm volatile("s_mov_b32 %0, 0" : "=s"(z));
    karg_t ka = (karg_t)__builtin_amdgcn_kernarg_segment_ptr() + z;
    Params q;
#pragma unroll
    for (int k = 0; k < 25; ++k) q.in[k] = *(const float* const __attribute__((address_space(4)))*)(ka + 8 * k);
    q.out = *(float* const __attribute__((address_space(4)))*)(ka + 200);
    q.ws = *(unsigned char* const __attribute__((address_space(4)))*)(ka + 208);
    q.pad = 0;
    return q;
}

constexpr size_t WS_BAR = WS_MISC + 65536;
constexpr int BAR_LDS_OFF = LDS_BYTES - 64;
#define GRID_BAR() do { const Params pb = load_params(); XcdBarrier xb; xb.bar = (unsigned*)(pb.ws + WS_BAR); xb.x = xb_xcc_id(); xb.st = (volatile LAS unsigned*)(lds + BAR_LDS_OFF); xcd_barrier(xb); } while (0)
#define STAMP(k) do { if (TSEL_A >= 0 && blockIdx.x == 0 && wave_s == 0 && __builtin_amdgcn_mbcnt_lo(~0u, 0u) == 0 && __builtin_amdgcn_mbcnt_hi(~0u, 0u) == 0) { const Params pt = load_params(); ((unsigned long long*)(pt.ws + WS_MISC + 1024))[(k)] = __builtin_amdgcn_s_memrealtime(); } } while (0)
#ifndef DUMP_STAGE
#define DUMP_STAGE 0
#endif
__device__ __forceinline__ void dump_bf16(float* out, const bf16_t* src, size_t ld) {
    for (size_t i = (size_t)blockIdx.x * NTHREADS + threadIdx.x; i < (size_t)NT * DM; i += (size_t)gridDim.x * NTHREADS) {
        const size_t t = i / DM, c = i % DM; float v = bf2f(src[t * ld + c]); if (!(v == v) || fabsf(v) > 1e30f) v = 1.0e4f; out[i] = v; }
}
__device__ __forceinline__ void dump_f32(float* out, const float* src, size_t n) {
    for (size_t i = (size_t)blockIdx.x * NTHREADS + threadIdx.x; i < (size_t)NT * DM; i += (size_t)gridDim.x * NTHREADS) out[i] = src[i % n];
}
#define DUMPF_AT(n, srcexpr, cnt) if (DUMP_STAGE == (n)) { const Params pd = load_params(); unsigned char* ws = pd.ws; dump_f32(pd.out, (const float*)(srcexpr), (cnt)); return; }
#define DUMP_AT(n, srcexpr, ld) if (DUMP_STAGE == (n)) { const Params pd = load_params(); unsigned char* ws = pd.ws; dump_bf16(pd.out, (const bf16_t*)(srcexpr), (ld)); return; }

__global__ void __launch_bounds__(NTHREADS, 2) fwd_megakernel(Params p_unused) {
    extern __shared__ __attribute__((aligned(16))) unsigned char lds_raw[];
    LAS unsigned char* lds = (LAS unsigned char*)lds_raw;
    cg::grid_group grid = cg::this_grid();
    const int wave_s = __builtin_amdgcn_readfirstlane(threadIdx.x >> 6);
    STAMP(0);
    {
        if (threadIdx.x < 16) ((volatile LAS unsigned*)(lds + BAR_LDS_OFF))[threadIdx.x] = 0u;
        if (blockIdx.x == 0) { const Params pz = load_params(); unsigned* bw = (unsigned*)(pz.ws + WS_BAR);
            for (int i = threadIdx.x; i < XCD_BAR_WORDS + 128; i += NTHREADS) __hip_atomic_store(bw + i, 0u, __ATOMIC_RELAXED, __HIP_MEMORY_SCOPE_AGENT);
            if (TSEL_A >= 0 && threadIdx.x == 0) ((unsigned long long*)(pz.ws + WS_MISC + 1024))[25] = 0ull; }
        __syncthreads();
    }
#define PHASE_BEGIN const Params p = load_params(); unsigned char* ws = p.ws; (void)ws; \
    int bid = blockIdx.x, G = gridDim.x; unsigned zq = 0; asm volatile("" : "+s"(bid), "+s"(G), "+s"(zq)); \
    int tid = (wave_s << 6) | (int)__builtin_amdgcn_mbcnt_hi(~0u, __builtin_amdgcn_mbcnt_lo(~0u, zq)); asm volatile("" : "+v"(tid)); const int lane = tid & 63, wave = wave_s; (void)lane; (void)wave; \


    { PHASE_BEGIN phase0a(p, lds, tid, lane, wave, bid, G); }
    grid.sync(); { const Params pb = load_params(); (void)xcd_barrier_post((unsigned*)(pb.ws + WS_BAR), (volatile LAS unsigned*)(lds + BAR_LDS_OFF)); } STAMP(1);
    { PHASE_BEGIN quant_weights(ws, lane, bid * 8 + wave, G * 8); phase_rows<true>(p, lds, p.in[0], p.in[5], (const float*)(ws + WS_MOD), 2048, 0, tid, lane, wave, bid, G); }
    GRID_BAR(); STAMP(2);
    DUMP_AT(1, ws + WS_HN, DM)
    DUMPF_AT(10, ws + WS_LF, 131072)
    DUMPF_AT(12, ws + WS_MOD, 98304)
    DUMP_AT(2, ws + WS_WIN0, DM)
    { PHASE_BEGIN EpiProj<0> E{(bf16_t*)(ws + WS_PROJ), EVEN_IN, (bf16_t*)(ws + WS_VTM), (bf16_t*)(ws + WS_VTD)}; run_gemm_i8(lds, ws + WS_HN8, ws + WS_W8, EVEN_IN, (const float*)(ws + WS_XS), (const float*)(ws + WS_WSC), E, tid, bid, G); }
    GRID_BAR(); STAMP(3);
    DUMP_AT(3, ws + WS_PROJ, EVEN_IN)
    DUMP_AT(4, ws + WS_PROJ + 2 * 3072, EVEN_IN)
    { PHASE_BEGIN
      for (int it = bid; it < 1024; it += G) {
        if (it < 512) mlstm_cloc_unit(p, lds, it, tid, lane, wave); else diff_post_item(p, lds, it - 512, tid);
      } }
    GRID_BAR(); STAMP(4);
    DUMP_AT(5, ws + WS_PROJ + 2 * 3072, EVEN_IN)
    DUMP_AT(6, ws + WS_CLOC, DM)
    DUMPF_AT(11, ws + WS_CHS, 1024)
    DUMPF_AT(13, ws + WS_NLOC, 65536)
    DUMP_AT(7, ws + WS_VTD, DM)
    DUMP_AT(8, ws + WS_QM, DM)
    {
        PHASE_BEGIN
        {
            for (int idx = bid * NTHREADS + tid; idx < 65536; idx += G * NTHREADS) mlstm_scan(p, idx);
            asm volatile("s_waitcnt vmcnt(0)" ::: "memory");
            __syncthreads();
            if (tid == 0) { __builtin_amdgcn_fence(__ATOMIC_RELEASE, "agent"); asm volatile("s_waitcnt vmcnt(0)" ::: "memory");
                __hip_atomic_fetch_add((unsigned*)(ws + WS_BAR) + XCD_BAR_WORDS + 64, 1u, __ATOMIC_RELAXED, __HIP_MEMORY_SCOPE_AGENT); }
        }
    }
#pragma unroll 1
    for (int st = 0; st < 3; ++st) {
        { PHASE_BEGIN if (((bid >> 3) & 3) == st) convert_tables(p, lane, bid * 8 + wave, G * 8); }
        if (st < 2) {
            PHASE_BEGIN
            const float lam = ((const float*)(ws + WS_MISC))[0];
            for (int pr = bid + st * G; pr < 512; pr += (st == 0 ? 512 : G)) {
                const int bh = pr >> 4, jj = pr & 15, b = bh >> 3, h = bh & 7;
                const bf16_t* PROJ = (const bf16_t*)(ws + WS_PROJ);
                const bf16_t* Qb = PROJ + (size_t)b * SEQ * EVEN_IN + 3072 + h * 128;
                const bf16_t* Kb = PROJ + (size_t)b * SEQ * EVEN_IN + 4096 + h * 128;
                const bf16_t* Vt = (const bf16_t*)(ws + WS_VTD) + ((size_t)bh * 128) * SEQ;
                bf16_t* outp = (bf16_t*)(ws + WS_CAT) + (size_t)b * SEQ * DM + 1024 + h * 128;
#pragma unroll 1
                for (int rep = 0; rep < 2; ++rep)
                    attn_unit<0>(lds, Qb, Kb, EVEN_IN, Vt, rep ? jj : 31 - jj, nullptr, outp, p.in[14] + h * 128, lam, tid, lane, wave);
            }
        }
    }
    STAMP(21);
    {
        PHASE_BEGIN
        if (tid == 0) {
            unsigned* cnt = (unsigned*)(ws + WS_BAR) + XCD_BAR_WORDS + 64; unsigned sp = 0;
            while (__hip_atomic_load(cnt, __ATOMIC_RELAXED, __HIP_MEMORY_SCOPE_AGENT) < (unsigned)G && ++sp < (1u << 22)) __builtin_amdgcn_s_sleep(2);
            __builtin_amdgcn_fence(__ATOMIC_ACQUIRE, "agent"); asm volatile("s_waitcnt vmcnt(0)" ::: "memory");
        }
        __syncthreads();
        for (int pr = bid; pr < 256; pr += G) {
            const int bh = pr >> 4, cc = pr & 15;
#pragma unroll 1
            for (int rep = 0; rep < 2; ++rep) mlstm_out_unit(p, lds, bh * 32 + (rep ? cc : 31 - cc), tid, lane, wave);
        }
    }
    { PHASE_BEGIN if (((bid >> 3) & 3) == 3) convert_tables(p, lane, bid * 8 + wave, G * 8); }
    GRID_BAR(); STAMP(5);
    DUMP_AT(9, ws + WS_CAT, DM)
    { PHASE_BEGIN EpiResid<true> E{p.in[0], (bf16_t*)(ws + WS_H), (const float*)(ws + WS_MOD) + 4096}; run_gemm(lds, (const bf16_t*)(ws + WS_CAT), (const bf16_t*)(ws + WS_WOUT0), DM, E, tid, bid, G); }
    GRID_BAR(); STAMP(6);
#if STOP_AFTER >= 2
    { PHASE_BEGIN phase_rows<false>(p, lds, ws + WS_H, p.in[5] + DM, (const float*)(ws + WS_MOD), 8192, 6144, tid, lane, wave, bid, G); }
    GRID_BAR(); STAMP(7);
    { PHASE_BEGIN EpiStoreBf16 E{(bf16_t*)(ws + WS_QP), DM}; run_gemm_i8(lds, ws + WS_HN8, ws + WS_W8 + (size_t)(6144 + 5120) * 2048, DM, (const float*)(ws + WS_XS), (const float*)(ws + WS_WSC) + 6144 + 5120, E, tid, bid, G); }
    GRID_BAR(); STAMP(8);
    { PHASE_BEGIN for (int tile = bid; tile < 256; tile += G) peer_tile<false>(p, lds, 0, tile, tid, lane, wave); }
    GRID_BAR(); STAMP(9);
#endif
#if STOP_AFTER >= 3
    { PHASE_BEGIN EpiProj<1> E{(bf16_t*)(ws + WS_PROJ), ODD_IN, (bf16_t*)(ws + WS_VTM), (bf16_t*)(ws + WS_VTD)}; run_gemm_i8(lds, ws + WS_HN8, ws + WS_W8 + (size_t)6144 * 2048, ODD_IN, (const float*)(ws + WS_XS), (const float*)(ws + WS_WSC) + 6144, E, tid, bid, G); }
    GRID_BAR(); STAMP(10);
    { PHASE_BEGIN
      for (int it = bid; it < 1536; it += G) {
        if (it < 512) moba_post_item(p, lds, it, tid); else sgu_unit(p, lds, it - 512, tid, lane, wave);
      } }
    GRID_BAR(); STAMP(11);
    { PHASE_BEGIN
      for (int pr = bid; pr < 512; pr += G) {
        const int bh = pr >> 4, jj = pr & 15, b = bh >> 3, h = bh & 7;
        const bf16_t* PROJ = (const bf16_t*)(ws + WS_PROJ);
        const bf16_t* Qb = PROJ + (size_t)b * SEQ * ODD_IN + h * 128;
        const bf16_t* Kb = PROJ + (size_t)b * SEQ * ODD_IN + 1024 + h * 128;
        const bf16_t* Vt = (const bf16_t*)(ws + WS_VTD) + ((size_t)bh * 128) * SEQ;
        const float* km = (const float*)(ws + WS_KMEAN) + (size_t)bh * 16 * 128;
        bf16_t* outp = (bf16_t*)(ws + WS_CAT) + (size_t)b * SEQ * DM + h * 128;
#pragma unroll 1
        for (int rep = 0; rep < 2; ++rep)
            attn_unit<1>(lds, Qb, Kb, ODD_IN, Vt, rep ? jj : 31 - jj, km, outp, nullptr, 0.f, tid, lane, wave);
      } }
    GRID_BAR(); STAMP(12);
    { PHASE_BEGIN EpiResid<false> E{(const bf16_t*)(ws + WS_H), (bf16_t*)(ws + WS_H), (const float*)(ws + WS_MOD) + 4 * 12288 + 4096}; run_gemm(lds, (const bf16_t*)(ws + WS_CAT), (const bf16_t*)(ws + WS_WOUT1), DM, E, tid, bid, G); }
    GRID_BAR(); STAMP(13);
#endif
#if STOP_AFTER >= 4
    { PHASE_BEGIN phase_rows<false>(p, lds, ws + WS_H, p.in[5] + 3 * DM, (const float*)(ws + WS_MOD) + 4 * 12288, 8192, 6144, tid, lane, wave, bid, G); }
    GRID_BAR(); STAMP(14);
    { PHASE_BEGIN EpiStoreBf16 E{(bf16_t*)(ws + WS_QP), DM}; run_gemm_i8(lds, ws + WS_HN8, ws + WS_W8 + (size_t)(6144 + 5120 + 2048) * 2048, DM, (const float*)(ws + WS_XS), (const float*)(ws + WS_WSC) + 6144 + 5120 + 2048, E, tid, bid, G); }
    GRID_BAR(); STAMP(15);
    { PHASE_BEGIN for (int tile = bid; tile < 256; tile += G) peer_tile<true>(p, lds, 1, tile, tid, lane, wave); }
    STAMP(31);
    if (TSEL_A >= 0 && blockIdx.x == 0 && wave_s == 0 && __builtin_amdgcn_mbcnt_lo(~0u, 0u) == 0 && __builtin_amdgcn_mbcnt_hi(~0u, 0u) == 0) { const Params pt = load_params(); const unsigned long long* ts = (const unsigned long long*)(pt.ws + WS_MISC + 1024);
        pt.out[0] += (float)(ts[TSEL_B] - ts[TSEL_A]) * (0.01f / TSCALE); }
#else
    {
        PHASE_BEGIN
        const int gw = bid * 8 + wave, NGW = G * 8;
        for (int m = gw; m < NT; m += NGW) {
            float* hr = p.out + (size_t)m * DM;
            f32x4 v[8]; float s = 0.f;
#pragma unroll
            for (int j = 0; j < 8; ++j) { v[j] = ((const f32x4*)hr)[lane + 64 * j]; s += (v[j][0] * v[j][0] + v[j][1] * v[j][1]) + (v[j][2] * v[j][2] + v[j][3] * v[j][3]); }
            const float r = rsqrtf(wave_sum(s) * (1.f / DM) + EPS);
#pragma unroll
            for (int j = 0; j < 8; ++j) ((f32x4*)hr)[lane + 64 * j] = v[j] * r * ((const f32x4*)p.in[6])[lane + 64 * j];
        }
    }
#endif
}

extern "C" void kernel_launch(void* const* d_in, const int* in_sizes, int n_in, void* d_out, int out_size, void* d_ws, size_t ws_size,
                              hipStream_t stream) {
    static int grid_blocks = 0;
    if (!grid_blocks) {
        int dev = 0, cus = 0, per_cu = 0;
        (void)hipGetDevice(&dev);
        (void)hipDeviceGetAttribute(&cus, hipDeviceAttributeMultiprocessorCount, dev);
        (void)hipFuncSetAttribute((const void*)fwd_megakernel, hipFuncAttributeMaxDynamicSharedMemorySize, LDS_BYTES);
        (void)hipOccupancyMaxActiveBlocksPerMultiprocessor(&per_cu, (const void*)fwd_megakernel, NTHREADS, LDS_BYTES);
        if (per_cu < 1) { fprintf(stderr, "kernel_launch: occupancy query says %d blocks per CU\n", per_cu); per_cu = 1; }
        grid_blocks = cus;
        if (n_in != 25 || ws_size < WS_END) fprintf(stderr, "kernel_launch: unexpected n_in %d or ws_size %zu (< %zu)\n", n_in, ws_size, (size_t)WS_END);
    }
    Params p{};
    for (int i = 0; i < 25 && i < n_in; ++i) p.in[i] = (const float*)d_in[i];
    p.out = (float*)d_out; p.ws = (unsigned char*)d_ws;
    void* args[] = {&p};
    hipError_t e = hipLaunchCooperativeKernel((const void*)fwd_megakernel, dim3(grid_blocks), dim3(NTHREADS), args, LDS_BYTES, stream);
    if (e != hipSuccess) fprintf(stderr, "cooperative launch failed: %s (grid %d)\n", hipGetErrorString(e), grid_blocks);
}
```
